# Optimizing an MI355X kernel written in HIP

```python
import jax, jax.numpy as jnp
from jax import lax
import numpy as np

D_MODEL = 1024
BATCH = 1
SEQ = 16384
DEPTH = 4

N_A_LAYERS = DEPTH // 2
N_B_LAYERS = DEPTH - N_A_LAYERS
D_FF = 2816
RMS_EPS = 1e-6

RWKV_HEAD_DIM = 64
RWKV_HEADS = D_MODEL // RWKV_HEAD_DIM
D_DECAY_LORA = 64
D_AAA_LORA = 64
D_MV_LORA = 32
D_GATE_LORA = 64
GN_EPS = 64e-5

DIL_GROUPS = ((128, 1), (512, 4), (2048, 16))
N_GROUPS = len(DIL_GROUPS)
ATTN_HEAD_DIM = 64
ATTN_HEADS = D_MODEL // ATTN_HEAD_DIM
Q_WIDTH = N_GROUPS * ATTN_HEADS * ATTN_HEAD_DIM
NEG_INF = -1e30

kernel_name = "rwkv7_yoco_dilated_macaron"


def rms_norm(x, g):
    xf = x.astype(jnp.float32)
    y = xf * lax.rsqrt(jnp.mean(xf * xf, axis=-1, keepdims=True) + RMS_EPS)
    return (y * g.astype(jnp.float32)).astype(x.dtype)


def swiglu(h, w_in, w_out):
    gate, up = jnp.split(h @ w_in, 2, axis=-1)
    return (jax.nn.silu(gate) * up) @ w_out


def token_shift(x):
    return jnp.pad(x, ((0, 0), (1, 0), (0, 0)))[:, :-1]


def rwkv7_recurrence(r, decay, k, v, a, b):
    Bsz, T, H, N = r.shape

    def step(S, inp):
        r_t, w_t, k_t, v_t, a_t, b_t = inp
        sa = jnp.einsum('bhij,bhj->bhi', S, a_t)
        S = S * w_t[:, :, None, :] + sa[..., None] * b_t[:, :, None, :] + v_t[..., None] * k_t[:, :, None, :]
        y = jnp.einsum('bhij,bhj->bhi', S, r_t)
        return S, y

    xs = tuple(jnp.moveaxis(t.astype(jnp.float32), 1, 0) for t in (r, decay, k, v, a, b))
    S0 = jnp.zeros((Bsz, H, N, N), jnp.float32)
    _, ys = lax.scan(step, S0, xs)
    return jnp.moveaxis(ys, 0, 1)


def rwkv7_time_mix(h, v_first, vres, mu, w_rkv, w0, w1, w2, a0, a1, a2, g1, g2,
                   k_k, k_a, r_k, ln_w, ln_b, w_o):
    Bsz, T, C = h.shape
    heads = lambda t: t.reshape(Bsz, T, RWKV_HEADS, RWKV_HEAD_DIM)
    xx = token_shift(h) - h
    xr, xw, xk, xv, xa, xg = [h + xx * mu[j] for j in range(6)]
    r = xr @ w_rkv[0]
    k = xk @ w_rkv[1]
    v = xv @ w_rkv[2]
    w = -jax.nn.softplus(-(w0 + jnp.tanh(xw @ w1) @ w2)) - 0.5
    decay = jnp.exp(-jnp.exp(w.astype(jnp.float32)))
    if vres is None:
        v_first = v
    else:
        v0, v1, v2 = vres
        v = v + (v_first - v) * jax.nn.sigmoid(v0 + (xv @ v1) @ v2)
    a = jax.nn.sigmoid(a0 + (xa @ a1) @ a2)
    g = jax.nn.sigmoid(xg @ g1) @ g2
    kk = heads(k * k_k).astype(jnp.float32)
    kk = kk / jnp.maximum(jnp.linalg.norm(kk, axis=-1, keepdims=True), 1e-12)
    k = k * (1.0 + (a - 1.0) * k_a)
    rh, kh, vh = heads(r), heads(k), heads(v)
    y = rwkv7_recurrence(rh, heads(decay), kh, vh, -kk, kk * heads(a))
    mean = jnp.mean(y, axis=-1, keepdims=True)
    var = jnp.mean(jnp.square(y - mean), axis=-1, keepdims=True)
    y = ((y - mean) * lax.rsqrt(var + GN_EPS)).reshape(Bsz, T, C) * ln_w + ln_b
    bonus = jnp.sum(rh * kh * r_k, axis=-1, keepdims=True) * vh
    y = y.astype(h.dtype) + bonus.reshape(Bsz, T, C)
    return (y * g) @ w_o, v_first


def dilated_group_attention(q, k, v, window, dilation):
    Bsz, T, H, Dh = q.shape
    blk = window // dilation
    Tp = -(-T // window) * window
    M = Tp // dilation
    NB = M // blk

    def to_blocks(t):
        t = jnp.pad(t, ((0, 0), (0, Tp - T), (0, 0), (0, 0)))
        t = t.reshape(Bsz, M, dilation, H, Dh).transpose(0, 2, 1, 3, 4)
        return t.reshape(Bsz, dilation, NB, blk, H, Dh)

    def with_prev(t):
        prev = jnp.pad(t, ((0, 0), (0, 0), (1, 0), (0, 0), (0, 0), (0, 0)))[:, :, :-1]
        return jnp.concatenate([prev, t], axis=3)

    def from_blocks(t):
        t = t.reshape((Bsz, dilation, M) + t.shape[4:])
        t = jnp.swapaxes(t, 1, 2).reshape((Bsz, Tp) + t.shape[3:])
        return t[:, :T]

    qb, kb, vb = to_blocks(q), to_blocks(k), to_blocks(v)
    ks, vs = with_prev(kb), with_prev(vb)
    s = jnp.einsum('brnqhd,brnkhd->brnhqk', qb, ks).astype(jnp.float32)
    qi = jnp.arange(blk)[:, None]
    kj = jnp.arange(2 * blk)[None, :]
    band = (kj >= qi) & (kj <= qi + blk)
    mask = band[None] & ((jnp.arange(NB)[:, None, None] > 0) | (kj >= blk)[None])
    s = jnp.where(mask[None, None, :, None], s, NEG_INF)
    m = jnp.max(s, axis=-1, keepdims=True)
    p = jnp.exp(s - m)
    l = jnp.sum(p, axis=-1, keepdims=True)
    o = jnp.einsum('brnhqk,brnkhd->brnqhd', p / l, vs.astype(jnp.float32))
    lse = jnp.swapaxes((m + jnp.log(l))[..., 0], -1, -2)
    return from_blocks(o), from_blocks(lse)


def shared_kv(x, kv_norm, w_kv, k_gain):
    Bsz, T, _ = x.shape
    kv = (rms_norm(x, kv_norm) @ w_kv).reshape(Bsz, T, 2, N_GROUPS, ATTN_HEADS, ATTN_HEAD_DIM)
    k = rms_norm(kv[:, :, 0], k_gain[:, None, :])
    return k, kv[:, :, 1]


def dilated_attention_mixer(h, k_sh, v_sh, w_q, q_gain, w_o):
    Bsz, T, _ = h.shape
    q = (h @ w_q).reshape(Bsz, T, N_GROUPS, ATTN_HEADS, ATTN_HEAD_DIM)
    q = rms_norm(q, q_gain[:, None, :]) * ATTN_HEAD_DIM ** -0.5
    outs, lses = [], []
    for g, (win, dil) in enumerate(DIL_GROUPS):
        o, lse = dilated_group_attention(q[:, :, g], k_sh[:, :, g], v_sh[:, :, g], win, dil)
        outs.append(o)
        lses.append(lse)
    alpha = jax.nn.softmax(jnp.stack(lses, axis=0), axis=0)
    o = jnp.sum(alpha[..., None] * jnp.stack(outs, axis=0), axis=0)
    return o.reshape(Bsz, T, ATTN_HEADS * ATTN_HEAD_DIM).astype(h.dtype) @ w_o


def setup_inputs(seed: int = 0) -> dict:
    key = jax.random.key(seed)
    ks = iter(jax.random.split(key, 40))
    f32 = jnp.float32
    D, F, NA, NB = D_MODEL, D_FF, N_A_LAYERS, N_B_LAYERS
    H, N = RWKV_HEADS, RWKV_HEAD_DIM

    def nrm(shape, scale):
        return jax.random.normal(next(ks), shape, f32) * scale

    def gain(shape):
        return 1.0 + nrm(shape, 0.02)

    def unif(shape, lo, hi):
        return jax.random.uniform(next(ks), shape, f32, lo, hi)

    return {
        "x": nrm((BATCH, SEQ, D), 1.0),
        "ffn_norm": gain((DEPTH, 2, D)),
        "ffn_w_in": nrm((DEPTH, 2, D, 2 * F), D ** -0.5),
        "ffn_w_out": nrm((DEPTH, 2, F, D), F ** -0.5),
        "mix_norm": gain((DEPTH, D)),
        "rwkv_mu": unif((NA, 6, D), 0.0, 1.0),
        "rwkv_w_rkv": nrm((NA, 3, D, D), D ** -0.5),
        "rwkv_w0": unif((NA, D), -5.0, -1.0),
        "rwkv_w1": nrm((NA, D, D_DECAY_LORA), D ** -0.5),
        "rwkv_w2": nrm((NA, D_DECAY_LORA, D), 0.1 * D_DECAY_LORA ** -0.5),
        "rwkv_a0": nrm((NA, D), 0.1),
        "rwkv_a1": nrm((NA, D, D_AAA_LORA), D ** -0.5),
        "rwkv_a2": nrm((NA, D_AAA_LORA, D), 0.5 * D_AAA_LORA ** -0.5),
        "rwkv_v0": 1.0 + nrm((NA - 1, D), 0.1),
        "rwkv_v1": nrm((NA - 1, D, D_MV_LORA), D ** -0.5),
        "rwkv_v2": nrm((NA - 1, D_MV_LORA, D), 0.5 * D_MV_LORA ** -0.5),
        "rwkv_g1": nrm((NA, D, D_GATE_LORA), D ** -0.5),
        "rwkv_g2": nrm((NA, D_GATE_LORA, D), D_GATE_LORA ** -0.5),
        "rwkv_k_k": 0.85 + nrm((NA, D), 0.05),
        "rwkv_k_a": 1.0 + nrm((NA, D), 0.05),
        "rwkv_r_k": nrm((NA, H, N), 0.1),
        "rwkv_ln_w": gain((NA, D)),
        "rwkv_ln_b": nrm((NA, D), 0.02),
        "rwkv_w_o": nrm((NA, D, D), D ** -0.5),
        "kv_norm": gain((D,)),
        "w_kv": nrm((D, 2 * Q_WIDTH), D ** -0.5),
        "k_norm": gain((N_GROUPS, ATTN_HEAD_DIM)),
        "attn_w_q": nrm((NB, D, Q_WIDTH), D ** -0.5),
        "q_norm": gain((NB, N_GROUPS, ATTN_HEAD_DIM)),
        "attn_w_o": nrm((NB, ATTN_HEADS * ATTN_HEAD_DIM, D), (ATTN_HEADS * ATTN_HEAD_DIM) ** -0.5),
    }


def reference(x, ffn_norm, ffn_w_in, ffn_w_out, mix_norm, rwkv_mu, rwkv_w_rkv, rwkv_w0,
              rwkv_w1, rwkv_w2, rwkv_a0, rwkv_a1, rwkv_a2, rwkv_v0, rwkv_v1, rwkv_v2,
              rwkv_g1, rwkv_g2, rwkv_k_k, rwkv_k_a, rwkv_r_k, rwkv_ln_w, rwkv_ln_b, rwkv_w_o,
              kv_norm, w_kv, k_norm, attn_w_q, q_norm, attn_w_o):
    v_first = None
    k_sh = None
    v_sh = None
    for l in range(DEPTH):
        x = x + 0.5 * swiglu(rms_norm(x, ffn_norm[l, 0]), ffn_w_in[l, 0], ffn_w_out[l, 0])
        h = rms_norm(x, mix_norm[l])
        if l < N_A_LAYERS:
            vres = None if l == 0 else (rwkv_v0[l - 1], rwkv_v1[l - 1], rwkv_v2[l - 1])
            y, v_first = rwkv7_time_mix(h, v_first, vres, rwkv_mu[l], rwkv_w_rkv[l], rwkv_w0[l],
                                        rwkv_w1[l], rwkv_w2[l], rwkv_a0[l], rwkv_a1[l], rwkv_a2[l],
                                        rwkv_g1[l], rwkv_g2[l], rwkv_k_k[l], rwkv_k_a[l], rwkv_r_k[l],
                                        rwkv_ln_w[l], rwkv_ln_b[l], rwkv_w_o[l])
        else:
            i = l - N_A_LAYERS
            y = dilated_attention_mixer(h, k_sh, v_sh, attn_w_q[i], q_norm[i], attn_w_o[i])
        x = x + y
        x = x + 0.5 * swiglu(rms_norm(x, ffn_norm[l, 1]), ffn_w_in[l, 1], ffn_w_out[l, 1])
        if l == N_A_LAYERS - 1:
            k_sh, v_sh = shared_kv(x, kv_norm, w_kv, k_norm)
    return x
```

```cpp
#include <hip/hip_runtime.h>
#include <hip/hip_cooperative_groups.h>
#include <cstdio>
#include <cstdint>
namespace cg = cooperative_groups;
namespace pg8 {
#define PG8_LAS __attribute__((address_space(3)))
typedef unsigned short bf16_t;
typedef short bf16x8 __attribute__((ext_vector_type(8)));
typedef float f32x4 __attribute__((ext_vector_type(4)));
typedef unsigned u32x4 __attribute__((ext_vector_type(4)));
__device__ __forceinline__ int opq_tid() { int t = threadIdx.x; asm volatile("" : "+v"(t)); return t; }
__device__ __forceinline__ int opq_bid() { int t = blockIdx.x; asm volatile("" : "+s"(t)); return t; }
__device__ __forceinline__ unsigned char* opq_ptr(unsigned char* q) { size_t off = 0; asm volatile("" : "+s"(off)); return q + off; }
constexpr int BM = 256, BK = 64, HALF = 128, HTB = HALF * BK * 2  , STAGE_BYTES = 8 * HTB, NXCD = 8, WGM = 8;

__host__ __device__ __forceinline__ int lds_byte(int r, int c) { const int st = (r >> 4) * 2 + (c >> 5), rr = r & 15, cc = c & 31, ob = rr * 64 + cc * 2; return st * 1024 + (ob ^ (((ob >> 9) & 1) << 5)); }
__host__ __device__ __forceinline__ void stage_rc(int b, int& R, int& C) { const int st = b / 1024, sb = b % 1024, swz = sb ^ (((sb >> 9) & 1) << 5); R = (st >> 1) * 16 + swz / 64; C = (st & 1) * 32 + (swz % 64) / 2; }
__host__ __device__ __forceinline__ int perm32(int rho) { const int n = rho >> 4, i = rho & 15; return 8 * (i >> 2) + 4 * n + (i & 3); }

struct Unit { int pm, pn; };
struct Gemm { const bf16_t* A; const bf16_t* Bt; int M, N, K; };

struct StaticOrder {
    int nM, nN, nwg, G, c;
    __host__ __device__ void init(int M, int N, int G_, int c_) { nM = M / BM; nN = N / BM; nwg = nM * nN; G = G_; c = c_; }
    __host__ __device__ bool next(int i, Unit& u) const {
        const long L = (long)i * G + c; if (L >= nwg) return false;
        int wgid = (int)L; { const int q = nwg / NXCD, r = nwg % NXCD, xcd = wgid % NXCD, off = wgid / NXCD; wgid = (xcd < r ? xcd * (q + 1) : r * (q + 1) + (xcd - r) * q) + off; }
        const int nig = WGM * nN, gid = wgid / nig, fm = gid * WGM, gsz = (nM - fm) < WGM ? (nM - fm) : WGM;
        u.pm = fm + ((wgid % nig) % gsz); u.pn = (wgid % nig) / gsz; return true;
    }
    __device__ __forceinline__ void a_ready(const Unit&) const {}
    __device__ __forceinline__ void done(const Unit&) const {}
};

typedef __bf16 bf16x2v_ __attribute__((ext_vector_type(2))); typedef float f32x2v_ __attribute__((ext_vector_type(2)));
__device__ __forceinline__ unsigned cvt_pk_bf16(float lo, float hi) { const f32x2v_ v = {lo, hi}; const bf16x2v_ b = __builtin_convertvector(v, bf16x2v_); return __builtin_bit_cast(unsigned, b); }
typedef float f32x2 __attribute__((ext_vector_type(2)));
template <class Epi, class Sched, bool ALIGN_EPI = false, bool SP2 = false>
__device__ __forceinline__ void gemm_phase(PG8_LAS unsigned char* lds, const Gemm g, const Sched& S, const Epi& E) {
    const int tid = opq_tid(), wid = __builtin_amdgcn_readfirstlane(tid >> 6), lane = tid & 63, wr = wid >> 2, wc = wid & 3, fr = lane & 15, fq = lane >> 4;
    const int K = g.K, nt = K / BK;
    unsigned voffA[2], voffB[2];
#pragma unroll
    for (int i = 0; i < 2; ++i) { int R, C; stage_rc(tid * 16 + i * 8192, R, C); const int Rb = Epi::PERM ? ((R & ~31) + perm32(R & 31)) : R;
        voffA[i] = (unsigned)(R * K + C) * 2u; voffB[i] = (unsigned)(Rb * K + C) * 2u; }
    const size_t kstep = (size_t)(BK * 2);
    const size_t hstep = (size_t)HALF * K * 2;
    const size_t tstep = 2 * hstep;
    const unsigned ldsw = (unsigned)wid * 1024u;
    const int aoff = lds_byte(wr * 64 + fr, fq * 8), boff = lds_byte(wc * 32 + fr, fq * 8);
#define PG8_SA(b, h) (((b) * 2 + (h)) * HTB)
#define PG8_SB(b, h) ((4 + (b) * 2 + (h)) * HTB)
#define PG8_STAGE(bufoff, gbase, voff) do { _Pragma("unroll") for (int _i = 0; _i < 2; ++_i) \
        __builtin_amdgcn_global_load_lds((const unsigned*)((const char*)(gbase) + (voff)[_i]), (PG8_LAS unsigned*)(lds + (bufoff) + ldsw + _i * 8192), 16, 0, 0); } while (0)
#define PG8_LDA(dst, b, h) do { _Pragma("unroll") for (int m = 0; m < 4; ++m) _Pragma("unroll") for (int k = 0; k < 2; ++k) dst[m][k] = *(const PG8_LAS bf16x8*)(lds + PG8_SA(b, h) + aoff + m * 2048 + k * 1024); } while (0)
#define PG8_LDB(dst, b, h) do { _Pragma("unroll") for (int n = 0; n < 2; ++n) _Pragma("unroll") for (int k = 0; k < 2; ++k) dst[n][k] = *(const PG8_LAS bf16x8*)(lds + PG8_SB(b, h) + boff + n * 2048 + k * 1024); } while (0)
#define PG8_MMA(ai, bj, At, Bt) do { __builtin_amdgcn_s_setprio(1); _Pragma("unroll") for (int m = 0; m < 4; ++m) _Pragma("unroll") for (int n = 0; n < 2; ++n) _Pragma("unroll") for (int k = 0; k < 2; ++k) \
        acc[ai][bj][m][n] = __builtin_amdgcn_mfma_f32_16x16x32_bf16(Bt[n][k], At[m][k], acc[ai][bj][m][n], 0, 0, 0); __builtin_amdgcn_s_setprio(0); } while (0)
#define PG8_WAIT_V(n) asm volatile("s_waitcnt vmcnt(" #n ")" ::: "memory")
#define PG8_WAIT_L(n) asm volatile("s_waitcnt lgkmcnt(" #n ")" ::: "memory")
#define PG8_BAR __builtin_amdgcn_s_barrier()
#define PG8_SCHED __builtin_amdgcn_sched_barrier(0)
    Unit cur, nxt; int ui = 0;
    if (!S.next(0, cur)) return;
    f32x4 acc[2][2][4][2];
#pragma unroll
    for (int a = 0; a < 2; ++a)
#pragma unroll
        for (int b = 0; b < 2; ++b)
#pragma unroll
            for (int m = 0; m < 4; ++m)
#pragma unroll
                for (int n = 0; n < 2; ++n) acc[a][b][m][n] = (f32x4){0.f, 0.f, 0.f, 0.f};
    bf16x8 At[4][2], B0[2][2], B1[2][2];
    const char* cA = (const char*)g.A + (size_t)cur.pm * tstep; const char* cB = (const char*)g.Bt + (size_t)cur.pn * tstep;
    S.a_ready(cur);
    if constexpr (SP2) {
        PG8_STAGE(PG8_SB(0, 0), cB, voffB); PG8_STAGE(PG8_SB(0, 1), cB + hstep, voffB); PG8_STAGE(PG8_SA(0, 0), cA, voffA); PG8_STAGE(PG8_SA(0, 1), cA + hstep, voffA);
        if (wr == 1) PG8_BAR;
        PG8_WAIT_V(2); PG8_BAR;
        PG8_STAGE(PG8_SB(1, 0), cB + kstep, voffB); PG8_STAGE(PG8_SA(1, 0), cA + kstep, voffA); PG8_STAGE(PG8_SB(1, 1), cB + hstep + kstep, voffB);
        PG8_WAIT_V(6); PG8_BAR;
    } else {
        PG8_STAGE(PG8_SB(0, 0), cB, voffB); PG8_STAGE(PG8_SA(0, 0), cA, voffA); PG8_STAGE(PG8_SB(0, 1), cB + hstep, voffB); PG8_STAGE(PG8_SA(0, 1), cA + hstep, voffA);
        if (wr == 1) PG8_BAR;
        PG8_WAIT_V(4); PG8_BAR;
        PG8_STAGE(PG8_SB(1, 0), cB + kstep, voffB); PG8_STAGE(PG8_SA(1, 0), cA + kstep, voffA); PG8_STAGE(PG8_SB(1, 1), cB + hstep + kstep, voffB);
        PG8_WAIT_V(6); PG8_BAR;
    }
    for (;;) {
        const bool has_next = S.next(ui + 1, nxt);
        const char* nA = has_next ? (const char*)g.A + (size_t)nxt.pm * tstep : cA; const char* nB = has_next ? (const char*)g.Bt + (size_t)nxt.pn * tstep : cB;
        for (int t = 0; t < nt; t += 2) {
            const bool last = (t == nt - 2);
            const char* a1 = cA + (size_t)(t + 1) * kstep;
            const char* a2 = last ? nA : cA + (size_t)(t + 2) * kstep; const char* b2 = last ? nB : cB + (size_t)(t + 2) * kstep;
            const char* a3 = a2 + kstep; const char* b3 = b2 + kstep;
            if (last && has_next) S.a_ready(nxt);
            if constexpr (SP2) {
            PG8_LDB(B0, 0, 0); PG8_LDB(B1, 0, 1); PG8_SCHED; PG8_LDA(At, 0, 0); PG8_STAGE(PG8_SA(1, 1), a1 + hstep, voffA);
            PG8_WAIT_V(8); PG8_WAIT_L(0); PG8_BAR; PG8_MMA(0, 0, At, B0); PG8_MMA(0, 1, At, B1); PG8_BAR; PG8_SCHED;
            PG8_LDA(At, 0, 1); PG8_STAGE(PG8_SB(0, 0), b2, voffB); PG8_STAGE(PG8_SB(0, 1), b2 + hstep, voffB); PG8_STAGE(PG8_SA(0, 0), a2, voffA);
            PG8_WAIT_V(8); PG8_WAIT_L(0); PG8_BAR; PG8_MMA(1, 0, At, B0); PG8_MMA(1, 1, At, B1); PG8_BAR; PG8_SCHED;
            PG8_LDB(B0, 1, 0); PG8_LDB(B1, 1, 1); PG8_SCHED; PG8_LDA(At, 1, 0); PG8_STAGE(PG8_SA(0, 1), a2 + hstep, voffA);
            PG8_WAIT_V(8); PG8_WAIT_L(0); PG8_BAR; PG8_MMA(0, 0, At, B0); PG8_MMA(0, 1, At, B1); PG8_BAR; PG8_SCHED;
            PG8_LDA(At, 1, 1); PG8_STAGE(PG8_SB(1, 0), b3, voffB); PG8_STAGE(PG8_SB(1, 1), b3 + hstep, voffB); PG8_STAGE(PG8_SA(1, 0), a3, voffA);
            PG8_WAIT_V(8); PG8_WAIT_L(0); PG8_BAR; PG8_MMA(1, 0, At, B0); PG8_MMA(1, 1, At, B1); PG8_BAR; PG8_SCHED;
            } else {
            PG8_LDB(B0, 0, 0); PG8_SCHED; PG8_LDA(At, 0, 0); PG8_STAGE(PG8_SA(1, 1), a1 + hstep, voffA);
            PG8_WAIT_L(8); PG8_BAR; PG8_WAIT_L(0); PG8_MMA(0, 0, At, B0); PG8_BAR; PG8_SCHED;
            PG8_LDB(B1, 0, 1); PG8_STAGE(PG8_SB(0, 0), b2, voffB);
            PG8_BAR; PG8_WAIT_L(0); PG8_MMA(0, 1, At, B1); PG8_BAR;
            PG8_LDA(At, 0, 1); PG8_STAGE(PG8_SA(0, 0), a2, voffA);
            PG8_BAR; PG8_WAIT_L(0); PG8_MMA(1, 0, At, B0); PG8_BAR; PG8_SCHED;
            PG8_STAGE(PG8_SB(0, 1), b2 + hstep, voffB);
            PG8_WAIT_V(6); PG8_BAR; PG8_MMA(1, 1, At, B1); PG8_BAR;
            PG8_LDB(B0, 1, 0); PG8_SCHED; PG8_LDA(At, 1, 0); PG8_STAGE(PG8_SA(0, 1), a2 + hstep, voffA);
            PG8_WAIT_L(8); PG8_BAR; PG8_WAIT_L(0); PG8_MMA(0, 0, At, B0); PG8_BAR; PG8_SCHED;
            PG8_LDB(B1, 1, 1); PG8_STAGE(PG8_SB(1, 0), b3, voffB);
            PG8_BAR; PG8_WAIT_L(0); PG8_MMA(0, 1, At, B1); PG8_BAR;
            PG8_LDA(At, 1, 1); PG8_STAGE(PG8_SA(1, 0), a3, voffA);
            PG8_BAR; PG8_WAIT_L(0); PG8_MMA(1, 0, At, B0); PG8_BAR; PG8_SCHED;
            PG8_STAGE(PG8_SB(1, 1), b3 + hstep, voffB);
            PG8_WAIT_V(6); PG8_BAR; PG8_MMA(1, 1, At, B1); PG8_BAR;
            }
        }
        if constexpr (ALIGN_EPI) { if (wr == 0) PG8_BAR; }
        if constexpr (!Epi::AFTER_DRAIN) { E(acc, cur, wr, wc, fr, fq); S.done(cur); }
        if (!has_next) break;
#pragma unroll
        for (int a = 0; a < 2; ++a)
#pragma unroll
            for (int b = 0; b < 2; ++b)
#pragma unroll
                for (int m = 0; m < 4; ++m)
#pragma unroll
                    for (int n = 0; n < 2; ++n) acc[a][b][m][n] = (f32x4){0.f, 0.f, 0.f, 0.f};
        cur = nxt; cA = nA; cB = nB; ++ui;
        if constexpr (ALIGN_EPI) { if (wr == 1) PG8_BAR; }
    }
    PG8_WAIT_V(0);
    if constexpr (!ALIGN_EPI) { if (wr == 0) PG8_BAR; }
    PG8_BAR;
    if constexpr (Epi::AFTER_DRAIN) { E.fused(acc, cur, wr, wc, fr, fq, lds, wid, lane); S.done(cur); }
#undef PG8_SA
#undef PG8_SB
#undef PG8_STAGE
#undef PG8_LDA
#undef PG8_LDB
#undef PG8_MMA
#undef PG8_WAIT_V
#undef PG8_WAIT_L
#undef PG8_BAR
#undef PG8_SCHED
}
}

#ifndef ONE_LAUNCH
#define ONE_LAUNCH 1
#endif
using pg8::bf16_t; using pg8::bf16x8; using pg8::f32x4; using pg8::u32x4; using pg8::Unit; using pg8::cvt_pk_bf16;
typedef unsigned u32x2 __attribute__((ext_vector_type(2)));
typedef unsigned short u16x4 __attribute__((ext_vector_type(4)));

constexpr int T = 16384, D = 1024, FF = 2816, NCAT = 6656, HALFCAT = 3328, QW = 3072, KVW = 6144;
constexpr float RMS_EPS = 1e-6f;
constexpr int LDS_BYTES = 147456;
constexpr int NSTEPS = 38;

constexpr size_t WS_BAR = 0;
constexpr size_t WS_WIN = 1u << 20;
constexpr size_t SZ_WIN = (size_t)5632 * 1024 * 2;
constexpr size_t WS_WOUT = WS_WIN + 8 * SZ_WIN;
constexpr size_t SZ_WOUT = (size_t)1024 * 2816 * 2;
constexpr size_t WS_WCAT = WS_WOUT + 8 * SZ_WOUT;
constexpr size_t SZ_WCAT = (size_t)NCAT * 1024 * 2;
constexpr size_t WS_WOR = WS_WCAT + 2 * SZ_WCAT;
constexpr size_t SZ_SQ = (size_t)1024 * 1024 * 2;
constexpr size_t WS_WUP = WS_WOR + 2 * SZ_SQ;
constexpr size_t SZ_UP = (size_t)1024 * 64 * 2;
constexpr size_t WS_WKV = WS_WUP + 8 * SZ_UP;
constexpr size_t WS_WQ = WS_WKV + (size_t)KVW * 1024 * 2;
constexpr size_t SZ_WQ = (size_t)QW * 1024 * 2;
constexpr size_t WS_WOA = WS_WQ + 2 * SZ_WQ;
constexpr size_t WS_XB = WS_WOA + 2 * SZ_SQ;
constexpr size_t SZ_TD2 = (size_t)T * 1024 * 2;
constexpr size_t WS_BIG = WS_XB + SZ_TD2;
constexpr size_t SZ_BIG = (size_t)T * NCAT * 2;
constexpr size_t WS_MIX = WS_BIG + SZ_BIG;
constexpr size_t WS_SS = WS_MIX + 8 * SZ_TD2;
constexpr size_t SZ_SS = (size_t)T * 16 * 4;
constexpr size_t WS_END = WS_SS + 13 * SZ_SS;
constexpr size_t BIG_Y = 0, BIG_YG = (size_t)T * 1024 * 4;
constexpr size_t BIG_Q = 0, BIG_OG = (size_t)T * QW * 2, BIG_LSE = BIG_OG + 3 * SZ_TD2;
static_assert(BIG_LSE + (size_t)3 * T * 16 * 4 <= SZ_BIG, "big");

struct Args { const float* in[30]; float* out; unsigned char* ws; int ph_lo, ph_hi; };

__device__ __forceinline__ float bf2f(unsigned short v) { return __uint_as_float((unsigned)v << 16); }
__device__ __forceinline__ float bflo(unsigned v) { return __uint_as_float(v << 16); }
__device__ __forceinline__ float bfhi(unsigned v) { return __uint_as_float(v & 0xffff0000u); }
__device__ __forceinline__ float row_rs(const float* ssp, int row) { const f32x4* q = (const f32x4*)(ssp + (size_t)row * 16); const f32x4 a = q[0], b = q[1], c = q[2], d = q[3];
    const float s = ((a[0] + a[1]) + (a[2] + a[3])) + ((b[0] + b[1]) + (b[2] + b[3])) + (((c[0] + c[1]) + (c[2] + c[3])) + ((d[0] + d[1]) + (d[2] + d[3]))); return rsqrtf(s * (1.f / 1024.f) + RMS_EPS); }
__device__ __forceinline__ float sigm(float x) { return __builtin_amdgcn_rcpf(1.f + __expf(-x)); }
__device__ __forceinline__ float tanh_fast(float x) { const float e = __expf(2.f * x); return 1.f - 2.f * __builtin_amdgcn_rcpf(e + 1.f); }
#define LAS __attribute__((address_space(3)))
#define XB_TMO      128
#define XB_XCNT(j)  (256  + 64 * (j))
#define XB_XSUB(j)  (1280 + 64 * (j))
#define XB_XGEN(j)  (2304 + 64 * (j))
#define XB_TOP      3328
#define XB_TOPGEN   3392
#define XCD_BAR_WORDS 3456
#define XB_SPIN_CAP (1u << 18)

__device__ __forceinline__ unsigned xb_ld(unsigned* p)              { return __hip_atomic_load(p, __ATOMIC_RELAXED, __HIP_MEMORY_SCOPE_AGENT); }
__device__ __forceinline__ unsigned xb_add(unsigned* p, unsigned v) { return __hip_atomic_fetch_add(p, v, __ATOMIC_RELAXED, __HIP_MEMORY_SCOPE_AGENT); }
__device__ __forceinline__ unsigned xb_xcc_id() { return (unsigned)__builtin_amdgcn_s_getreg((3 << 11) | 20) & 0xFu; }
#define XB_SPIN(cond, bar) do { unsigned _sp = 0; while (cond) { __builtin_amdgcn_s_sleep(1); \
    if ((++_sp & 255u) == 0u) { if (xb_ld(&(bar)[XB_TMO])) break; if (_sp > XB_SPIN_CAP) { atomicAdd(&(bar)[XB_TMO], 1u); break; } } } } while (0)

struct XcdBarrier {
    unsigned* bar; unsigned x;
    volatile LAS unsigned* st;
};

__device__ __forceinline__ XcdBarrier xcd_barrier_post(unsigned* bar, volatile LAS unsigned* st) {
    XcdBarrier b; b.bar = bar; b.x = xb_xcc_id(); b.st = st;
    if (threadIdx.x == 0) (void)xb_add(&bar[XB_XCNT(b.x)], 1u);
    return b;
}
__device__ __forceinline__ void xcd_barrier_complete(unsigned* bar, unsigned x, unsigned& nloc, unsigned& nx) {
    const unsigned G = gridDim.x * gridDim.y * gridDim.z;
    unsigned sum, cnt, mine, sp = 0u;
    for (;;) {
        sum = 0u; cnt = 0u; mine = 0u;
#pragma unroll
        for (unsigned j = 0; j < 16; ++j) { const unsigned c = xb_ld(&bar[XB_XCNT(j)]); sum += c; cnt += (c > 0u) ? 1u : 0u; mine = (j == x) ? c : mine; }
        if (sum == G) break;
        __builtin_amdgcn_s_sleep(1);
        if ((++sp & 255u) == 0u) { if (xb_ld(&bar[XB_TMO])) break; if (sp > XB_SPIN_CAP) { atomicAdd(&bar[XB_TMO], 1u); break; } }
    }
    nloc = mine > 0u ? mine : 1u; nx = cnt > 0u ? cnt : 1u;
}

__device__ __forceinline__ void xcd_barrier(const XcdBarrier& b) {
    asm volatile("s_waitcnt vmcnt(0)" ::: "memory");
    __syncthreads();
    if (threadIdx.x == 0) {
        unsigned* bar = b.bar;
        __builtin_amdgcn_s_waitcnt(0);
        unsigned nloc = b.st[0], nx = b.st[1];
        if (nloc == 0u) { xcd_barrier_complete(bar, b.x, nloc, nx); b.st[0] = nloc; b.st[1] = nx; }
        const unsigned old = xb_add(&bar[XB_XSUB(b.x)], 1u);
        const unsigned gen = old / nloc;
        if (old + 1u == (gen + 1u) * nloc) {
            __builtin_amdgcn_fence(__ATOMIC_RELEASE, "agent");
            asm volatile("s_waitcnt vmcnt(0)" ::: "memory");
            const unsigned og = xb_add(&bar[XB_TOP], 1u);
            const unsigned tg = og / nx;
            if (og + 1u == (tg + 1u) * nx) xb_add(&bar[XB_TOPGEN], 1u);
            else XB_SPIN(xb_ld(&bar[XB_TOPGEN]) == tg, bar);
            __builtin_amdgcn_fence(__ATOMIC_ACQUIRE, "agent");
            xb_add(&bar[XB_XGEN(b.x)], 1u);
            asm volatile("s_waitcnt vmcnt(0)" ::: "memory");
        } else {
            XB_SPIN(xb_ld(&bar[XB_XGEN(b.x)]) == gen, bar);
            __builtin_amdgcn_fence(__ATOMIC_ACQUIRE, "agent");
            asm volatile("s_waitcnt vmcnt(0)" ::: "memory");
        }
    }
    __syncthreads();
}
struct EpiPlain {
    static constexpr bool PERM = true, AFTER_DRAIN = false;
    bf16_t* O; int ldc;
    __device__ __forceinline__ void operator()(const f32x4 (&acc)[2][2][4][2], const Unit& u, int wr, int wc, int fr, int fq) const {
        const int row0 = u.pm * 256 + wr * 64 + fr, col0 = u.pn * 256 + wc * 32 + 8 * fq;
#pragma unroll
        for (int ai = 0; ai < 2; ++ai)
#pragma unroll
            for (int m = 0; m < 4; ++m) { bf16_t* rowp = O + (size_t)(row0 + ai * 128 + m * 16) * ldc + col0;
#pragma unroll
                for (int bj = 0; bj < 2; ++bj) { const f32x4 v0 = acc[ai][bj][m][0], v1 = acc[ai][bj][m][1]; u32x4 w;
                    w.x = cvt_pk_bf16(v0[0], v0[1]); w.y = cvt_pk_bf16(v0[2], v0[3]); w.z = cvt_pk_bf16(v1[0], v1[1]); w.w = cvt_pk_bf16(v1[2], v1[3]);
                    *(u32x4*)(rowp + bj * 128) = w; } }
    }
};
struct EpiSwiglu {
    static constexpr bool PERM = true, AFTER_DRAIN = false;
    bf16_t* O; const float* ss;
    __device__ __forceinline__ void operator()(const f32x4 (&acc)[2][2][4][2], const Unit& u, int wr, int wc, int fr, int fq) const {
        const int row0 = u.pm * 256 + wr * 64 + fr, col0 = u.pn * 128 + wc * 32 + 8 * fq;
#pragma unroll
        for (int ai = 0; ai < 2; ++ai)
#pragma unroll
            for (int m = 0; m < 4; ++m) { const int row = row0 + ai * 128 + m * 16; const float rs = row_rs(ss, row);
                float o[8];
#pragma unroll
                for (int n = 0; n < 2; ++n)
#pragma unroll
                    for (int e = 0; e < 4; ++e) { const float g = acc[ai][0][m][n][e] * rs, up = acc[ai][1][m][n][e] * rs; o[n * 4 + e] = g * sigm(g) * up; }
                u32x4 w; w.x = cvt_pk_bf16(o[0], o[1]); w.y = cvt_pk_bf16(o[2], o[3]); w.z = cvt_pk_bf16(o[4], o[5]); w.w = cvt_pk_bf16(o[6], o[7]);
                *(u32x4*)(O + (size_t)row * FF + col0) = w; }
    }
};
struct EpiResid {
    static constexpr bool PERM = true, AFTER_DRAIN = false;
    const float* xold; float* xnew; bf16_t* xb; float* ssn; float alpha;
    __device__ __forceinline__ void operator()(const f32x4 (&acc)[2][2][4][2], const Unit& u, int wr, int wc, int fr, int fq) const {
        const int row0 = u.pm * 256 + wr * 64 + fr, col0 = u.pn * 256 + wc * 32 + 8 * fq;
#pragma unroll
        for (int ai = 0; ai < 2; ++ai)
#pragma unroll
            for (int m = 0; m < 4; ++m) { const int row = row0 + ai * 128 + m * 16; float s = 0.f;
#pragma unroll
                for (int bj = 0; bj < 2; ++bj) { const size_t off = (size_t)row * D + col0 + bj * 128;
                    const f32x4 xo0 = *(const f32x4*)(xold + off), xo1 = *(const f32x4*)(xold + off + 4);
                    const f32x4 xn0 = xo0 + acc[ai][bj][m][0] * alpha, xn1 = xo1 + acc[ai][bj][m][1] * alpha;
                    *(f32x4*)(xnew + off) = xn0; *(f32x4*)(xnew + off + 4) = xn1;
                    s += ((xn0[0] * xn0[0] + xn0[1] * xn0[1]) + (xn0[2] * xn0[2] + xn0[3] * xn0[3])) + ((xn1[0] * xn1[0] + xn1[1] * xn1[1]) + (xn1[2] * xn1[2] + xn1[3] * xn1[3]));
                    u32x4 w; w.x = cvt_pk_bf16(xn0[0], xn0[1]); w.y = cvt_pk_bf16(xn0[2], xn0[3]); w.z = cvt_pk_bf16(xn1[0], xn1[1]); w.w = cvt_pk_bf16(xn1[2], xn1[3]); *(u32x4*)(xb + off) = w; }
                s += __shfl_xor(s, 16); s += __shfl_xor(s, 32);
                if (fq == 0) ssn[(size_t)row * 16 + u.pn * 4 + wc] = s; }
    }
};
struct EpiHeadNorm {
    static constexpr bool PERM = true, AFTER_DRAIN = false;
    bf16_t* O; int ldc; const float* ss; const float* gain; int nnorm; float scale;
    __device__ __forceinline__ void operator()(const f32x4 (&acc)[2][2][4][2], const Unit& u, int wr, int wc, int fr, int fq) const {
        const int row0 = u.pm * 256 + wr * 64 + fr; const int head = u.pn * 4 + wc; const bool normed = head < nnorm; const int g = (head >> 4) % 3;
        float gn[2][8];
#pragma unroll
        for (int bj = 0; bj < 2; ++bj)
#pragma unroll
            for (int j = 0; j < 8; ++j) gn[bj][j] = normed ? gain[g * 64 + bj * 32 + 8 * fq + j] * scale : 1.f;
#pragma unroll
        for (int ai = 0; ai < 2; ++ai)
#pragma unroll
            for (int m = 0; m < 4; ++m) { const int row = row0 + ai * 128 + m * 16; const float rs = row_rs(ss, row);
                float v[2][8]; float s = 0.f;
#pragma unroll
                for (int bj = 0; bj < 2; ++bj)
#pragma unroll
                    for (int n = 0; n < 2; ++n)
#pragma unroll
                        for (int e = 0; e < 4; ++e) { const float x = acc[ai][bj][m][n][e] * rs; v[bj][n * 4 + e] = x; s += x * x; }
                s += __shfl_xor(s, 16); s += __shfl_xor(s, 32);
                const float inv = normed ? rsqrtf(s * (1.f / 64.f) + RMS_EPS) : 1.f;
#pragma unroll
                for (int bj = 0; bj < 2; ++bj) { float o[8];
#pragma unroll
                    for (int j = 0; j < 8; ++j) o[j] = v[bj][j] * inv * gn[bj][j];
                    u32x4 w; w.x = cvt_pk_bf16(o[0], o[1]); w.y = cvt_pk_bf16(o[2], o[3]); w.z = cvt_pk_bf16(o[4], o[5]); w.w = cvt_pk_bf16(o[6], o[7]);
                    const int hh = head % 48, pg_ = hh >> 4, sh_ = 2 * pg_; const int pos = (row & ((1 << sh_) - 1)) * (T >> sh_) + (row >> sh_);
                    *(u32x4*)(O + (head >= 48 ? (size_t)48 * T * 64 : (size_t)0) + ((size_t)hh * T + pos) * 64 + bj * 32 + 8 * fq) = w; } }
    }
};
struct MatDesc { const float* W; int K, N; bf16_t* dst; int dstK, row_off, maptype; const float* s1; const float* s2; int s2mode; };
__device__ __forceinline__ int map_row(int maptype, int n) {
    if (maptype == 1) { const int u = n % FF, isup = n / FF; return (u >> 7) * 256 + isup * 128 + (u & 127); }
    if (maptype == 2) { const int tile = n >> 8, w = n & 255, head = w >> 6, d = w & 63; return tile * 256 + (d >> 5) * 128 + head * 32 + (d & 31); }
    return n;
}
struct ConvRegs { f32x4 v[2]; float sc[2]; };
__device__ __forceinline__ void conv_load(const MatDesc& md, int tile, ConvRegs& R) {
    const int tid = pg8::opq_tid(); const int ntn = (md.N + 63) >> 6; const int kt = tile / ntn, nt = tile - kt * ntn; const int k0 = kt * 64, n0 = nt * 64;
#pragma unroll
    for (int p = 0; p < 2; ++p) { const int kk = p * 32 + (tid >> 4), nn = (tid & 15) * 4, k = k0 + kk;
        f32x4 v = {0.f, 0.f, 0.f, 0.f}; float sc = 1.f;
        if (k < md.K) { if (n0 + nn < md.N) v = *(const f32x4*)(md.W + (size_t)k * md.N + n0 + nn);
            if (md.s1) sc = md.s1[k]; if (md.s2mode == 1) sc *= md.s2[k]; else if (md.s2mode == 2) sc *= (1.f - md.s2[k]); }
        R.v[p] = v; R.sc[p] = sc; }
}
__device__ __forceinline__ void conv_store(const MatDesc& md, int tile, const ConvRegs& R, float* tl) {
    const int tid = pg8::opq_tid(); const int ntn = (md.N + 63) >> 6; const int kt = tile / ntn, nt = tile - kt * ntn; const int k0 = kt * 64, n0 = nt * 64;
#pragma unroll
    for (int p = 0; p < 2; ++p) { const int kk = p * 32 + (tid >> 4), nn = (tid & 15) * 4; const f32x4 v = R.v[p]; const float sc = R.sc[p];
        tl[kk * 65 + nn + 0] = v[0] * sc; tl[kk * 65 + nn + 1] = v[1] * sc; tl[kk * 65 + nn + 2] = v[2] * sc; tl[kk * 65 + nn + 3] = v[3] * sc; }
    asm volatile("s_waitcnt lgkmcnt(0)" ::: "memory"); __builtin_amdgcn_s_barrier(); asm volatile("" ::: "memory");
    { const int n = tid >> 3, kc = tid & 7;
      if (n0 + n < md.N && k0 + kc * 8 < md.dstK) { float o[8];
#pragma unroll
          for (int j = 0; j < 8; ++j) o[j] = tl[(kc * 8 + j) * 65 + n];
          u32x4 w; w.x = cvt_pk_bf16(o[0], o[1]); w.y = cvt_pk_bf16(o[2], o[3]); w.z = cvt_pk_bf16(o[4], o[5]); w.w = cvt_pk_bf16(o[6], o[7]);
          const int drow = md.row_off + map_row(md.maptype, n0 + n);
          *(u32x4*)(md.dst + (size_t)drow * md.dstK + k0 + kc * 8) = w; } }
    asm volatile("s_waitcnt lgkmcnt(0)" ::: "memory"); __builtin_amdgcn_s_barrier(); asm volatile("" ::: "memory");
}
__device__ __forceinline__ bool get_mat(const Args& a, int mi, MatDesc& md) {
    unsigned char* ws = pg8::opq_ptr(a.ws); md.s1 = nullptr; md.s2 = nullptr; md.s2mode = 0; md.row_off = 0; md.maptype = 0;
    if (mi < 8) { md.W = a.in[2] + (size_t)mi * 1024 * 5632; md.K = 1024; md.N = 5632; md.dst = (bf16_t*)(ws + WS_WIN + mi * SZ_WIN); md.dstK = 1024; md.maptype = 1; md.s1 = a.in[1] + mi * 1024; return true; }
    mi -= 8;
    if (mi < 8) { md.W = a.in[3] + (size_t)mi * 2816 * 1024; md.K = 2816; md.N = 1024; md.dst = (bf16_t*)(ws + WS_WOUT + mi * SZ_WOUT); md.dstK = 2816; return true; }
    mi -= 8;
    if (mi < 38) { const int l = mi / 19, r = mi % 19;
        if (r < 14) { const int part = r / 7, s = r % 7; md.K = 1024; md.dstK = 1024; md.dst = (bf16_t*)(ws + WS_WCAT + l * SZ_WCAT); md.s1 = a.in[4] + l * 1024; md.s2mode = part ? 1 : 2;
            const float* mu = a.in[5] + (size_t)l * 6 * 1024; int off;
            if (s == 0) { md.W = a.in[6] + (size_t)(l * 3 + 0) * 1024 * 1024; md.N = 1024; md.s2 = mu + 0 * 1024; off = 0; }
            else if (s == 1) { md.W = a.in[6] + (size_t)(l * 3 + 1) * 1024 * 1024; md.N = 1024; md.s2 = mu + 2 * 1024; off = 1024; }
            else if (s == 2) { md.W = a.in[6] + (size_t)(l * 3 + 2) * 1024 * 1024; md.N = 1024; md.s2 = mu + 3 * 1024; off = 2048; }
            else if (s == 3) { md.W = a.in[8] + (size_t)l * 1024 * 64; md.N = 64; md.s2 = mu + 1 * 1024; off = 3072; }
            else if (s == 4) { md.W = a.in[11] + (size_t)l * 1024 * 64; md.N = 64; md.s2 = mu + 4 * 1024; off = 3136; }
            else if (s == 5) { if (l == 0) return false; md.W = a.in[14]; md.N = 32; md.s2 = mu + 3 * 1024; off = 3200; }
            else { md.W = a.in[16] + (size_t)l * 1024 * 64; md.N = 64; md.s2 = mu + 5 * 1024; off = 3232; }
            md.row_off = off + part * HALFCAT; return true; }
        if (r == 14) { md.W = a.in[23] + (size_t)l * 1024 * 1024; md.K = 1024; md.N = 1024; md.dst = (bf16_t*)(ws + WS_WOR + l * SZ_SQ); md.dstK = 1024; return true; }
        const int ui = r - 15; md.N = 1024; md.dstK = 64; md.K = 64; md.dst = (bf16_t*)(ws + WS_WUP + (size_t)(l * 4 + ui) * SZ_UP);
        if (ui == 0) md.W = a.in[9] + (size_t)l * 64 * 1024;
        else if (ui == 1) md.W = a.in[12] + (size_t)l * 64 * 1024;
        else if (ui == 2) { if (l == 0) return false; md.W = a.in[15]; md.K = 32; }
        else md.W = a.in[17] + (size_t)l * 64 * 1024;
        return true; }
    mi -= 38;
    if (mi == 0) { md.W = a.in[25]; md.K = 1024; md.N = KVW; md.dst = (bf16_t*)(ws + WS_WKV); md.dstK = 1024; md.maptype = 2; md.s1 = a.in[24]; return true; }
    mi -= 1;
    if (mi < 2) { md.W = a.in[27] + (size_t)mi * 1024 * QW; md.K = 1024; md.N = QW; md.dst = (bf16_t*)(ws + WS_WQ + mi * SZ_WQ); md.dstK = 1024; md.maptype = 2; md.s1 = a.in[4] + (2 + mi) * 1024; return true; }
    mi -= 2;
    md.W = a.in[29] + (size_t)mi * 1024 * 1024; md.K = 1024; md.N = 1024; md.dst = (bf16_t*)(ws + WS_WOA + mi * SZ_SQ); md.dstK = 1024; return true;
}
constexpr int NMAT = 8 + 8 + 38 + 1 + 2 + 2;
__device__ __forceinline__ void zero_rows(bf16_t* base, int row0, int nrows) {
    const int gt = pg8::opq_bid() * 512 + pg8::opq_tid(), NT = gridDim.x * 512;
    for (int i = gt; i < nrows * 128; i += NT) *(u32x4*)(base + (size_t)row0 * 1024 + (size_t)i * 8) = (u32x4){0u, 0u, 0u, 0u};
}
__device__ __forceinline__ int conv_sel(int mi) {
    if (mi < 16) { const int idx = mi & 7; return idx == 0 ? 0 : (idx < 4 ? 1 : 2); }
    if (mi < 54) return (mi - 16) / 19;
    return 2;
}
__device__ __forceinline__ void p0_convert(const Args& a, float* tl, int sel, int vbid, int vG) {
    for (int mi = 0; mi < NMAT; ++mi) { if (conv_sel(mi) != sel) continue; MatDesc md; if (!get_mat(a, mi, md)) continue;
        const int ntiles = ((md.K + 63) >> 6) * ((md.N + 63) >> 6);
        const int G = vG; int tile = (vbid + mi * 37) % G; ConvRegs R[4];
#pragma unroll
        for (int k = 0; k < 4; ++k) if (tile + k * G < ntiles) conv_load(md, tile + k * G, R[k]);
        for (; tile < ntiles; tile += 4 * G) {
#pragma unroll
            for (int k = 0; k < 4; ++k) { const int tk = tile + k * G; if (tk < ntiles) { conv_store(md, tk, R[k], tl); const int tn = tk + 4 * G; if (tn < ntiles) conv_load(md, tn, R[k]); } } } }
}
__device__ __forceinline__ void p0_phase(const Args& a, float* tl) {
    unsigned char* ws = pg8::opq_ptr(a.ws);
    p0_convert(a, tl, 0, pg8::opq_bid(), gridDim.x);
    if (gridDim.x <= 64) { p0_convert(a, tl, 1, pg8::opq_bid(), gridDim.x); p0_convert(a, tl, 2, pg8::opq_bid(), gridDim.x); }
    for (int l = 0; l < 2; ++l) { bf16_t* wc = (bf16_t*)(ws + WS_WCAT + l * SZ_WCAT);
        zero_rows(wc, 3296, 32); zero_rows(wc, HALFCAT + 3296, 32);
        if (l == 0) { zero_rows(wc, 3200, 32); zero_rows(wc, HALFCAT + 3200, 32); } }
    { const int gw = pg8::opq_bid() * 8 + (pg8::opq_tid() >> 6), NGW = gridDim.x * 8, lane = pg8::opq_tid() & 63;
      const float* x = a.in[0]; bf16_t* xb = (bf16_t*)(ws + WS_XB); float* ss = (float*)(ws + WS_SS);
      for (int m = gw; m < T; m += NGW) { float s = 0.f;
#pragma unroll
          for (int j = 0; j < 4; ++j) { const f32x4 v = *(const f32x4*)(x + (size_t)m * D + j * 256 + lane * 4); s += (v[0] * v[0] + v[1] * v[1]) + (v[2] * v[2] + v[3] * v[3]);
              u32x2 w; w.x = cvt_pk_bf16(v[0], v[1]); w.y = cvt_pk_bf16(v[2], v[3]); *(u32x2*)(xb + (size_t)m * D + j * 256 + lane * 4) = w; }
#pragma unroll
          for (int o = 1; o < 64; o <<= 1) s += __shfl_xor(s, o);
          if (lane < 16) ss[(size_t)m * 16 + lane] = lane == 0 ? s : 0.f; }
    }
}
#define MFMA16(a, b, c) __builtin_amdgcn_mfma_f32_16x16x32_bf16((a), (b), (c), 0, 0, 0)
__device__ __forceinline__ void ld8(const bf16_t* p, float (&o)[8]) { const u32x4 w = *(const u32x4*)p; o[0] = bflo(w.x); o[1] = bfhi(w.x); o[2] = bflo(w.y); o[3] = bfhi(w.y); o[4] = bflo(w.z); o[5] = bfhi(w.z); o[6] = bflo(w.w); o[7] = bfhi(w.w); }
__device__ __forceinline__ void ld4(const bf16_t* p, float (&o)[4]) { const u32x2 w = *(const u32x2*)p; o[0] = bflo(w.x); o[1] = bfhi(w.x); o[2] = bflo(w.y); o[3] = bfhi(w.y); }
__device__ __forceinline__ void up8(const u32x4 w, float (&o)[8]) { o[0] = bflo(w.x); o[1] = bfhi(w.x); o[2] = bflo(w.y); o[3] = bfhi(w.y); o[4] = bflo(w.z); o[5] = bfhi(w.z); o[6] = bflo(w.w); o[7] = bfhi(w.w); }
__device__ __forceinline__ void up4(const u32x2 w, float (&o)[4]) { o[0] = bflo(w.x); o[1] = bfhi(w.x); o[2] = bflo(w.y); o[3] = bfhi(w.y); }
__device__ __forceinline__ bf16x8 pack8(const float (&o)[8]) { u32x4 w; w.x = cvt_pk_bf16(o[0], o[1]); w.y = cvt_pk_bf16(o[2], o[3]); w.z = cvt_pk_bf16(o[4], o[5]); w.w = cvt_pk_bf16(o[6], o[7]); return __builtin_bit_cast(bf16x8, w); }
__device__ __forceinline__ void st4(bf16_t* p, float a, float b, float c, float d) { u32x2 w; w.x = cvt_pk_bf16(a, b); w.y = cvt_pk_bf16(c, d); *(u32x2*)p = w; }

__device__ __forceinline__ void f1_phase(const Args& a, int l, unsigned char* lds) {
    unsigned char* ws = pg8::opq_ptr(a.ws); const int lane = pg8::opq_tid() & 63, wave = pg8::opq_tid() >> 6; const int gw = pg8::opq_bid() * 8 + wave, NGW = gridDim.x * 8;
    const int tok = lane & 15, q = lane >> 4;
    const bf16_t* P = (const bf16_t*)(ws + WS_BIG); const float* ss = (const float*)(ws + WS_SS) + (size_t)(3 * l + 1) * T * 16;
    const bf16_t* WUP = (const bf16_t*)(ws + WS_WUP + (size_t)l * 4 * SZ_UP);
    bf16_t* oR = (bf16_t*)(ws + WS_MIX); bf16_t* oLD = oR + (size_t)T * D; bf16_t* oK = oLD + (size_t)T * D; bf16_t* oA = oK + (size_t)T * D; bf16_t* oB = oA + (size_t)T * D;
    bf16_t* oV0 = oB + (size_t)T * D; bf16_t* oV1 = oV0 + (size_t)T * D; bf16_t* oG = oV1 + (size_t)T * D;
    bf16_t* oV = l ? oV1 : oV0;
    const float* w0 = a.in[7] + l * D; const float* a0 = a.in[10] + l * D; const float* v0 = a.in[13]; const float* kkp = a.in[18] + l * D; const float* kap = a.in[19] + l * D;
    const int bidf = pg8::opq_bid(); const int h = bidf & 15, grp = bidf >> 4, ngrp = gridDim.x >> 4; (void)gw; (void)NGW;
    bf16_t* wl = (bf16_t*)lds; float* pl = (float*)(lds + 4 * 64 * 72 * 2);
    { const int tidf = pg8::opq_tid();
      for (int i = tidf; i < 4 * 64 * 8; i += 512) { const int m = i >> 9, r = (i >> 3) & 63, c8 = (i & 7) * 8;
          u32x4 v = {0u, 0u, 0u, 0u}; if (m != 2 || l) v = *(const u32x4*)(WUP + (size_t)m * 1024 * 64 + (size_t)(h * 64 + r) * 64 + c8);
          *(u32x4*)(wl + (m * 64 + r) * 72 + c8) = v; }
      if (tidf < 320) { const int m = tidf >> 6, c = tidf & 63; float v = 0.f;
          if (m == 0) v = w0[h * 64 + c]; else if (m == 1) v = a0[h * 64 + c]; else if (m == 2) { if (l) v = v0[h * 64 + c]; } else if (m == 3) v = kkp[h * 64 + c]; else v = kap[h * 64 + c];
          pl[m * 64 + c] = v; } }
    __syncthreads();
    bf16_t* stg = (bf16_t*)(lds + 38400 + wave * 12288);
    for (int tt = grp * 8 + wave; tt < T / 16 && grp < ngrp; tt += ngrp * 8) {
        const int t = tt * 16 + tok;
        const float rs_c = row_rs(ss, t); const float rs_p = t > 0 ? row_rs(ss, t > 0 ? t - 1 : 0) : 0.f;
        const bf16_t* Pc = P + (size_t)t * NCAT; const bf16_t* Pp = P + (size_t)(t > 0 ? t - 1 : 0) * NCAT + HALFCAT;
        u32x4 Lw[2][2], La[2][2], Lg[2][2], Lv[2]; u32x2 Lr[4][2], Lk[4][2], Lvv[4][2], Lvf[4];
#pragma unroll
        for (int ks = 0; ks < 2; ++ks) { const int ko = ks * 32 + q * 8;
            Lw[ks][0] = *(const u32x4*)(Pc + 3072 + ko); Lw[ks][1] = *(const u32x4*)(Pp + 3072 + ko); La[ks][0] = *(const u32x4*)(Pc + 3136 + ko); La[ks][1] = *(const u32x4*)(Pp + 3136 + ko);
            Lg[ks][0] = *(const u32x4*)(Pc + 3232 + ko); Lg[ks][1] = *(const u32x4*)(Pp + 3232 + ko); }
        Lv[0] = *(const u32x4*)(Pc + 3200 + q * 8); Lv[1] = *(const u32x4*)(Pp + 3200 + q * 8);
        { const int srow = lane >> 3, ch8 = (lane & 7) * 8; const int t0 = tt * 16; u32x4 sv[6][2];
#pragma unroll
          for (int a6 = 0; a6 < 6; ++a6)
#pragma unroll
              for (int hf = 0; hf < 2; ++hf) { int tr = t0 + 8 * hf + srow - (a6 & 1); tr = tr < 0 ? 0 : tr;
                  sv[a6][hf] = *(const u32x4*)(P + (size_t)tr * NCAT + (a6 & 1) * HALFCAT + (a6 >> 1) * 1024 + h * 64 + ch8); }
#pragma unroll
          for (int a6 = 0; a6 < 6; ++a6)
#pragma unroll
              for (int hf = 0; hf < 2; ++hf) *(u32x4*)(stg + (a6 * 16 + 8 * hf + srow) * 64 + ch8) = sv[a6][hf];
          asm volatile("s_waitcnt lgkmcnt(0)" ::: "memory"); }
#pragma unroll
        for (int nt = 0; nt < 4; ++nt) { const int c0 = h * 64 + nt * 16 + 4 * q; const int cl4 = nt * 16 + 4 * q;
            Lr[nt][0] = *(const u32x2*)(stg + (0 * 16 + tok) * 64 + cl4); Lr[nt][1] = *(const u32x2*)(stg + (1 * 16 + tok) * 64 + cl4);
            Lk[nt][0] = *(const u32x2*)(stg + (2 * 16 + tok) * 64 + cl4); Lk[nt][1] = *(const u32x2*)(stg + (3 * 16 + tok) * 64 + cl4);
            Lvv[nt][0] = *(const u32x2*)(stg + (4 * 16 + tok) * 64 + cl4); Lvv[nt][1] = *(const u32x2*)(stg + (5 * 16 + tok) * 64 + cl4);
            Lvf[nt] = (u32x2){0u, 0u}; if (l) Lvf[nt] = *(const u32x2*)(oV0 + (size_t)t * D + c0); }
        asm volatile("s_waitcnt lgkmcnt(0)" ::: "memory");
        bf16x8 actW[2], actA[2], actG[2], actV;
#pragma unroll
        for (int ks = 0; ks < 2; ++ks) { float c[8], p[8], x[8];
            up8(Lw[ks][0], c); up8(Lw[ks][1], p);
#pragma unroll
            for (int j = 0; j < 8; ++j) x[j] = tanh_fast(rs_c * c[j] + rs_p * p[j]);
            actW[ks] = pack8(x);
            up8(La[ks][0], c); up8(La[ks][1], p);
#pragma unroll
            for (int j = 0; j < 8; ++j) x[j] = rs_c * c[j] + rs_p * p[j];
            actA[ks] = pack8(x);
            up8(Lg[ks][0], c); up8(Lg[ks][1], p);
#pragma unroll
            for (int j = 0; j < 8; ++j) x[j] = sigm(rs_c * c[j] + rs_p * p[j]);
            actG[ks] = pack8(x); }
        { float c[8], p[8], x[8]; up8(Lv[0], c); up8(Lv[1], p);
#pragma unroll
          for (int j = 0; j < 8; ++j) x[j] = rs_c * c[j] + rs_p * p[j];
          actV = pack8(x); }
        f32x4 Dw[4], Da[4], Dv[4], Dg[4];
#pragma unroll
        for (int nt = 0; nt < 4; ++nt) { const f32x4 z = {0.f, 0.f, 0.f, 0.f}; Dw[nt] = z; Da[nt] = z; Dv[nt] = z; Dg[nt] = z;
            const int wo = (nt * 16 + tok) * 72 + q * 8;
#pragma unroll
            for (int ks = 0; ks < 2; ++ks) {
                Dw[nt] = MFMA16(*(const bf16x8*)(wl + wo + ks * 32), actW[ks], Dw[nt]);
                Da[nt] = MFMA16(*(const bf16x8*)(wl + 64 * 72 + wo + ks * 32), actA[ks], Da[nt]);
                Dg[nt] = MFMA16(*(const bf16x8*)(wl + 3 * 64 * 72 + wo + ks * 32), actG[ks], Dg[nt]); }
            if (l) Dv[nt] = MFMA16(*(const bf16x8*)(wl + 2 * 64 * 72 + wo), actV, Dv[nt]);
            __builtin_amdgcn_sched_barrier(0); }
        float kkv[4][4], asg[4][4]; float ssq = 0.f;
#pragma unroll
        for (int nt = 0; nt < 4; ++nt) { const int c0 = h * 64 + nt * 16 + 4 * q; const size_t off = (size_t)t * D + c0;
            float rc[4], rp[4], kc[4], kp[4], vc[4], vp[4];
            up4(Lr[nt][0], rc); up4(Lr[nt][1], rp); up4(Lk[nt][0], kc); up4(Lk[nt][1], kp); up4(Lvv[nt][0], vc); up4(Lvv[nt][1], vp);
            const int cl = nt * 16 + 4 * q; const f32x4 w0v = *(const f32x4*)(pl + cl), a0v = *(const f32x4*)(pl + 64 + cl), kkw = *(const f32x4*)(pl + 192 + cl), kaw = *(const f32x4*)(pl + 256 + cl);
            float vf[4] = {0.f, 0.f, 0.f, 0.f}; f32x4 v0v = {0.f, 0.f, 0.f, 0.f};
            if (l) { up4(Lvf[nt], vf); v0v = *(const f32x4*)(pl + 128 + cl); }
            float ro[4], ldo[4], ko[4], vo[4], go[4];
#pragma unroll
            for (int e = 0; e < 4; ++e) {
                const float rr = rs_c * rc[e] + rs_p * rp[e], kx = rs_c * kc[e] + rs_p * kp[e]; float vx = rs_c * vc[e] + rs_p * vp[e];
                const float wl = w0v[e] + Dw[nt][e]; const float xx = -wl; const float sp = fmaxf(xx, 0.f) + __logf(1.f + __expf(-fabsf(xx)));
                ldo[e] = -__expf(-sp - 0.5f);
                const float as = sigm(a0v[e] + Da[nt][e]);
                if (l) vx = vx + (vf[e] - vx) * sigm(v0v[e] + Dv[nt][e]);
                const float kk = kx * kkw[e]; ssq += kk * kk; kkv[nt][e] = kk; asg[nt][e] = as;
                ro[e] = rr; ko[e] = kx * (1.f + (as - 1.f) * kaw[e]); vo[e] = vx; go[e] = Dg[nt][e]; }
            { const int so = tok * 64 + nt * 16 + 4 * q; (void)off;
              st4(stg + 0 * 1024 + so, ro[0], ro[1], ro[2], ro[3]); st4(stg + 1 * 1024 + so, ldo[0], ldo[1], ldo[2], ldo[3]); st4(stg + 2 * 1024 + so, ko[0], ko[1], ko[2], ko[3]);
              st4(stg + 3 * 1024 + so, vo[0], vo[1], vo[2], vo[3]); st4(stg + 4 * 1024 + so, go[0], go[1], go[2], go[3]); } }
        asm volatile("s_waitcnt lgkmcnt(0)" ::: "memory");
        { const int srow = lane >> 3, ch8 = (lane & 7) * 8;
#define F1_OUT(ptr, sl) do { _Pragma("unroll") for (int hf = 0; hf < 2; ++hf) *(u32x4*)((ptr) + (size_t)(tt * 16 + 8 * hf + srow) * D + h * 64 + ch8) = *(const u32x4*)(stg + (sl) * 1024 + (8 * hf + srow) * 64 + ch8); } while (0)
          F1_OUT(oR, 0); F1_OUT(oLD, 1); F1_OUT(oK, 2); F1_OUT(oV, 3); F1_OUT(oG, 4); }
        asm volatile("s_waitcnt lgkmcnt(0)" ::: "memory");
        ssq += __shfl_xor(ssq, 16); ssq += __shfl_xor(ssq, 32);
        const float inv = 1.f / fmaxf(sqrtf(ssq), 1e-12f);
#pragma unroll
        for (int nt = 0; nt < 4; ++nt) { const size_t off = (size_t)t * D + h * 64 + nt * 16 + 4 * q;
            float av[4], bv[4];
#pragma unroll
            for (int e = 0; e < 4; ++e) { const float kn = kkv[nt][e] * inv; av[e] = -kn; bv[e] = kn * asg[nt][e]; }
            { const int so = tok * 64 + nt * 16 + 4 * q; (void)off; st4(stg + so, av[0], av[1], av[2], av[3]); st4(stg + 1024 + so, bv[0], bv[1], bv[2], bv[3]); } }
        asm volatile("s_waitcnt lgkmcnt(0)" ::: "memory");
        { const int srow = lane >> 3, ch8 = (lane & 7) * 8; F1_OUT(oA, 0); F1_OUT(oB, 1); }
        asm volatile("s_waitcnt lgkmcnt(0)" ::: "memory");
    }
}

__device__ __forceinline__ void rseq_phase(const Args& a, int l, float* lds) {
    if (pg8::opq_bid() >= 16) return;
    unsigned char* ws = pg8::opq_ptr(a.ws); const int tid = pg8::opq_tid(), h = pg8::opq_bid();
    const bf16_t* base = (const bf16_t*)(ws + WS_MIX);
    float* Y = (float*)(ws + WS_BIG + BIG_Y);
    const int row = tid >> 2, cgp = tid & 3;
    float s[16];
#pragma unroll
    for (int j = 0; j < 16; ++j) s[j] = 0.f;
    for (int c0 = 0; c0 < T; c0 += 16) {
        __syncthreads();
#pragma unroll
        for (int i = 0; i < 12; ++i) { const int idx = tid + i * 512; const int arr = idx >> 10, rem = idx & 1023, st = rem >> 6, j = rem & 63;
            const int ga = arr == 5 ? (5 + l) : arr;
            float v = bf2f(base[(size_t)ga * T * D + (size_t)(c0 + st) * D + h * 64 + j]); if (arr == 1) v = __expf(v);
            lds[idx] = v; }
        __syncthreads();
        if (tid < 256) {
#pragma unroll 4
            for (int st = 0; st < 16; ++st) {
                const float* pR = lds + 0 * 1024 + st * 64 + cgp * 16; const float* pD = lds + 1 * 1024 + st * 64 + cgp * 16; const float* pK = lds + 2 * 1024 + st * 64 + cgp * 16;
                const float* pA = lds + 3 * 1024 + st * 64 + cgp * 16; const float* pB = lds + 4 * 1024 + st * 64 + cgp * 16;
                const float vv = lds[5 * 1024 + st * 64 + row];
                float sa = 0.f;
#pragma unroll
                for (int j = 0; j < 16; ++j) sa += s[j] * pA[j];
                sa += __shfl_xor(sa, 1); sa += __shfl_xor(sa, 2);
                float y = 0.f;
#pragma unroll
                for (int j = 0; j < 16; ++j) { s[j] = s[j] * pD[j] + sa * pB[j] + vv * pK[j]; y += s[j] * pR[j]; }
                y += __shfl_xor(y, 1); y += __shfl_xor(y, 2);
                if (cgp == 0) Y[(size_t)(c0 + st) * D + h * 64 + row] = y;
            }
        }
    }
}

__device__ __forceinline__ void f2_phase(const Args& a, int l) {
    unsigned char* ws = pg8::opq_ptr(a.ws); const int lane = pg8::opq_tid() & 63; const int gw = pg8::opq_bid() * 8 + (pg8::opq_tid() >> 6), NGW = gridDim.x * 8;
    const bf16_t* base = (const bf16_t*)(ws + WS_MIX); const float* Y = (const float*)(ws + WS_BIG + BIG_Y); bf16_t* YG = (bf16_t*)(ws + WS_BIG + BIG_YG);
    const bf16_t* pR = base; const bf16_t* pK = base + (size_t)2 * T * D; const bf16_t* pV = base + (size_t)(5 + l) * T * D; const bf16_t* pG = base + (size_t)7 * T * D;
    const float* lnw = a.in[21] + l * D; const float* lnb = a.in[22] + l * D; const float* rk = a.in[20] + l * D;
    const int c0 = lane * 16;
    for (int t = gw; t < T; t += NGW) { const size_t off = (size_t)t * D + c0;
        float y[16], r[16], k[16], v[16], g[16];
#pragma unroll
        for (int j = 0; j < 4; ++j) { const f32x4 yy = *(const f32x4*)(Y + off + j * 4); y[j * 4] = yy[0]; y[j * 4 + 1] = yy[1]; y[j * 4 + 2] = yy[2]; y[j * 4 + 3] = yy[3]; }
        { float tmp[8]; ld8(pR + off, tmp);
#pragma unroll
          for (int j = 0; j < 8; ++j) r[j] = tmp[j];
          ld8(pR + off + 8, tmp);
#pragma unroll
          for (int j = 0; j < 8; ++j) r[8 + j] = tmp[j];
          ld8(pK + off, tmp);
#pragma unroll
          for (int j = 0; j < 8; ++j) k[j] = tmp[j];
          ld8(pK + off + 8, tmp);
#pragma unroll
          for (int j = 0; j < 8; ++j) k[8 + j] = tmp[j];
          ld8(pV + off, tmp);
#pragma unroll
          for (int j = 0; j < 8; ++j) v[j] = tmp[j];
          ld8(pV + off + 8, tmp);
#pragma unroll
          for (int j = 0; j < 8; ++j) v[8 + j] = tmp[j];
          ld8(pG + off, tmp);
#pragma unroll
          for (int j = 0; j < 8; ++j) g[j] = tmp[j];
          ld8(pG + off + 8, tmp);
#pragma unroll
          for (int j = 0; j < 8; ++j) g[8 + j] = tmp[j]; }
        float sm = 0.f, bs = 0.f;
#pragma unroll
        for (int j = 0; j < 16; ++j) { sm += y[j]; bs += r[j] * k[j] * rk[c0 + j]; }
        sm += __shfl_xor(sm, 1); sm += __shfl_xor(sm, 2); bs += __shfl_xor(bs, 1); bs += __shfl_xor(bs, 2);
        const float mean = sm * (1.f / 64.f); float vr = 0.f;
#pragma unroll
        for (int j = 0; j < 16; ++j) { const float d = y[j] - mean; vr += d * d; }
        vr += __shfl_xor(vr, 1); vr += __shfl_xor(vr, 2);
        const float rstd = rsqrtf(vr * (1.f / 64.f) + 64e-5f);
        float o[16];
#pragma unroll
        for (int j = 0; j < 16; ++j) o[j] = ((y[j] - mean) * rstd * lnw[c0 + j] + lnb[c0 + j] + bs * v[j]) * g[j];
        u32x4 w0, w1; w0.x = cvt_pk_bf16(o[0], o[1]); w0.y = cvt_pk_bf16(o[2], o[3]); w0.z = cvt_pk_bf16(o[4], o[5]); w0.w = cvt_pk_bf16(o[6], o[7]);
        w1.x = cvt_pk_bf16(o[8], o[9]); w1.y = cvt_pk_bf16(o[10], o[11]); w1.z = cvt_pk_bf16(o[12], o[13]); w1.w = cvt_pk_bf16(o[14], o[15]);
        *(u32x4*)(YG + off) = w0; *(u32x4*)(YG + off + 8) = w1; }
}
constexpr size_t BIG_RH = 0, BIG_Y0 = (size_t)4096 * 8192, BIG_MM = BIG_Y0 + (size_t)4096 * 16384, BIG_NT = BIG_MM + (size_t)4096 * 8192;
static_assert(BIG_NT + (size_t)4096 * 16384 <= SZ_BIG, "big2");
__device__ __forceinline__ int nat_frag(int rtile, int ks, int lane) { return ((rtile * 2 + ks) * 64 + lane) * 8; }
__device__ __forceinline__ int nat_st4(int rtile, int lq, int c0) { return ((rtile * 2 + (c0 >> 5)) * 64 + ((c0 >> 3) & 3) * 16 + lq) * 8 + (c0 & 7); }
constexpr int R4_RHS = 0, R4_AAB = 34816, R4_PL = 51200, R4_SEG = 51456, R4_BF = 53504, R4_ASZ = 9216, R4_LD = 72, XLD = 68;
__device__ __forceinline__ bf16x8 ldsfrag(const bf16_t* arr, int row, int koff) { return *(const bf16x8*)(arr + row * R4_LD + koff); }
__device__ __forceinline__ void r4_phase(const Args& a, int l, unsigned char* lds) {
    unsigned char* ws = pg8::opq_ptr(a.ws); const int tid = pg8::opq_tid(), lane = tid & 63, w = tid >> 6, lq = lane & 15, q = lane >> 4;
    const bf16_t* base = (const bf16_t*)(ws + WS_MIX);
    float* RHS = (float*)(lds + R4_RHS); float* AAB = (float*)(lds + R4_AAB); float* PL = (float*)(lds + R4_PL); float* SEG = (float*)(lds + R4_SEG);
    bf16_t* Arow = (bf16_t*)(lds + R4_BF); bf16_t* Brow = Arow + R4_ASZ / 2; bf16_t* Krow = Brow + R4_ASZ / 2; bf16_t* Rrow = Krow + R4_ASZ / 2;
    bf16_t* BT = Rrow + R4_ASZ / 2; bf16_t* KT = BT + R4_ASZ / 2; bf16_t* VT = KT + R4_ASZ / 2; bf16_t* AAK = VT + R4_ASZ / 2; bf16_t* ARB = AAK + R4_ASZ / 2; bf16_t* ARK = ARB + R4_ASZ / 2;
    bf16_t* AhT = Arow; bf16_t* W1T = Krow;
    const int bid = pg8::opq_bid();
    u32x4 pre[6]; bf16_t* raw = (bf16_t*)lds;
#define R4_PREFETCH(uu) do { const int h_ = (uu) & 15, c_ = (uu) >> 4; _Pragma("unroll") for (int k_ = 0; k_ < 6; ++k_) { const int idx_ = tid + 512 * k_; const int arr_ = idx_ >> 9, t_ = (idx_ >> 3) & 63, j8_ = (idx_ & 7) * 8; \
        pre[k_] = *(const u32x4*)(base + (size_t)(arr_ == 5 ? 5 + l : arr_) * T * D + (size_t)(c_ * 64 + t_) * D + h_ * 64 + j8_); } } while (0)
    for (int u = bid; u < 4096; u += gridDim.x) {
        const int h = u & 15, c = u >> 4;
        R4_PREFETCH(u);
        __syncthreads();
#pragma unroll
        for (int k_ = 0; k_ < 6; ++k_) { const int idx_ = tid + 512 * k_; *(u32x4*)(raw + (size_t)idx_ * 8) = pre[k_]; }
        __syncthreads();
#ifndef NO_S1
        { const int j = lane, seg = w; const size_t g0 = (size_t)(c * 64 + seg * 8) * D + h * 64 + j;
          float r[8], ld[8], k[8], v[8], aa[8], bb[8];
#pragma unroll
          for (int i = 0; i < 8; ++i) { const int o = (seg * 8 + i) * 64 + j; r[i] = bf2f(raw[o]); ld[i] = bf2f(raw[4096 + o]); k[i] = bf2f(raw[2 * 4096 + o]);
              aa[i] = bf2f(raw[3 * 4096 + o]); bb[i] = bf2f(raw[4 * 4096 + o]); v[i] = bf2f(raw[5 * 4096 + o]); }
          (void)g0;
          float cum[8]; float run = 0.f;
#pragma unroll
          for (int i = 0; i < 8; ++i) { run += ld[i]; cum[i] = run; }
          SEG[seg * 64 + j] = run;
          __syncthreads();
          float off = 0.f;
#pragma unroll
          for (int s = 0; s < 8; ++s) off += (s < seg) ? SEG[s * 64 + j] : 0.f;
          float at[8], rt[8], bt[8], kt[8];
#pragma unroll
          for (int i = 0; i < 8; ++i) { const float cm = cum[i] + off; const float ep = __expf(cm), em = __expf(-cm), epp = __expf(cm - ld[i]);
              at[i] = aa[i] * epp; rt[i] = r[i] * ep; bt[i] = bb[i] * em; kt[i] = k[i] * em;
              const int t = seg * 8 + i;
              Arow[t * R4_LD + j] = (bf16_t)(cvt_pk_bf16(at[i], 0.f) & 0xffffu); Brow[t * R4_LD + j] = (bf16_t)(cvt_pk_bf16(bt[i], 0.f) & 0xffffu);
              Krow[t * R4_LD + j] = (bf16_t)(cvt_pk_bf16(kt[i], 0.f) & 0xffffu); Rrow[t * R4_LD + j] = (bf16_t)(cvt_pk_bf16(rt[i], 0.f) & 0xffffu);
              if (i == 7 && seg == 7) PL[j] = ep; }
          *(f32x4*)(RHS + j * XLD + seg * 8) = (f32x4){at[0], at[1], at[2], at[3]}; *(f32x4*)(RHS + j * XLD + seg * 8 + 4) = (f32x4){at[4], at[5], at[6], at[7]};
          *(bf16x8*)(BT + j * R4_LD + seg * 8) = pack8(bt); *(bf16x8*)(KT + j * R4_LD + seg * 8) = pack8(kt); *(bf16x8*)(VT + j * R4_LD + seg * 8) = pack8(v); }
#endif
        __syncthreads();
        { const int tt = w >> 1; const int t = 16 * tt + lq;
          bf16x8 fa[2], fr[2];
#pragma unroll
          for (int ks = 0; ks < 2; ++ks) { fa[ks] = ldsfrag(Arow, t, ks * 32 + 8 * q); fr[ks] = ldsfrag(Rrow, t, ks * 32 + 8 * q); }
#pragma unroll
          for (int k2 = 0; k2 < 2; ++k2) { const int st = 2 * (w & 1) + k2; const int s0 = 16 * st + 4 * q;
              f32x4 dab = {0.f, 0.f, 0.f, 0.f}, dak = dab, drb = dab, drk = dab;
              if (st <= tt) {
#pragma unroll
                  for (int ks = 0; ks < 2; ++ks) { const bf16x8 fb = ldsfrag(Brow, 16 * st + lq, ks * 32 + 8 * q), fk = ldsfrag(Krow, 16 * st + lq, ks * 32 + 8 * q);
                      dab = MFMA16(fb, fa[ks], dab); dak = MFMA16(fk, fa[ks], dak); drb = MFMA16(fb, fr[ks], drb); drk = MFMA16(fk, fr[ks], drk); } }
#pragma unroll
              for (int e = 0; e < 4; ++e) { const int s = s0 + e; if (!(s < t)) { dab[e] = 0.f; dak[e] = 0.f; } if (!(s <= t)) { drb[e] = 0.f; drk[e] = 0.f; } }
              *(f32x4*)(AAB + t * 64 + s0) = dab;
              st4(AAK + t * R4_LD + s0, dak[0], dak[1], dak[2], dak[3]); st4(ARB + t * R4_LD + s0, drb[0], drb[1], drb[2], drb[3]); st4(ARK + t * R4_LD + s0, drk[0], drk[1], drk[2], drk[3]); } }
        __syncthreads();
        { bf16_t* AOFF = Brow; const int t = tid >> 3, s8 = (tid & 7) * 8; const f32x4 a0 = *(const f32x4*)(AAB + t * 64 + s8), a1 = *(const f32x4*)(AAB + t * 64 + s8 + 4);
          const bool keep = (s8 >> 4) < (t >> 4); const float o[8] = {keep ? a0[0] : 0.f, keep ? a0[1] : 0.f, keep ? a0[2] : 0.f, keep ? a0[3] : 0.f, keep ? a1[0] : 0.f, keep ? a1[1] : 0.f, keep ? a1[2] : 0.f, keep ? a1[3] : 0.f};
          *(bf16x8*)(AOFF + t * R4_LD + s8) = pack8(o); }
        { const int tt = w >> 1; const int t = 16 * tt + lq;
          bf16x8 fb[2];
#pragma unroll
          for (int ks = 0; ks < 2; ++ks) fb[ks] = ldsfrag(AAK, t, ks * 32 + 8 * q);
#pragma unroll
          for (int k2 = 0; k2 < 2; ++k2) { const int it = 2 * (w & 1) + k2; f32x4 d = {0.f, 0.f, 0.f, 0.f};
#pragma unroll
              for (int ks = 0; ks < 2; ++ks) d = MFMA16(ldsfrag(VT, 16 * it + lq, ks * 32 + 8 * q), fb[ks], d);
#pragma unroll
              for (int e = 0; e < 4; ++e) RHS[(64 + 16 * it + 4 * q + e) * XLD + t] = d[e]; } }
        __syncthreads();
        { bf16_t* AOFF = Brow;
          for (int i = tid; i < 2 * 64 * R4_LD / 2; i += 512) { const int arr = i / (64 * R4_LD / 2), r = i - arr * (64 * R4_LD / 2); ((unsigned*)(arr ? W1T : AhT))[r] = 0u; }
          __syncthreads();
#pragma unroll
          for (int b = 0; b < 4; ++b) {
              if (b > 0) { const bf16_t* xt = (w < 4 ? AhT : W1T); const int crow = 16 * (w & 3) + lq; f32x4 d = {0.f, 0.f, 0.f, 0.f};
#pragma unroll
                  for (int ks = 0; ks < (b + 1) / 2; ++ks) d = MFMA16(ldsfrag(xt, crow, ks * 32 + 8 * q), ldsfrag(AOFF, 16 * b + lq, ks * 32 + 8 * q), d);
                  const int t = 16 * b + lq; const int c0 = 16 * w + 4 * q;
#pragma unroll
                  for (int e = 0; e < 4; ++e) RHS[(c0 + e) * XLD + t] += d[e];
                  __syncthreads(); }
              if (tid < 128) { float* xr = RHS + tid * XLD + 16 * b; float x[16];
#pragma unroll
                  for (int k = 0; k < 4; ++k) { const f32x4 v = *(const f32x4*)(xr + 4 * k); x[4 * k] = v[0]; x[4 * k + 1] = v[1]; x[4 * k + 2] = v[2]; x[4 * k + 3] = v[3]; }
#pragma unroll
                  for (int t = 1; t < 16; ++t) { const float* ar = AAB + (16 * b + t) * 64 + 16 * b; float acc = x[t];
#pragma unroll
                      for (int k = 0; k < (t + 3) / 4; ++k) { const f32x4 av = *(const f32x4*)(ar + 4 * k);
#pragma unroll
                          for (int e = 0; e < 4; ++e) if (4 * k + e < t) acc += av[e] * x[4 * k + e]; }
                      x[t] = acc; }
#pragma unroll
                  for (int k = 0; k < 4; ++k) *(f32x4*)(xr + 4 * k) = (f32x4){x[4 * k], x[4 * k + 1], x[4 * k + 2], x[4 * k + 3]};
                  bf16_t* dst = (tid < 64 ? AhT : W1T) + (tid & 63) * R4_LD + 16 * b;
                  { const float o0[8] = {x[0], x[1], x[2], x[3], x[4], x[5], x[6], x[7]}; const float o1[8] = {x[8], x[9], x[10], x[11], x[12], x[13], x[14], x[15]};
                    *(bf16x8*)dst = pack8(o0); *(bf16x8*)(dst + 8) = pack8(o1); } }
              if (b < 3) __syncthreads();
          } }
        __syncthreads();
#ifndef NO_S5
        { const int rt_ = w >> 1; const int row = 16 * rt_ + lq;
          unsigned char* bigb = ws + WS_BIG;
          bf16_t* gRH = (bf16_t*)(bigb + BIG_RH) + (size_t)u * 4096; float* gY0 = (float*)(bigb + BIG_Y0) + (size_t)u * 4096;
          bf16_t* gMM = (bf16_t*)(bigb + BIG_MM) + (size_t)(h * 256 + c) * 4096; float* gNT = (float*)(bigb + BIG_NT) + (size_t)(h * 256 + c) * 4096;
          bf16x8 f_arb[2], f_ark[2], f_bt[2], f_w1[2], f_vt[2];
#pragma unroll
          for (int ks = 0; ks < 2; ++ks) { const int ko = ks * 32 + 8 * q; f_arb[ks] = ldsfrag(ARB, row, ko); f_ark[ks] = ldsfrag(ARK, row, ko); f_bt[ks] = ldsfrag(BT, row, ko); f_w1[ks] = ldsfrag(W1T, row, ko); f_vt[ks] = ldsfrag(VT, row, ko); }
          const float plrow = PL[row];
#pragma unroll
          for (int k2 = 0; k2 < 2; ++k2) { const int ct = 2 * (w & 1) + k2; const int c0 = 16 * ct + 4 * q;
              f32x4 drh = {0.f, 0.f, 0.f, 0.f}, dy0 = drh, dmm = drh, dnt = drh;
#pragma unroll
              for (int ks = 0; ks < 2; ++ks) { const int ko = ks * 32 + 8 * q;
                  const bf16x8 c_ah = ldsfrag(AhT, 16 * ct + lq, ko), c_w1 = ldsfrag(W1T, 16 * ct + lq, ko), c_vt = ldsfrag(VT, 16 * ct + lq, ko), c_bt = ldsfrag(BT, 16 * ct + lq, ko), c_kt = ldsfrag(KT, 16 * ct + lq, ko);
                  drh = MFMA16(c_ah, f_arb[ks], drh);
                  dy0 = MFMA16(c_w1, f_arb[ks], dy0); dy0 = MFMA16(c_vt, f_ark[ks], dy0);
                  dmm = MFMA16(c_ah, f_bt[ks], dmm);
                  dnt = MFMA16(c_bt, f_w1[ks], dnt); dnt = MFMA16(c_kt, f_vt[ks], dnt); }
              float rr[4]; ld4(Rrow + row * R4_LD + c0, rr);
              st4(gRH + nat_st4(rt_, lq, c0), drh[0] + rr[0], drh[1] + rr[1], drh[2] + rr[2], drh[3] + rr[3]);
              *(f32x4*)(gY0 + ((rt_ * 4 + ct) * 64 + lane) * 4) = dy0;
#pragma unroll
              for (int e = 0; e < 4; ++e) { dmm[e] = plrow * (dmm[e] + ((c0 + e) == row ? 1.f : 0.f)); dnt[e] *= PL[c0 + e]; }
              st4(gMM + nat_st4(rt_, lq, c0), dmm[0], dmm[1], dmm[2], dmm[3]);
              *(f32x4*)(gNT + ((rt_ * 4 + ct) * 64 + lane) * 4) = dnt; } }
#endif
    }
}
__device__ __forceinline__ void r5_phase(const Args& a, unsigned char* lds) {
    const int bid = pg8::opq_bid(); if (bid >= 64) return;
    unsigned char* ws = pg8::opq_ptr(a.ws); const int tid = pg8::opq_tid(), lane = tid & 63, w = tid >> 6, lq = lane & 15, q = lane >> 4; const int h = bid & 15, iq = bid >> 4;
    const bf16_t* gMM = (const bf16_t*)(ws + WS_BIG + BIG_MM); const float* gNT = (const float*)(ws + WS_BIG + BIG_NT);
    bf16_t* SC = (bf16_t*)(ws + WS_MIX + (size_t)1 * SZ_TD2);
    bf16_t* Sb = (bf16_t*)lds;
    for (int i = tid; i < 2 * 16 * R4_LD / 2; i += 512) ((unsigned*)Sb)[i] = 0u;
    for (int i = tid; i < 512; i += 512) ((unsigned*)(SC + (size_t)h * 4096 + iq * 1024))[i] = 0u;
    __syncthreads();
    if (w >= 4) {
        for (int c = 0; c < 256; ++c) { asm volatile("s_waitcnt lgkmcnt(0)" ::: "memory"); __builtin_amdgcn_s_barrier(); asm volatile("" ::: "memory"); }
        return; }
    const int jt = w; const int irow = 16 * iq + lq;
    bf16x8 Mr[8][2]; f32x4 Nr[8];
#pragma unroll
    for (int k = 0; k < 8; ++k) { const size_t ub = (size_t)(h * 256 + k) * 4096;
#pragma unroll
        for (int ks = 0; ks < 2; ++ks) Mr[k][ks] = *(const bf16x8*)(gMM + ub + nat_frag(jt, ks, lane));
        Nr[k] = *(const f32x4*)(gNT + ub + ((iq * 4 + jt) * 64 + lane) * 4); }
    for (int c0 = 0; c0 < 256; c0 += 8) {
#pragma unroll
        for (int k = 0; k < 8; ++k) { const int c = c0 + k;
            const bf16_t* Sc_ = Sb + (k & 1) * 16 * R4_LD; bf16_t* Sn_ = Sb + ((k & 1) ^ 1) * 16 * R4_LD;
            bf16_t* scn = SC + (size_t)((c + 1) * 16 + h) * 4096;
            f32x4 d = Nr[k];
#pragma unroll
            for (int ks = 0; ks < 2; ++ks) d = MFMA16(Mr[k][ks], ldsfrag(Sc_, lq, ks * 32 + 8 * q), d);
            st4(Sn_ + lq * R4_LD + 16 * jt + 4 * q, d[0], d[1], d[2], d[3]);
            if (c < 255) st4(scn + nat_st4(iq, lq, 16 * jt + 4 * q), d[0], d[1], d[2], d[3]);
            { const int cn = (c + 8 < 256) ? c + 8 : 255; const size_t ub = (size_t)(h * 256 + cn) * 4096;
#pragma unroll
              for (int ks = 0; ks < 2; ++ks) Mr[k][ks] = *(const bf16x8*)(gMM + ub + nat_frag(jt, ks, lane));
              Nr[k] = *(const f32x4*)(gNT + ub + ((iq * 4 + jt) * 64 + lane) * 4); }
            asm volatile("s_waitcnt lgkmcnt(0)" ::: "memory"); __builtin_amdgcn_s_barrier(); asm volatile("" ::: "memory");
        }
    }
}
__device__ __forceinline__ void r6_phase(const Args& a, int l) {
    unsigned char* ws = pg8::opq_ptr(a.ws); const int tid = pg8::opq_tid(), lane = tid & 63, lq = lane & 15, q = lane >> 4; const int gw = pg8::opq_bid() * 8 + (tid >> 6), NGW = gridDim.x * 8;
    const bf16_t* gRH = (const bf16_t*)(ws + WS_BIG + BIG_RH); const float* gY0 = (const float*)(ws + WS_BIG + BIG_Y0); const bf16_t* SC = (const bf16_t*)(ws + WS_MIX + (size_t)1 * SZ_TD2);
    const bf16_t* base = (const bf16_t*)(ws + WS_MIX); const bf16_t* pR = base; const bf16_t* pK = base + (size_t)2 * T * D; const bf16_t* pV = base + (size_t)(5 + l) * T * D; const bf16_t* pG = base + (size_t)7 * T * D;
    bf16_t* YG = (bf16_t*)(ws + WS_MIX + (size_t)3 * SZ_TD2);
    const float* lnw = a.in[21] + l * D; const float* lnb = a.in[22] + l * D; const float* rk = a.in[20] + l * D;
    for (int item = gw; item < 16384; item += NGW) { const int tt = item & 3, u = item >> 2; const int h = u & 15, c = u >> 4; const int t = c * 64 + tt * 16 + lq;
        const size_t ub = (size_t)u * 4096;
        bf16x8 fr[2];
#pragma unroll
        for (int ks = 0; ks < 2; ++ks) fr[ks] = *(const bf16x8*)(gRH + ub + nat_frag(tt, ks, lane));
        f32x4 y[4]; bf16x8 fs[4][2]; u32x2 Lr[4], Lk[4], Lv[4], Lg[4];
#pragma unroll
        for (int it = 0; it < 4; ++it) { y[it] = *(const f32x4*)(gY0 + ub + ((tt * 4 + it) * 64 + lane) * 4);
#pragma unroll
            for (int ks = 0; ks < 2; ++ks) fs[it][ks] = *(const bf16x8*)(SC + ub + nat_frag(it, ks, lane));
            const size_t off = (size_t)t * D + h * 64 + 16 * it + 4 * q; Lr[it] = *(const u32x2*)(pR + off); Lk[it] = *(const u32x2*)(pK + off); Lv[it] = *(const u32x2*)(pV + off); Lg[it] = *(const u32x2*)(pG + off); }
#pragma unroll
        for (int it = 0; it < 4; ++it)
#pragma unroll
            for (int ks = 0; ks < 2; ++ks) y[it] = MFMA16(fs[it][ks], fr[ks], y[it]);
        float sm = 0.f, bs = 0.f; float vv[4][4], gg[4][4];
#pragma unroll
        for (int it = 0; it < 4; ++it) { const int c0 = h * 64 + 16 * it + 4 * q; float r4[4], k4[4];
            up4(Lr[it], r4); up4(Lk[it], k4); up4(Lv[it], vv[it]); up4(Lg[it], gg[it]); const f32x4 rkv = *(const f32x4*)(rk + c0);
#pragma unroll
            for (int e = 0; e < 4; ++e) { sm += y[it][e]; bs += r4[e] * k4[e] * rkv[e]; } }
        sm += __shfl_xor(sm, 16); sm += __shfl_xor(sm, 32); bs += __shfl_xor(bs, 16); bs += __shfl_xor(bs, 32);
        const float mean = sm * (1.f / 64.f); float vr = 0.f;
#pragma unroll
        for (int it = 0; it < 4; ++it)
#pragma unroll
            for (int e = 0; e < 4; ++e) { const float dd = y[it][e] - mean; vr += dd * dd; }
        vr += __shfl_xor(vr, 16); vr += __shfl_xor(vr, 32);
        const float rstd = rsqrtf(vr * (1.f / 64.f) + 64e-5f);
#pragma unroll
        for (int it = 0; it < 4; ++it) { const int c0 = h * 64 + 16 * it + 4 * q; const f32x4 lw = *(const f32x4*)(lnw + c0), lb = *(const f32x4*)(lnb + c0); float o[4];
#pragma unroll
            for (int e = 0; e < 4; ++e) o[e] = ((y[it][e] - mean) * rstd * lw[e] + lb[e] + bs * vv[it][e]) * gg[it][e];
            st4(YG + (size_t)t * D + c0, o[0], o[1], o[2], o[3]); }
    }
}
constexpr int VT_LD = 136;
__device__ __forceinline__ int vt_addr(int dim, int kp) { return dim * VT_LD + (dim >> 4) * 8 + kp; }
constexpr int KL_LD = 72;
struct AttRegs { u32x4 k[4], v0a, v0b, v1a, v1b; bf16x8 q[2]; };
__device__ __forceinline__ void att_decode(int u, int& g, int& h, int& d, int& rsd, int& n) { g = u >> 11; const int rem = u & 2047; h = rem >> 7; const int rr = rem & 127; const int sh = 2 * g; d = 1 << sh; rsd = rr & (d - 1); n = rr >> sh; }
__device__ __forceinline__ void att_load(const bf16_t* Q, const bf16_t* KV, int u, int tid, AttRegs& R) {
    int g, h, d, rsd, n; att_decode(u, g, h, d, rsd, n); const int hc = g * 1024 + h * 64; const int lane = tid & 63, w = tid >> 6, lq = lane & 15, qp = lane >> 4;
    const int sh = 2 * g; const size_t plane = ((size_t)(g * 16 + h) * T + (size_t)rsd * (T >> sh)) * 64; (void)hc;
    { const int key = tid >> 1, half = tid & 1; int mk = 128 * (n - 1) + key; mk = mk < 0 ? 0 : mk; const bf16_t* p = KV + plane + (size_t)mk * 64 + half * 32;
#pragma unroll
      for (int i = 0; i < 4; ++i) R.k[i] = *(const u32x4*)(p + 8 * i); }
    { const int kp = tid >> 2, dg = tid & 3; const u32x4 z = {0u, 0u, 0u, 0u}; R.v0a = z; R.v0b = z; R.v1a = z; R.v1b = z; const int m0 = 128 * (n - 1) + 2 * kp;
      if (m0 >= 0) { const bf16_t* p0 = KV + (size_t)48 * T * 64 + plane + (size_t)m0 * 64 + dg * 16; const bf16_t* p1 = p0 + 64;
          R.v0a = *(const u32x4*)p0; R.v0b = *(const u32x4*)(p0 + 8); R.v1a = *(const u32x4*)p1; R.v1b = *(const u32x4*)(p1 + 8); } }
    { const int qi = 16 * w + lq; const int tq = (128 * n + qi) * d + rsd;
#pragma unroll
      for (int ks = 0; ks < 2; ++ks) R.q[ks] = *(const bf16x8*)(Q + plane + (size_t)(128 * n + qi) * 64 + ks * 32 + qp * 8); (void)tq; }
}
__device__ __forceinline__ void attn_phase(const Args& a, unsigned* vt) {
    unsigned char* ws = pg8::opq_ptr(a.ws); const int tid = pg8::opq_tid(), lane = tid & 63, w = tid >> 6, lq = lane & 15, qp = lane >> 4;
    const bf16_t* Q = (const bf16_t*)(ws + WS_BIG + BIG_Q); const bf16_t* KV = (const bf16_t*)(ws + WS_MIX);
    bf16_t* OG = (bf16_t*)(ws + WS_BIG + BIG_OG); float* LSE = (float*)(ws + WS_BIG + BIG_LSE);
    bf16_t* kl = (bf16_t*)(vt + 9216);
    const int G = gridDim.x; int u = pg8::opq_bid();
    AttRegs R, R2; if (u < 6144) { att_load(Q, KV, u, tid, R); att_load(Q, KV, (u + G < 6144) ? u + G : u, tid, R2); }
    for (; u < 6144; u += G) {
        int g, h, d, rsd, n; att_decode(u, g, h, d, rsd, n);
        asm volatile("s_waitcnt lgkmcnt(0)" ::: "memory"); __builtin_amdgcn_s_barrier(); asm volatile("" ::: "memory");
        { const int key = tid >> 1, half = tid & 1;
#pragma unroll
          for (int i = 0; i < 4; ++i) *(u32x4*)(kl + key * KL_LD + half * 32 + 8 * i) = R.k[i]; }
        { const int kp = tid >> 2, dg = tid & 3;
          const unsigned e0[8] = {R.v0a.x, R.v0a.y, R.v0a.z, R.v0a.w, R.v0b.x, R.v0b.y, R.v0b.z, R.v0b.w}; const unsigned e1[8] = {R.v1a.x, R.v1a.y, R.v1a.z, R.v1a.w, R.v1b.x, R.v1b.y, R.v1b.z, R.v1b.w};
#pragma unroll
          for (int j = 0; j < 8; ++j) { const int dim = dg * 16 + 2 * j;
              vt[vt_addr(dim, kp)] = (e0[j] & 0xffffu) | (e1[j] << 16);
              vt[vt_addr(dim + 1, kp)] = (e0[j] >> 16) | (e1[j] & 0xffff0000u); } }
        bf16x8 bq[2]; bq[0] = R.q[0]; bq[1] = R.q[1];
        asm volatile("s_waitcnt lgkmcnt(0)" ::: "memory"); __builtin_amdgcn_s_barrier(); asm volatile("" ::: "memory");
        R = R2; { const int un = (u + 2 * G < 6144) ? u + 2 * G : u; att_load(Q, KV, un, tid, R2); }
        const int qi = 16 * w + lq; const int tq = (128 * n + qi) * d + rsd;
        const int kt0 = 2 * (w >> 1);
        f32x4 sc[10];
#pragma unroll
        for (int kl_ = 0; kl_ < 10; ++kl_) { const int krow = 16 * (kt0 + kl_) + lq; f32x4 acc = {0.f, 0.f, 0.f, 0.f};
            acc = MFMA16(*(const bf16x8*)(kl + krow * KL_LD + qp * 8), bq[0], acc); acc = MFMA16(*(const bf16x8*)(kl + krow * KL_LD + 32 + qp * 8), bq[1], acc); sc[kl_] = acc; }
        float mx = -3.0e38f;
#pragma unroll
        for (int kl_ = 0; kl_ < 10; ++kl_)
#pragma unroll
            for (int e = 0; e < 4; ++e) { const int kj = 16 * (kt0 + kl_) + 4 * qp + e; const bool valid = (kj >= qi) && (kj <= qi + 128) && (n > 0 || kj >= 128);
                const float sv = valid ? sc[kl_][e] : -1e30f; sc[kl_][e] = sv; mx = fmaxf(mx, sv); }
        mx = fmaxf(mx, __shfl_xor(mx, 16)); mx = fmaxf(mx, __shfl_xor(mx, 32));
        float lsum = 0.f;
#pragma unroll
        for (int kl_ = 0; kl_ < 10; ++kl_)
#pragma unroll
            for (int e = 0; e < 4; ++e) { const float p = __expf(sc[kl_][e] - mx); sc[kl_][e] = p; lsum += p; }
        lsum += __shfl_xor(lsum, 16); lsum += __shfl_xor(lsum, 32);
        f32x4 oacc[4];
#pragma unroll
        for (int dt = 0; dt < 4; ++dt) oacc[dt] = (f32x4){0.f, 0.f, 0.f, 0.f};
#pragma unroll
        for (int sl = 0; sl < 5; ++sl) { u32x4 pw; pw.x = cvt_pk_bf16(sc[2 * sl][0], sc[2 * sl][1]); pw.y = cvt_pk_bf16(sc[2 * sl][2], sc[2 * sl][3]);
            pw.z = cvt_pk_bf16(sc[2 * sl + 1][0], sc[2 * sl + 1][1]); pw.w = cvt_pk_bf16(sc[2 * sl + 1][2], sc[2 * sl + 1][3]);
            const bf16x8 bp = __builtin_bit_cast(bf16x8, pw); const int kpb = 16 * ((kt0 >> 1) + sl) + 2 * qp;
#pragma unroll
            for (int dt = 0; dt < 4; ++dt) { const int dim = dt * 16 + lq; const u32x2 lo = *(const u32x2*)(vt + vt_addr(dim, kpb)); const u32x2 hi = *(const u32x2*)(vt + vt_addr(dim, kpb + 8));
                u32x4 aw; aw.x = lo.x; aw.y = lo.y; aw.z = hi.x; aw.w = hi.y;
                oacc[dt] = MFMA16(__builtin_bit_cast(bf16x8, aw), bp, oacc[dt]); } }
        const float il = 1.f / lsum;
        bf16_t* op = OG + (size_t)g * T * D + (size_t)tq * D + h * 64 + 4 * qp;
#pragma unroll
        for (int dt = 0; dt < 4; ++dt) st4(op + dt * 16, oacc[dt][0] * il, oacc[dt][1] * il, oacc[dt][2] * il, oacc[dt][3] * il);
        if (qp == 0) LSE[(size_t)g * T * 16 + (size_t)tq * 16 + h] = mx + __logf(lsum);
    }
}
__device__ __forceinline__ void comb_phase(const Args& a) {
    unsigned char* ws = pg8::opq_ptr(a.ws); const int lane = pg8::opq_tid() & 63; const int gw = pg8::opq_bid() * 8 + (pg8::opq_tid() >> 6), NGW = gridDim.x * 8;
    const bf16_t* OG = (const bf16_t*)(ws + WS_BIG + BIG_OG); const float* LSE = (const float*)(ws + WS_BIG + BIG_LSE); bf16_t* O = (bf16_t*)(ws + WS_MIX + (size_t)T * KVW * 2);
    const int c0 = lane * 16, h = lane >> 2;
    for (int t = gw; t < T; t += NGW) {
        const float l0 = LSE[(size_t)t * 16 + h], l1 = LSE[(size_t)T * 16 + (size_t)t * 16 + h], l2 = LSE[(size_t)2 * T * 16 + (size_t)t * 16 + h];
        const float mx = fmaxf(l0, fmaxf(l1, l2)); float e0 = __expf(l0 - mx), e1 = __expf(l1 - mx), e2 = __expf(l2 - mx); const float is = 1.f / (e0 + e1 + e2); e0 *= is; e1 *= is; e2 *= is;
        float o[16];
#pragma unroll
        for (int hf = 0; hf < 2; ++hf) { float x0[8], x1[8], x2[8]; const size_t off = (size_t)t * D + c0 + hf * 8;
            ld8(OG + off, x0); ld8(OG + (size_t)T * D + off, x1); ld8(OG + (size_t)2 * T * D + off, x2);
#pragma unroll
            for (int j = 0; j < 8; ++j) o[hf * 8 + j] = e0 * x0[j] + e1 * x1[j] + e2 * x2[j]; }
        u32x4 w0, w1; w0.x = cvt_pk_bf16(o[0], o[1]); w0.y = cvt_pk_bf16(o[2], o[3]); w0.z = cvt_pk_bf16(o[4], o[5]); w0.w = cvt_pk_bf16(o[6], o[7]);
        w1.x = cvt_pk_bf16(o[8], o[9]); w1.y = cvt_pk_bf16(o[10], o[11]); w1.z = cvt_pk_bf16(o[12], o[13]); w1.w = cvt_pk_bf16(o[14], o[15]);
        *(u32x4*)(O + (size_t)t * D + c0) = w0; *(u32x4*)(O + (size_t)t * D + c0 + 8) = w1; }
}
__global__ void __launch_bounds__(512, 2) mega(Args a) {
    extern __shared__ __attribute__((aligned(16))) unsigned char lds[];
    { volatile LAS unsigned* stw = (volatile LAS unsigned*)((LAS unsigned char*)lds + (LDS_BYTES - 64)); if (threadIdx.x < 2) stw[threadIdx.x] = 0u; }
    __syncthreads();
    { cg::grid_group grid = cg::this_grid(); if (a.ph_hi < 0) grid.sync(); }
    XcdBarrier bar = xcd_barrier_post((unsigned*)(a.ws + WS_BAR), (volatile LAS unsigned*)((LAS unsigned char*)lds + (LDS_BYTES - 64)));
    for (int s = a.ph_lo; s < a.ph_hi; ++s) {
        if (s > a.ph_lo) xcd_barrier(bar);
        unsigned char* ws = pg8::opq_ptr(a.ws); PG8_LAS unsigned char* glds = (PG8_LAS unsigned char*)lds; float* ssb = (float*)(ws + WS_SS); bf16_t* XB = (bf16_t*)(ws + WS_XB); const int bid = pg8::opq_bid();
        int type, l = 0, j = 0;
        if (s == 0) type = 0; else if (s == 21) type = 8;
        else { int o; if (s <= 10) { l = 0; o = s - 1; } else if (s <= 20) { l = 1; o = s - 11; } else if (s <= 29) { l = 2; o = s - 22; } else { l = 3; o = s - 30; }
            if (l < 2) { if (o < 2) type = 1 + o; else if (o < 6) type = o + 1; else if (o == 6) type = 13; else if (o == 7) type = 7; else { type = o - 7; j = 1; } }
            else { if (o < 2) type = 1 + o; else if (o < 6) type = o + 7; else { type = o - 5; j = 1; } } }
#ifndef DUP_MASK
#define DUP_MASK 0
#endif
        for (int rep = 0; rep < (((DUP_MASK >> type) & 1) ? 2 : 1); ++rep) {
        if (type == 0) { p0_phase(a, (float*)lds); }
        else if (type == 1) { pg8::Gemm g{XB, (const bf16_t*)(ws + WS_WIN + (size_t)(l * 2 + j) * SZ_WIN), T, 2 * FF, D}; pg8::StaticOrder S; S.init(T, 2 * FF, gridDim.x, bid);
            EpiSwiglu E{(bf16_t*)(ws + WS_BIG), ssb + (size_t)(3 * l + (j ? 2 : 0)) * T * 16};
            pg8::gemm_phase<EpiSwiglu, pg8::StaticOrder, true, true>(glds, g, S, E); }
        else if (type == 2 || type == 7 || type == 12) {
            pg8::Gemm g; EpiResid E; E.xnew = a.out; E.xb = XB; E.xold = a.out;
            if (type == 2) { g = pg8::Gemm{(const bf16_t*)(ws + WS_BIG), (const bf16_t*)(ws + WS_WOUT + (size_t)(l * 2 + j) * SZ_WOUT), T, D, FF}; E.alpha = 0.5f; E.ssn = ssb + (size_t)(3 * l + (j ? 3 : 1)) * T * 16; if (l == 0 && j == 0) E.xold = a.in[0]; }
            else if (type == 7) { g = pg8::Gemm{(const bf16_t*)(ws + WS_MIX + (size_t)3 * SZ_TD2), (const bf16_t*)(ws + WS_WOR + (size_t)l * SZ_SQ), T, D, D}; E.alpha = 1.f; E.ssn = ssb + (size_t)(3 * l + 2) * T * 16; }
            else { g = pg8::Gemm{(const bf16_t*)(ws + WS_MIX + (size_t)T * KVW * 2), (const bf16_t*)(ws + WS_WOA + (size_t)(l - 2) * SZ_SQ), T, D, D}; E.alpha = 1.f; E.ssn = ssb + (size_t)(3 * l + 2) * T * 16; }
            pg8::StaticOrder S; S.init(T, D, gridDim.x, bid);
            pg8::gemm_phase<EpiResid, pg8::StaticOrder, true, true>(glds, g, S, E); }
        else if (type == 3) { pg8::Gemm g{XB, (const bf16_t*)(ws + WS_WCAT + (size_t)l * SZ_WCAT), T, NCAT, D}; pg8::StaticOrder S; S.init(T, NCAT, gridDim.x, bid);
            EpiPlain E{(bf16_t*)(ws + WS_BIG), NCAT};
            pg8::gemm_phase<EpiPlain, pg8::StaticOrder, true, true>(glds, g, S, E); }
        else if (type == 4) f1_phase(a, l, lds);
        else if (type == 5) r4_phase(a, l, lds);
        else if (type == 6) { if (bid >= 64 && gridDim.x > 64) p0_convert(a, (float*)lds, l + 1, bid - 64, gridDim.x - 64); else r5_phase(a, lds); }
        else if (type == 13) r6_phase(a, l);
        else if (type == 8 || type == 9) {
            pg8::Gemm g; EpiHeadNorm E; E.nnorm = 48;
            if (type == 8) { g = pg8::Gemm{XB, (const bf16_t*)(ws + WS_WKV), T, KVW, D}; E.O = (bf16_t*)(ws + WS_MIX); E.ldc = KVW; E.ss = ssb + (size_t)6 * T * 16; E.gain = a.in[26]; E.scale = 1.f; }
            else { g = pg8::Gemm{XB, (const bf16_t*)(ws + WS_WQ + (size_t)(l - 2) * SZ_WQ), T, QW, D}; E.O = (bf16_t*)(ws + WS_BIG + BIG_Q); E.ldc = QW; E.ss = ssb + (size_t)(3 * l + 1) * T * 16; E.gain = a.in[28] + (l - 2) * 192; E.scale = 0.125f; }
            pg8::StaticOrder S; S.init(T, g.N, gridDim.x, bid);
            pg8::gemm_phase<EpiHeadNorm, pg8::StaticOrder, true, true>(glds, g, S, E); }
        else if (type == 10) attn_phase(a, (unsigned*)lds);
        else if (type == 11) comb_phase(a);
        }
    }
}

extern "C" void kernel_launch(void* const* d_in, const int* in_sizes, int n_in, void* d_out, int out_size, void* d_ws, size_t ws_size, hipStream_t stream) {
    static int grid = 0;
    if (grid == 0) {
        if (n_in != 30 || out_size != T * D || ws_size < WS_END) { fprintf(stderr, "kernel_launch: unexpected shapes: n_in %d out %d ws %zu (need %zu)\n", n_in, out_size, ws_size, (size_t)WS_END); grid = -1; return; }
        int dev = 0, cus = 0, per_cu = 0;
        (void)hipGetDevice(&dev); (void)hipDeviceGetAttribute(&cus, hipDeviceAttributeMultiprocessorCount, dev);
        if (hipFuncSetAttribute((const void*)mega, hipFuncAttributeMaxDynamicSharedMemorySize, LDS_BYTES) != hipSuccess) { fprintf(stderr, "kernel_launch: hipFuncSetAttribute failed\n"); grid = -1; return; }
        if (hipOccupancyMaxActiveBlocksPerMultiprocessor(&per_cu, (const void*)mega, 512, LDS_BYTES) != hipSuccess || per_cu < 1) { fprintf(stderr, "kernel_launch: occupancy query says %d\n", per_cu); per_cu = 1; }
        (void)hipGetLastError();
        grid = cus * 1;
        if (grid <= 0) grid = 256;
    }
    if (grid < 0) return;
    if (hipMemsetAsync((char*)d_ws + WS_BAR, 0, XCD_BAR_WORDS * 4, stream) != hipSuccess) { fprintf(stderr, "kernel_launch: memset failed\n"); return; }
    Args a{};
    for (int i = 0; i < 30; ++i) a.in[i] = (const float*)d_in[i];
    a.out = (float*)d_out; a.ws = (unsigned char*)d_ws;
#if ONE_LAUNCH
    a.ph_lo = 0; a.ph_hi = NSTEPS;
    void* args[] = {&a};
    hipError_t e = hipLaunchCooperativeKernel((const void*)mega, dim3(grid), dim3(512), args, LDS_BYTES, stream);
    if (e != hipSuccess) fprintf(stderr, "cooperative launch failed: %s (grid %d)\n", hipGetErrorString(e), grid);
#else
    for (int s = 0; s < NSTEPS; ++s) { a.ph_lo = s; a.ph_hi = s + 1; hipLaunchKernelGGL(mega, dim3(grid), dim3(512), LDS_BYTES, stream, a); }
#endif
}
```

```cpp
#include <hip/hip_runtime.h>
#include <hip/hip_cooperative_groups.h>
#include <cstdio>
#include <cstdint>
namespace cg = cooperative_groups;
namespace pg8 {
#define PG8_LAS __attribute__((address_space(3)))
typedef unsigned short bf16_t;
typedef short bf16x8 __attribute__((ext_vector_type(8)));
typedef float f32x4 __attribute__((ext_vector_type(4)));
typedef unsigned u32x4 __attribute__((ext_vector_type(4)));
__device__ __forceinline__ int opq_tid() { int t = threadIdx.x; asm volatile("" : "+v"(t)); return t; }
__device__ __forceinline__ int opq_bid() { int t = blockIdx.x; asm volatile("" : "+s"(t)); return t; }
__device__ __forceinline__ unsigned char* opq_ptr(unsigned char* q) { size_t off = 0; asm volatile("" : "+s"(off)); return q + off; }
constexpr int BM = 256, BK = 64, HALF = 128, HTB = HALF * BK * 2  , STAGE_BYTES = 8 * HTB, NXCD = 8, WGM = 8;

__host__ __device__ __forceinline__ int lds_byte(int r, int c) { const int st = (r >> 4) * 2 + (c >> 5), rr = r & 15, cc = c & 31, ob = rr * 64 + cc * 2; return st * 1024 + (ob ^ (((ob >> 9) & 1) << 5)); }
__host__ __device__ __forceinline__ void stage_rc(int b, int& R, int& C) { const int st = b / 1024, sb = b % 1024, swz = sb ^ (((sb >> 9) & 1) << 5); R = (st >> 1) * 16 + swz / 64; C = (st & 1) * 32 + (swz % 64) / 2; }
__host__ __device__ __forceinline__ int perm32(int rho) { const int n = rho >> 4, i = rho & 15; return 8 * (i >> 2) + 4 * n + (i & 3); }

struct Unit { int pm, pn; };
struct Gemm { const bf16_t* A; const bf16_t* Bt; int M, N, K; };

struct StaticOrder {
    int nM, nN, nwg, G, c;
    __host__ __device__ void init(int M, int N, int G_, int c_) { nM = M / BM; nN = N / BM; nwg = nM * nN; G = G_; c = c_; }
    __host__ __device__ bool next(int i, Unit& u) const {
        const long L = (long)i * G + c; if (L >= nwg) return false;
        int wgid = (int)L; { const int q = nwg / NXCD, r = nwg % NXCD, xcd = wgid % NXCD, off = wgid / NXCD; wgid = (xcd < r ? xcd * (q + 1) : r * (q + 1) + (xcd - r) * q) + off; }
        const int nig = WGM * nN, gid = wgid / nig, fm = gid * WGM, gsz = (nM - fm) < WGM ? (nM - fm) : WGM;
        u.pm = fm + ((wgid % nig) % gsz); u.pn = (wgid % nig) / gsz; return true;
    }
    __device__ __forceinline__ void a_ready(const Unit&) const {}
    __device__ __forceinline__ void done(const Unit&) const {}
};

typedef __bf16 bf16x2v_ __attribute__((ext_vector_type(2))); typedef float f32x2v_ __attribute__((ext_vector_type(2)));
__device__ __forceinline__ unsigned cvt_pk_bf16(float lo, float hi) { const f32x2v_ v = {lo, hi}; const bf16x2v_ b = __builtin_convertvector(v, bf16x2v_); return __builtin_bit_cast(unsigned, b); }
typedef float f32x2 __attribute__((ext_vector_type(2)));
template <class Epi, class Sched, bool ALIGN_EPI = false, bool SP2 = false>
__device__ __forceinline__ void gemm_phase(PG8_LAS unsigned char* lds, const Gemm g, const Sched& S, const Epi& E) {
    const int tid = opq_tid(), wid = __builtin_amdgcn_readfirstlane(tid >> 6), lane = tid & 63, wr = wid >> 2, wc = wid & 3, fr = lane & 15, fq = lane >> 4;
    const int K = g.K, nt = K / BK;
    unsigned voffA[2], voffB[2];
#pragma unroll
    for (int i = 0; i < 2; ++i) { int R, C; stage_rc(tid * 16 + i * 8192, R, C); const int Rb = Epi::PERM ? ((R & ~31) + perm32(R & 31)) : R;
        voffA[i] = (unsigned)(R * K + C) * 2u; voffB[i] = (unsigned)(Rb * K + C) * 2u; }
    const size_t kstep = (size_t)(BK * 2);
    const size_t hstep = (size_t)HALF * K * 2;
    const size_t tstep = 2 * hstep;
    const unsigned ldsw = (unsigned)wid * 1024u;
    const int aoff = lds_byte(wr * 64 + fr, fq * 8), boff = lds_byte(wc * 32 + fr, fq * 8);
#define PG8_SA(b, h) (((b) * 2 + (h)) * HTB)
#define PG8_SB(b, h) ((4 + (b) * 2 + (h)) * HTB)
#define PG8_STAGE(bufoff, gbase, voff) do { _Pragma("unroll") for (int _i = 0; _i < 2; ++_i) \
        __builtin_amdgcn_global_load_lds((const unsigned*)((const char*)(gbase) + (voff)[_i]), (PG8_LAS unsigned*)(lds + (bufoff) + ldsw + _i * 8192), 16, 0, 0); } while (0)
#define PG8_LDA(dst, b, h) do { _Pragma("unroll") for (int m = 0; m < 4; ++m) _Pragma("unroll") for (int k = 0; k < 2; ++k) dst[m][k] = *(const PG8_LAS bf16x8*)(lds + PG8_SA(b, h) + aoff + m * 2048 + k * 1024); } while (0)
#define PG8_LDB(dst, b, h) do { _Pragma("unroll") for (int n = 0; n < 2; ++n) _Pragma("unroll") for (int k = 0; k < 2; ++k) dst[n][k] = *(const PG8_LAS bf16x8*)(lds + PG8_SB(b, h) + boff + n * 2048 + k * 1024); } while (0)
#define PG8_MMA(ai, bj, At, Bt) do { __builtin_amdgcn_s_setprio(1); _Pragma("unroll") for (int m = 0; m < 4; ++m) _Pragma("unroll") for (int n = 0; n < 2; ++n) _Pragma("unroll") for (int k = 0; k < 2; ++k) \
        acc[ai][bj][m][n] = __builtin_amdgcn_mfma_f32_16x16x32_bf16(Bt[n][k], At[m][k], acc[ai][bj][m][n], 0, 0, 0); __builtin_amdgcn_s_setprio(0); } while (0)
#define PG8_WAIT_V(n) asm volatile("s_waitcnt vmcnt(" #n ")" ::: "memory")
#define PG8_WAIT_L(n) asm volatile("s_waitcnt lgkmcnt(" #n ")" ::: "memory")
#define PG8_BAR __builtin_amdgcn_s_barrier()
#define PG8_SCHED __builtin_amdgcn_sched_barrier(0)
    Unit cur, nxt; int ui = 0;
    if (!S.next(0, cur)) return;
    f32x4 acc[2][2][4][2];
#pragma unroll
    for (int a = 0; a < 2; ++a)
#pragma unroll
        for (int b = 0; b < 2; ++b)
#pragma unroll
            for (int m = 0; m < 4; ++m)
#pragma unroll
                for (int n = 0; n < 2; ++n) acc[a][b][m][n] = (f32x4){0.f, 0.f, 0.f, 0.f};
    bf16x8 At[4][2], B0[2][2], B1[2][2];
    const char* cA = (const char*)g.A + (size_t)cur.pm * tstep; const char* cB = (const char*)g.Bt + (size_t)cur.pn * tstep;
    S.a_ready(cur);
    if constexpr (SP2) {
        PG8_STAGE(PG8_SB(0, 0), cB, voffB); PG8_STAGE(PG8_SB(0, 1), cB + hstep, voffB); PG8_STAGE(PG8_SA(0, 0), cA, voffA); PG8_STAGE(PG8_SA(0, 1), cA + hstep, voffA);
        if (wr == 1) PG8_BAR;
        PG8_WAIT_V(2); PG8_BAR;
        PG8_STAGE(PG8_SB(1, 0), cB + kstep, voffB); PG8_STAGE(PG8_SA(1, 0), cA + kstep, voffA); PG8_STAGE(PG8_SB(1, 1), cB + hstep + kstep, voffB);
        PG8_WAIT_V(6); PG8_BAR;
    } else {
        PG8_STAGE(PG8_SB(0, 0), cB, voffB); PG8_STAGE(PG8_SA(0, 0), cA, voffA); PG8_STAGE(PG8_SB(0, 1), cB + hstep, voffB); PG8_STAGE(PG8_SA(0, 1), cA + hstep, voffA);
        if (wr == 1) PG8_BAR;
        PG8_WAIT_V(4); PG8_BAR;
        PG8_STAGE(PG8_SB(1, 0), cB + kstep, voffB); PG8_STAGE(PG8_SA(1, 0), cA + kstep, voffA); PG8_STAGE(PG8_SB(1, 1), cB + hstep + kstep, voffB);
        PG8_WAIT_V(6); PG8_BAR;
    }
    for (;;) {
        const bool has_next = S.next(ui + 1, nxt);
        const char* nA = has_next ? (const char*)g.A + (size_t)nxt.pm * tstep : cA; const char* nB = has_next ? (const char*)g.Bt + (size_t)nxt.pn * tstep : cB;
        for (int t = 0; t < nt; t += 2) {
            const bool last = (t == nt - 2);
            const char* a1 = cA + (size_t)(t + 1) * kstep;
            const char* a2 = last ? nA : cA + (size_t)(t + 2) * kstep; const char* b2 = last ? nB : cB + (size_t)(t + 2) * kstep;
            const char* a3 = a2 + kstep; const char* b3 = b2 + kstep;
            if (last && has_next) S.a_ready(nxt);
            if constexpr (SP2) {
            PG8_LDB(B0, 0, 0); PG8_LDB(B1, 0, 1); PG8_SCHED; PG8_LDA(At, 0, 0); PG8_STAGE(PG8_SA(1, 1), a1 + hstep, voffA);
            PG8_WAIT_V(8); PG8_WAIT_L(0); PG8_BAR; PG8_MMA(0, 0, At, B0); PG8_MMA(0, 1, At, B1); PG8_BAR; PG8_SCHED;
            PG8_LDA(At, 0, 1); PG8_STAGE(PG8_SB(0, 0), b2, voffB); PG8_STAGE(PG8_SB(0, 1), b2 + hstep, voffB); PG8_STAGE(PG8_SA(0, 0), a2, voffA);
            PG8_WAIT_V(8); PG8_WAIT_L(0); PG8_BAR; PG8_MMA(1, 0, At, B0); PG8_MMA(1, 1, At, B1); PG8_BAR; PG8_SCHED;
            PG8_LDB(B0, 1, 0); PG8_LDB(B1, 1, 1); PG8_SCHED; PG8_LDA(At, 1, 0); PG8_STAGE(PG8_SA(0, 1), a2 + hstep, voffA);
            PG8_WAIT_V(8); PG8_WAIT_L(0); PG8_BAR; PG8_MMA(0, 0, At, B0); PG8_MMA(0, 1, At, B1); PG8_BAR; PG8_SCHED;
            PG8_LDA(At, 1, 1); PG8_STAGE(PG8_SB(1, 0), b3, voffB); PG8_STAGE(PG8_SB(1, 1), b3 + hstep, voffB); PG8_STAGE(PG8_SA(1, 0), a3, voffA);
            PG8_WAIT_V(8); PG8_WAIT_L(0); PG8_BAR; PG8_MMA(1, 0, At, B0); PG8_MMA(1, 1, At, B1); PG8_BAR; PG8_SCHED;
            } else {
            PG8_LDB(B0, 0, 0); PG8_SCHED; PG8_LDA(At, 0, 0); PG8_STAGE(PG8_SA(1, 1), a1 + hstep, voffA);
            PG8_WAIT_L(8); PG8_BAR; PG8_WAIT_L(0); PG8_MMA(0, 0, At, B0); PG8_BAR; PG8_SCHED;
            PG8_LDB(B1, 0, 1); PG8_STAGE(PG8_SB(0, 0), b2, voffB);
            PG8_BAR; PG8_WAIT_L(0); PG8_MMA(0, 1, At, B1); PG8_BAR;
            PG8_LDA(At, 0, 1); PG8_STAGE(PG8_SA(0, 0), a2, voffA);
            PG8_BAR; PG8_WAIT_L(0); PG8_MMA(1, 0, At, B0); PG8_BAR; PG8_SCHED;
            PG8_STAGE(PG8_SB(0, 1), b2 + hstep, voffB);
            PG8_WAIT_V(6); PG8_BAR; PG8_MMA(1, 1, At, B1); PG8_BAR;
            PG8_LDB(B0, 1, 0); PG8_SCHED; PG8_LDA(At, 1, 0); PG8_STAGE(PG8_SA(0, 1), a2 + hstep, voffA);
            PG8_WAIT_L(8); PG8_BAR; PG8_WAIT_L(0); PG8_MMA(0, 0, At, B0); PG8_BAR; PG8_SCHED;
            PG8_LDB(B1, 1, 1); PG8_STAGE(PG8_SB(1, 0), b3, voffB);
            PG8_BAR; PG8_WAIT_L(0); PG8_MMA(0, 1, At, B1); PG8_BAR;
            PG8_LDA(At, 1, 1); PG8_STAGE(PG8_SA(1, 0), a3, voffA);
            PG8_BAR; PG8_WAIT_L(0); PG8_MMA(1, 0, At, B0); PG8_BAR; PG8_SCHED;
            PG8_STAGE(PG8_SB(1, 1), b3 + hstep, voffB);
            PG8_WAIT_V(6); PG8_BAR; PG8_MMA(1, 1, At, B1); PG8_BAR;
            }
        }
        if constexpr (ALIGN_EPI) { if (wr == 0) PG8_BAR; }
        if constexpr (!Epi::AFTER_DRAIN) { E(acc, cur, wr, wc, fr, fq); S.done(cur); }
        if (!has_next) break;
#pragma unroll
        for (int a = 0; a < 2; ++a)
#pragma unroll
            for (int b = 0; b < 2; ++b)
#pragma unroll
                for (int m = 0; m < 4; ++m)
#pragma unroll
                    for (int n = 0; n < 2; ++n) acc[a][b][m][n] = (f32x4){0.f, 0.f, 0.f, 0.f};
        cur = nxt; cA = nA; cB = nB; ++ui;
        if constexpr (ALIGN_EPI) { if (wr == 1) PG8_BAR; }
    }
    PG8_WAIT_V(0);
    if constexpr (!ALIGN_EPI) { if (wr == 0) PG8_BAR; }
    PG8_BAR;
    if constexpr (Epi::AFTER_DRAIN) { E.fused(acc, cur, wr, wc, fr, fq, lds, wid, lane); S.done(cur); }
#undef PG8_SA
#undef PG8_SB
#undef PG8_STAGE
#undef PG8_LDA
#undef PG8_LDB
#undef PG8_MMA
#undef PG8_WAIT_V
#undef PG8_WAIT_L
#undef PG8_BAR
#undef PG8_SCHED
}
}

#ifndef ONE_LAUNCH
#define ONE_LAUNCH 1
#endif
using pg8::bf16_t; using pg8::bf16x8; using pg8::f32x4; using pg8::u32x4; using pg8::Unit; using pg8::cvt_pk_bf16;
typedef unsigned u32x2 __attribute__((ext_vector_type(2)));
typedef unsigned short u16x4 __attribute__((ext_vector_type(4)));

constexpr int T = 16384, D = 1024, FF = 2816, NCAT = 6656, HALFCAT = 3328, QW = 3072, KVW = 6144;
constexpr float RMS_EPS = 1e-6f;
constexpr int LDS_BYTES = 147456;
constexpr int NSTEPS = 38;

constexpr size_t WS_BAR = 0;
constexpr size_t WS_WIN = 1u << 20;
constexpr size_t SZ_WIN = (size_t)5632 * 1024 * 2;
constexpr size_t WS_WOUT = WS_WIN + 8 * SZ_WIN;
constexpr size_t SZ_WOUT = (size_t)1024 * 2816 * 2;
constexpr size_t WS_WCAT = WS_WOUT + 8 * SZ_WOUT;
constexpr size_t SZ_WCAT = (size_t)NCAT * 1024 * 2;
constexpr size_t WS_WOR = WS_WCAT + 2 * SZ_WCAT;
constexpr size_t SZ_SQ = (size_t)1024 * 1024 * 2;
constexpr size_t WS_WUP = WS_WOR + 2 * SZ_SQ;
constexpr size_t SZ_UP = (size_t)1024 * 64 * 2;
constexpr size_t WS_WKV = WS_WUP + 8 * SZ_UP;
constexpr size_t WS_WQ = WS_WKV + (size_t)KVW * 1024 * 2;
constexpr size_t SZ_WQ = (size_t)QW * 1024 * 2;
constexpr size_t WS_WOA = WS_WQ + 2 * SZ_WQ;
constexpr size_t WS_XB = WS_WOA + 2 * SZ_SQ;
constexpr size_t SZ_TD2 = (size_t)T * 1024 * 2;
constexpr size_t WS_BIG = WS_XB + SZ_TD2;
constexpr size_t SZ_BIG = (size_t)T * NCAT * 2;
constexpr size_t WS_MIX = WS_BIG + SZ_BIG;
constexpr size_t WS_SS = WS_MIX + 8 * SZ_TD2;
constexpr size_t SZ_SS = (size_t)T * 16 * 4;
constexpr size_t WS_END = WS_SS + 13 * SZ_SS;
constexpr size_t BIG_Y = 0, BIG_YG = (size_t)T * 1024 * 4;
constexpr size_t BIG_Q = 0, BIG_OG = (size_t)T * QW * 2, BIG_LSE = BIG_OG + 3 * SZ_TD2;
static_assert(BIG_LSE + (size_t)3 * T * 16 * 4 <= SZ_BIG, "big");

struct Args { const float* in[30]; float* out; unsigned char* ws; int ph_lo, ph_hi; };

__device__ __forceinline__ float bf2f(unsigned short v) { return __uint_as_float((unsigned)v << 16); }
__device__ __forceinline__ float bflo(unsigned v) { return __uint_as_float(v << 16); }
__device__ __forceinline__ float bfhi(unsigned v) { return __uint_as_float(v & 0xffff0000u); }
__device__ __forceinline__ float row_rs(const float* ssp, int row) { const f32x4* q = (const f32x4*)(ssp + (size_t)row * 16); const f32x4 a = q[0], b = q[1], c = q[2], d = q[3];
    const float s = ((a[0] + a[1]) + (a[2] + a[3])) + ((b[0] + b[1]) + (b[2] + b[3])) + (((c[0] + c[1]) + (c[2] + c[3])) + ((d[0] + d[1]) + (d[2] + d[3]))); return rsqrtf(s * (1.f / 1024.f) + RMS_EPS); }
__device__ __forceinline__ float sigm(float x) { return __builtin_amdgcn_rcpf(1.f + __expf(-x)); }
__device__ __forceinline__ float tanh_fast(float x) { const float e = __expf(2.f * x); return 1.f - 2.f * __builtin_amdgcn_rcpf(e + 1.f); }
#define LAS __attribute__((address_space(3)))
#define XB_TMO      128
#define XB_XCNT(j)  (256  + 64 * (j))
#define XB_XSUB(j)  (1280 + 64 * (j))
#define XB_XGEN(j)  (2304 + 64 * (j))
#define XB_TOP      3328
#define XB_TOPGEN   3392
#define XCD_BAR_WORDS 3456
#define XB_SPIN_CAP (1u << 18)

__device__ __forceinline__ unsigned xb_ld(unsigned* p)              { return __hip_atomic_load(p, __ATOMIC_RELAXED, __HIP_MEMORY_SCOPE_AGENT); }
__device__ __forceinline__ unsigned xb_add(unsigned* p, unsigned v) { return __hip_atomic_fetch_add(p, v, __ATOMIC_RELAXED, __HIP_MEMORY_SCOPE_AGENT); }
__device__ __forceinline__ unsigned xb_xcc_id() { return (unsigned)__builtin_amdgcn_s_getreg((3 << 11) | 20) & 0xFu; }
#define XB_SPIN(cond, bar) do { unsigned _sp = 0; while (cond) { __builtin_amdgcn_s_sleep(1); \
    if ((++_sp & 255u) == 0u) { if (xb_ld(&(bar)[XB_TMO])) break; if (_sp > XB_SPIN_CAP) { atomicAdd(&(bar)[XB_TMO], 1u); break; } } } } while (0)

struct XcdBarrier {
    unsigned* bar; unsigned x;
    volatile LAS unsigned* st;
};

__device__ __forceinline__ XcdBarrier xcd_barrier_post(unsigned* bar, volatile LAS unsigned* st) {
    XcdBarrier b; b.bar = bar; b.x = xb_xcc_id(); b.st = st;
    if (threadIdx.x == 0) (void)xb_add(&bar[XB_XCNT(b.x)], 1u);
    return b;
}
__device__ __forceinline__ void xcd_barrier_complete(unsigned* bar, unsigned x, unsigned& nloc, unsigned& nx) {
    const unsigned G = gridDim.x * gridDim.y * gridDim.z;
    unsigned sum, cnt, mine, sp = 0u;
    for (;;) {
        sum = 0u; cnt = 0u; mine = 0u;
#pragma unroll
        for (unsigned j = 0; j < 16; ++j) { const unsigned c = xb_ld(&bar[XB_XCNT(j)]); sum += c; cnt += (c > 0u) ? 1u : 0u; mine = (j == x) ? c : mine; }
        if (sum == G) break;
        __builtin_amdgcn_s_sleep(1);
        if ((++sp & 255u) == 0u) { if (xb_ld(&bar[XB_TMO])) break; if (sp > XB_SPIN_CAP) { atomicAdd(&bar[XB_TMO], 1u); break; } }
    }
    nloc = mine > 0u ? mine : 1u; nx = cnt > 0u ? cnt : 1u;
}

__device__ __forceinline__ void xcd_barrier(const XcdBarrier& b) {
    asm volatile("s_waitcnt vmcnt(0)" ::: "memory");
    __syncthreads();
    if (threadIdx.x == 0) {
        unsigned* bar = b.bar;
        __builtin_amdgcn_s_waitcnt(0);
        unsigned nloc = b.st[0], nx = b.st[1];
        if (nloc == 0u) { xcd_barrier_complete(bar, b.x, nloc, nx); b.st[0] = nloc; b.st[1] = nx; }
        const unsigned old = xb_add(&bar[XB_XSUB(b.x)], 1u);
        const unsigned gen = old / nloc;
        if (old + 1u == (gen + 1u) * nloc) {
            __builtin_amdgcn_fence(__ATOMIC_RELEASE, "agent");
            asm volatile("s_waitcnt vmcnt(0)" ::: "memory");
            const unsigned og = xb_add(&bar[XB_TOP], 1u);
            const unsigned tg = og / nx;
            if (og + 1u == (tg + 1u) * nx) xb_add(&bar[XB_TOPGEN], 1u);
            else XB_SPIN(xb_ld(&bar[XB_TOPGEN]) == tg, bar);
            __builtin_amdgcn_fence(__ATOMIC_ACQUIRE, "agent");
            xb_add(&bar[XB_XGEN(b.x)], 1u);
            asm volatile("s_waitcnt vmcnt(0)" ::: "memory");
        } else {
            XB_SPIN(xb_ld(&bar[XB_XGEN(b.x)]) == gen, bar);
            __builtin_amdgcn_fence(__ATOMIC_ACQUIRE, "agent");
            asm volatile("s_waitcnt vmcnt(0)" ::: "memory");
        }
    }
    __syncthreads();
}
struct EpiPlain {
    static constexpr bool PERM = true, AFTER_DRAIN = false;
    bf16_t* O; int ldc;
    __device__ __forceinline__ void operator()(const f32x4 (&acc)[2][2][4][2], const Unit& u, int wr, int wc, int fr, int fq) const {
        const int row0 = u.pm * 256 + wr * 64 + fr, col0 = u.pn * 256 + wc * 32 + 8 * fq;
#pragma unroll
        for (int ai = 0; ai < 2; ++ai)
#pragma unroll
            for (int m = 0; m < 4; ++m) { bf16_t* rowp = O + (size_t)(row0 + ai * 128 + m * 16) * ldc + col0;
#pragma unroll
                for (int bj = 0; bj < 2; ++bj) { const f32x4 v0 = acc[ai][bj][m][0], v1 = acc[ai][bj][m][1]; u32x4 w;
                    w.x = cvt_pk_bf16(v0[0], v0[1]); w.y = cvt_pk_bf16(v0[2], v0[3]); w.z = cvt_pk_bf16(v1[0], v1[1]); w.w = cvt_pk_bf16(v1[2], v1[3]);
                    *(u32x4*)(rowp + bj * 128) = w; } }
    }
};
struct EpiSwiglu {
    static constexpr bool PERM = true, AFTER_DRAIN = false;
    bf16_t* O; const float* ss;
    __device__ __forceinline__ void operator()(const f32x4 (&acc)[2][2][4][2], const Unit& u, int wr, int wc, int fr, int fq) const {
        const int row0 = u.pm * 256 + wr * 64 + fr, col0 = u.pn * 128 + wc * 32 + 8 * fq;
#pragma unroll
        for (int ai = 0; ai < 2; ++ai)
#pragma unroll
            for (int m = 0; m < 4; ++m) { const int row = row0 + ai * 128 + m * 16; const float rs = row_rs(ss, row);
                float o[8];
#pragma unroll
                for (int n = 0; n < 2; ++n)
#pragma unroll
                    for (int e = 0; e < 4; ++e) { const float g = acc[ai][0][m][n][e] * rs, up = acc[ai][1][m][n][e] * rs; o[n * 4 + e] = g * sigm(g) * up; }
                u32x4 w; w.x = cvt_pk_bf16(o[0], o[1]); w.y = cvt_pk_bf16(o[2], o[3]); w.z = cvt_pk_bf16(o[4], o[5]); w.w = cvt_pk_bf16(o[6], o[7]);
                *(u32x4*)(O + (size_t)row * FF + col0) = w; }
    }
};
struct EpiResid {
    static constexpr bool PERM = true, AFTER_DRAIN = false;
    const float* xold; float* xnew; bf16_t* xb; float* ssn; float alpha;
    __device__ __forceinline__ void operator()(const f32x4 (&acc)[2][2][4][2], const Unit& u, int wr, int wc, int fr, int fq) const {
        const int row0 = u.pm * 256 + wr * 64 + fr, col0 = u.pn * 256 + wc * 32 + 8 * fq;
#pragma unroll
        for (int ai = 0; ai < 2; ++ai)
#pragma unroll
            for (int m = 0; m < 4; ++m) { const int row = row0 + ai * 128 + m * 16; float s = 0.f;
#pragma unroll
                for (int bj = 0; bj < 2; ++bj) { const size_t off = (size_t)row * D + col0 + bj * 128;
                    const f32x4 xo0 = *(const f32x4*)(xold + off), xo1 = *(const f32x4*)(xold + off + 4);
                    const f32x4 xn0 = xo0 + acc[ai][bj][m][0] * alpha, xn1 = xo1 + acc[ai][bj][m][1] * alpha;
                    *(f32x4*)(xnew + off) = xn0; *(f32x4*)(xnew + off + 4) = xn1;
                    s += ((xn0[0] * xn0[0] + xn0[1] * xn0[1]) + (xn0[2] * xn0[2] + xn0[3] * xn0[3])) + ((xn1[0] * xn1[0] + xn1[1] * xn1[1]) + (xn1[2] * xn1[2] + xn1[3] * xn1[3]));
                    u32x4 w; w.x = cvt_pk_bf16(xn0[0], xn0[1]); w.y = cvt_pk_bf16(xn0[2], xn0[3]); w.z = cvt_pk_bf16(xn1[0], xn1[1]); w.w = cvt_pk_bf16(xn1[2], xn1[3]); *(u32x4*)(xb + off) = w; }
                s += __shfl_xor(s, 16); s += __shfl_xor(s, 32);
                if (fq == 0) ssn[(size_t)row * 16 + u.pn * 4 + wc] = s; }
    }
};
struct EpiHeadNorm {
    static constexpr bool PERM = true, AFTER_DRAIN = false;
    bf16_t* O; int ldc; const float* ss; const float* gain; int nnorm; float scale;
    __device__ __forceinline__ void operator()(const f32x4 (&acc)[2][2][4][2], const Unit& u, int wr, int wc, int fr, int fq) const {
        const int row0 = u.pm * 256 + wr * 64 + fr; const int head = u.pn * 4 + wc; const bool normed = head < nnorm; const int g = (head >> 4) % 3;
        float gn[2][8];
#pragma unroll
        for (int bj = 0; bj < 2; ++bj)
#pragma unroll
            for (int j = 0; j < 8; ++j) gn[bj][j] = normed ? gain[g * 64 + bj * 32 + 8 * fq + j] * scale : 1.f;
#pragma unroll
        for (int ai = 0; ai < 2; ++ai)
#pragma unroll
            for (int m = 0; m < 4; ++m) { const int row = row0 + ai * 128 + m * 16; const float rs = row_rs(ss, row);
                float v[2][8]; float s = 0.f;
#pragma unroll
                for (int bj = 0; bj < 2; ++bj)
#pragma unroll
                    for (int n = 0; n < 2; ++n)
#pragma unroll
                        for (int e = 0; e < 4; ++e) { const float x = acc[ai][bj][m][n][e] * rs; v[bj][n * 4 + e] = x; s += x * x; }
                s += __shfl_xor(s, 16); s += __shfl_xor(s, 32);
                const float inv = normed ? rsqrtf(s * (1.f / 64.f) + RMS_EPS) : 1.f;
#pragma unroll
                for (int bj = 0; bj < 2; ++bj) { float o[8];
#pragma unroll
                    for (int j = 0; j < 8; ++j) o[j] = v[bj][j] * inv * gn[bj][j];
                    u32x4 w; w.x = cvt_pk_bf16(o[0], o[1]); w.y = cvt_pk_bf16(o[2], o[3]); w.z = cvt_pk_bf16(o[4], o[5]); w.w = cvt_pk_bf16(o[6], o[7]);
                    const int hh = head % 48, pg_ = hh >> 4, sh_ = 2 * pg_; const int pos = (row & ((1 << sh_) - 1)) * (T >> sh_) + (row >> sh_);
                    *(u32x4*)(O + (head >= 48 ? (size_t)48 * T * 64 : (size_t)0) + ((size_t)hh * T + pos) * 64 + bj * 32 + 8 * fq) = w; } }
    }
};
struct MatDesc { const float* W; int K, N; bf16_t* dst; int dstK, row_off, maptype; const float* s1; const float* s2; int s2mode; };
__device__ __forceinline__ int map_row(int maptype, int n) {
    if (maptype == 1) { const int u = n % FF, isup = n / FF; return (u >> 7) * 256 + isup * 128 + (u & 127); }
    if (maptype == 2) { const int tile = n >> 8, w = n & 255, head = w >> 6, d = w & 63; return tile * 256 + (d >> 5) * 128 + head * 32 + (d & 31); }
    return n;
}
struct ConvRegs { f32x4 v[2]; float sc[2]; };
__device__ __forceinline__ void conv_load(const MatDesc& md, int tile, ConvRegs& R) {
    const int tid = pg8::opq_tid(); const int ntn = (md.N + 63) >> 6; const int kt = tile / ntn, nt = tile - kt * ntn; const int k0 = kt * 64, n0 = nt * 64;
#pragma unroll
    for (int p = 0; p < 2; ++p) { const int kk = p * 32 + (tid >> 4), nn = (tid & 15) * 4, k = k0 + kk;
        f32x4 v = {0.f, 0.f, 0.f, 0.f}; float sc = 1.f;
        if (k < md.K) { if (n0 + nn < md.N) v = *(const f32x4*)(md.W + (size_t)k * md.N + n0 + nn);
            if (md.s1) sc = md.s1[k]; if (md.s2mode == 1) sc *= md.s2[k]; else if (md.s2mode == 2) sc *= (1.f - md.s2[k]); }
        R.v[p] = v; R.sc[p] = sc; }
}
__device__ __forceinline__ void conv_store(const MatDesc& md, int tile, const ConvRegs& R, float* tl) {
    const int tid = pg8::opq_tid(); const int ntn = (md.N + 63) >> 6; const int kt = tile / ntn, nt = tile - kt * ntn; const int k0 = kt * 64, n0 = nt * 64;
#pragma unroll
    for (int p = 0; p < 2; ++p) { const int kk = p * 32 + (tid >> 4), nn = (tid & 15) * 4; const f32x4 v = R.v[p]; const float sc = R.sc[p];
        tl[kk * 65 + nn + 0] = v[0] * sc; tl[kk * 65 + nn + 1] = v[1] * sc; tl[kk * 65 + nn + 2] = v[2] * sc; tl[kk * 65 + nn + 3] = v[3] * sc; }
    asm volatile("s_waitcnt lgkmcnt(0)" ::: "memory"); __builtin_amdgcn_s_barrier(); asm volatile("" ::: "memory");
    { const int n = tid >> 3, kc = tid & 7;
      if (n0 + n < md.N && k0 + kc * 8 < md.dstK) { float o[8];
#pragma unroll
          for (int j = 0; j < 8; ++j) o[j] = tl[(kc * 8 + j) * 65 + n];
          u32x4 w; w.x = cvt_pk_bf16(o[0], o[1]); w.y = cvt_pk_bf16(o[2], o[3]); w.z = cvt_pk_bf16(o[4], o[5]); w.w = cvt_pk_bf16(o[6], o[7]);
          const int drow = md.row_off + map_row(md.maptype, n0 + n);
          *(u32x4*)(md.dst + (size_t)drow * md.dstK + k0 + kc * 8) = w; } }
    asm volatile("s_waitcnt lgkmcnt(0)" ::: "memory"); __builtin_amdgcn_s_barrier(); asm volatile("" ::: "memory");
}
__device__ __forceinline__ bool get_mat(const Args& a, int mi, MatDesc& md) {
    unsigned char* ws = pg8::opq_ptr(a.ws); md.s1 = nullptr; md.s2 = nullptr; md.s2mode = 0; md.row_off = 0; md.maptype = 0;
    if (mi < 8) { md.W = a.in[2] + (size_t)mi * 1024 * 5632; md.K = 1024; md.N = 5632; md.dst = (bf16_t*)(ws + WS_WIN + mi * SZ_WIN); md.dstK = 1024; md.maptype = 1; md.s1 = a.in[1] + mi * 1024; return true; }
    mi -= 8;
    if (mi < 8) { md.W = a.in[3] + (size_t)mi * 2816 * 1024; md.K = 2816; md.N = 1024; md.dst = (bf16_t*)(ws + WS_WOUT + mi * SZ_WOUT); md.dstK = 2816; return true; }
    mi -= 8;
    if (mi < 38) { const int l = mi / 19, r = mi % 19;
        if (r < 14) { const int part = r / 7, s = r % 7; md.K = 1024; md.dstK = 1024; md.dst = (bf16_t*)(ws + WS_WCAT + l * SZ_WCAT); md.s1 = a.in[4] + l * 1024; md.s2mode = part ? 1 : 2;
            const float* mu = a.in[5] + (size_t)l * 6 * 1024; int off;
            if (s == 0) { md.W = a.in[6] + (size_t)(l * 3 + 0) * 1024 * 1024; md.N = 1024; md.s2 = mu + 0 * 1024; off = 0; }
            else if (s == 1) { md.W = a.in[6] + (size_t)(l * 3 + 1) * 1024 * 1024; md.N = 1024; md.s2 = mu + 2 * 1024; off = 1024; }
            else if (s == 2) { md.W = a.in[6] + (size_t)(l * 3 + 2) * 1024 * 1024; md.N = 1024; md.s2 = mu + 3 * 1024; off = 2048; }
            else if (s == 3) { md.W = a.in[8] + (size_t)l * 1024 * 64; md.N = 64; md.s2 = mu + 1 * 1024; off = 3072; }
            else if (s == 4) { md.W = a.in[11] + (size_t)l * 1024 * 64; md.N = 64; md.s2 = mu + 4 * 1024; off = 3136; }
            else if (s == 5) { if (l == 0) return false; md.W = a.in[14]; md.N = 32; md.s2 = mu + 3 * 1024; off = 3200; }
            else { md.W = a.in[16] + (size_t)l * 1024 * 64; md.N = 64; md.s2 = mu + 5 * 1024; off = 3232; }
            md.row_off = off + part * HALFCAT; return true; }
        if (r == 14) { md.W = a.in[23] + (size_t)l * 1024 * 1024; md.K = 1024; md.N = 1024; md.dst = (bf16_t*)(ws + WS_WOR + l * SZ_SQ); md.dstK = 1024; return true; }
        const int ui = r - 15; md.N = 1024; md.dstK = 64; md.K = 64; md.dst = (bf16_t*)(ws + WS_WUP + (size_t)(l * 4 + ui) * SZ_UP);
        if (ui == 0) md.W = a.in[9] + (size_t)l * 64 * 1024;
        else if (ui == 1) md.W = a.in[12] + (size_t)l * 64 * 1024;
        else if (ui == 2) { if (l == 0) return false; md.W = a.in[15]; md.K = 32; }
        else md.W = a.in[17] + (size_t)l * 64 * 1024;
        return true; }
    mi -= 38;
    if (mi == 0) { md.W = a.in[25]; md.K = 1024; md.N = KVW; md.dst = (bf16_t*)(ws + WS_WKV); md.dstK = 1024; md.maptype = 2; md.s1 = a.in[24]; return true; }
    mi -= 1;
    if (mi < 2) { md.W = a.in[27] + (size_t)mi * 1024 * QW; md.K = 1024; md.N = QW; md.dst = (bf16_t*)(ws + WS_WQ + mi * SZ_WQ); md.dstK = 1024; md.maptype = 2; md.s1 = a.in[4] + (2 + mi) * 1024; return true; }
    mi -= 2;
    md.W = a.in[29] + (size_t)mi * 1024 * 1024; md.K = 1024; md.N = 1024; md.dst = (bf16_t*)(ws + WS_WOA + mi * SZ_SQ); md.dstK = 1024; return true;
}
constexpr int NMAT = 8 + 8 + 38 + 1 + 2 + 2;
__device__ __forceinline__ void zero_rows(bf16_t* base, int row0, int nrows) {
    const int gt = pg8::opq_bid() * 512 + pg8::opq_tid(), NT = gridDim.x * 512;
    for (int i = gt; i < nrows * 128; i += NT) *(u32x4*)(base + (size_t)row0 * 1024 + (size_t)i * 8) = (u32x4){0u, 0u, 0u, 0u};
}
__device__ __forceinline__ int conv_sel(int mi) {
    if (mi < 16) { const int idx = mi & 7; return idx == 0 ? 0 : (idx < 4 ? 1 : 2); }
    if (mi < 54) return (mi - 16) / 19;
    return 2;
}
__device__ __forceinline__ void p0_convert(const Args& a, float* tl, int sel, int vbid, int vG) {
    for (int mi = 0; mi < NMAT; ++mi) { if (conv_sel(mi) != sel) continue; MatDesc md; if (!get_mat(a, mi, md)) continue;
        const int ntiles = ((md.K + 63) >> 6) * ((md.N + 63) >> 6);
        const int G = vG; int tile = (vbid + mi * 37) % G; ConvRegs R[4];
#pragma unroll
        for (int k = 0; k < 4; ++k) if (tile + k * G < ntiles) conv_load(md, tile + k * G, R[k]);
        for (; tile < ntiles; tile += 4 * G) {
#pragma unroll
            for (int k = 0; k < 4; ++k) { const int tk = tile + k * G; if (tk < ntiles) { conv_store(md, tk, R[k], tl); const int tn = tk + 4 * G; if (tn < ntiles) conv_load(md, tn, R[k]); } } } }
}
__device__ __forceinline__ void p0_phase(const Args& a, float* tl) {
    unsigned char* ws = pg8::opq_ptr(a.ws);
    p0_convert(a, tl, 0, pg8::opq_bid(), gridDim.x);
    if (gridDim.x <= 64) { p0_convert(a, tl, 1, pg8::opq_bid(), gridDim.x); p0_convert(a, tl, 2, pg8::opq_bid(), gridDim.x); }
    for (int l = 0; l < 2; ++l) { bf16_t* wc = (bf16_t*)(ws + WS_WCAT + l * SZ_WCAT);
        zero_rows(wc, 3296, 32); zero_rows(wc, HALFCAT + 3296, 32);
        if (l == 0) { zero_rows(wc, 3200, 32); zero_rows(wc, HALFCAT + 3200, 32); } }
    { const int gw = pg8::opq_bid() * 8 + (pg8::opq_tid() >> 6), NGW = gridDim.x * 8, lane = pg8::opq_tid() & 63;
      const float* x = a.in[0]; bf16_t* xb = (bf16_t*)(ws + WS_XB); float* ss = (float*)(ws + WS_SS);
      for (int m = gw; m < T; m += NGW) { float s = 0.f;
#pragma unroll
          for (int j = 0; j < 4; ++j) { const f32x4 v = *(const f32x4*)(x + (size_t)m * D + j * 256 + lane * 4); s += (v[0] * v[0] + v[1] * v[1]) + (v[2] * v[2] + v[3] * v[3]);
              u32x2 w; w.x = cvt_pk_bf16(v[0], v[1]); w.y = cvt_pk_bf16(v[2], v[3]); *(u32x2*)(xb + (size_t)m * D + j * 256 + lane * 4) = w; }
#pragma unroll
          for (int o = 1; o < 64; o <<= 1) s += __shfl_xor(s, o);
          if (lane < 16) ss[(size_t)m * 16 + lane] = lane == 0 ? s : 0.f; }
    }
}
#define MFMA16(a, b, c) __builtin_amdgcn_mfma_f32_16x16x32_bf16((a), (b), (c), 0, 0, 0)
__device__ __forceinline__ void ld8(const bf16_t* p, float (&o)[8]) { const u32x4 w = *(const u32x4*)p; o[0] = bflo(w.x); o[1] = bfhi(w.x); o[2] = bflo(w.y); o[3] = bfhi(w.y); o[4] = bflo(w.z); o[5] = bfhi(w.z); o[6] = bflo(w.w); o[7] = bfhi(w.w); }
__device__ __forceinline__ void ld4(const bf16_t* p, float (&o)[4]) { const u32x2 w = *(const u32x2*)p; o[0] = bflo(w.x); o[1] = bfhi(w.x); o[2] = bflo(w.y); o[3] = bfhi(w.y); }
__device__ __forceinline__ void up8(const u32x4 w, float (&o)[8]) { o[0] = bflo(w.x); o[1] = bfhi(w.x); o[2] = bflo(w.y); o[3] = bfhi(w.y); o[4] = bflo(w.z); o[5] = bfhi(w.z); o[6] = bflo(w.w); o[7] = bfhi(w.w); }
__device__ __forceinline__ void up4(const u32x2 w, float (&o)[4]) { o[0] = bflo(w.x); o[1] = bfhi(w.x); o[2] = bflo(w.y); o[3] = bfhi(w.y); }
__device__ __forceinline__ bf16x8 pack8(const float (&o)[8]) { u32x4 w; w.x = cvt_pk_bf16(o[0], o[1]); w.y = cvt_pk_bf16(o[2], o[3]); w.z = cvt_pk_bf16(o[4], o[5]); w.w = cvt_pk_bf16(o[6], o[7]); return __builtin_bit_cast(bf16x8, w); }
__device__ __forceinline__ void st4(bf16_t* p, float a, float b, float c, float d) { u32x2 w; w.x = cvt_pk_bf16(a, b); w.y = cvt_pk_bf16(c, d); *(u32x2*)p = w; }

__device__ __forceinline__ void f1_phase(const Args& a, int l, unsigned char* lds) {
    unsigned char* ws = pg8::opq_ptr(a.ws); const int lane = pg8::opq_tid() & 63, wave = pg8::opq_tid() >> 6; const int gw = pg8::opq_bid() * 8 + wave, NGW = gridDim.x * 8;
    const int tok = lane & 15, q = lane >> 4;
    const bf16_t* P = (const bf16_t*)(ws + WS_BIG); const float* ss = (const float*)(ws + WS_SS) + (size_t)(3 * l + 1) * T * 16;
    const bf16_t* WUP = (const bf16_t*)(ws + WS_WUP + (size_t)l * 4 * SZ_UP);
    bf16_t* oR = (bf16_t*)(ws + WS_MIX); bf16_t* oLD = oR + (size_t)T * D; bf16_t* oK = oLD + (size_t)T * D; bf16_t* oA = oK + (size_t)T * D; bf16_t* oB = oA + (size_t)T * D;
    bf16_t* oV0 = oB + (size_t)T * D; bf16_t* oV1 = oV0 + (size_t)T * D; bf16_t* oG = oV1 + (size_t)T * D;
    bf16_t* oV = l ? oV1 : oV0;
    const float* w0 = a.in[7] + l * D; const float* a0 = a.in[10] + l * D; const float* v0 = a.in[13]; const float* kkp = a.in[18] + l * D; const float* kap = a.in[19] + l * D;
    const int bidf = pg8::opq_bid(); const int h = bidf & 15, grp = bidf >> 4, ngrp = gridDim.x >> 4; (void)gw; (void)NGW;
    bf16_t* wl = (bf16_t*)lds; float* pl = (float*)(lds + 4 * 64 * 72 * 2);
    { const int tidf = pg8::opq_tid();
      for (int i = tidf; i < 4 * 64 * 8; i += 512) { const int m = i >> 9, r = (i >> 3) & 63, c8 = (i & 7) * 8;
          u32x4 v = {0u, 0u, 0u, 0u}; if (m != 2 || l) v = *(const u32x4*)(WUP + (size_t)m * 1024 * 64 + (size_t)(h * 64 + r) * 64 + c8);
          *(u32x4*)(wl + (m * 64 + r) * 72 + c8) = v; }
      if (tidf < 320) { const int m = tidf >> 6, c = tidf & 63; float v = 0.f;
          if (m == 0) v = w0[h * 64 + c]; else if (m == 1) v = a0[h * 64 + c]; else if (m == 2) { if (l) v = v0[h * 64 + c]; } else if (m == 3) v = kkp[h * 64 + c]; else v = kap[h * 64 + c];
          pl[m * 64 + c] = v; } }
    __syncthreads();
    bf16_t* stg = (bf16_t*)(lds + 38400 + wave * 12288);
    for (int tt = grp * 8 + wave; tt < T / 16 && grp < ngrp; tt += ngrp * 8) {
        const int t = tt * 16 + tok;
        const float rs_c = row_rs(ss, t); const float rs_p = t > 0 ? row_rs(ss, t > 0 ? t - 1 : 0) : 0.f;
        const bf16_t* Pc = P + (size_t)t * NCAT; const bf16_t* Pp = P + (size_t)(t > 0 ? t - 1 : 0) * NCAT + HALFCAT;
        u32x4 Lw[2][2], La[2][2], Lg[2][2], Lv[2]; u32x2 Lr[4][2], Lk[4][2], Lvv[4][2], Lvf[4];
#pragma unroll
        for (int ks = 0; ks < 2; ++ks) { const int ko = ks * 32 + q * 8;
            Lw[ks][0] = *(const u32x4*)(Pc + 3072 + ko); Lw[ks][1] = *(const u32x4*)(Pp + 3072 + ko); La[ks][0] = *(const u32x4*)(Pc + 3136 + ko); La[ks][1] = *(const u32x4*)(Pp + 3136 + ko);
            Lg[ks][0] = *(const u32x4*)(Pc + 3232 + ko); Lg[ks][1] = *(const u32x4*)(Pp + 3232 + ko); }
        Lv[0] = *(const u32x4*)(Pc + 3200 + q * 8); Lv[1] = *(const u32x4*)(Pp + 3200 + q * 8);
        { const int srow = lane >> 3, ch8 = (lane & 7) * 8; const int t0 = tt * 16; u32x4 sv[6][2];
#pragma unroll
          for (int a6 = 0; a6 < 6; ++a6)
#pragma unroll
              for (int hf = 0; hf < 2; ++hf) { int tr = t0 + 8 * hf + srow - (a6 & 1); tr = tr < 0 ? 0 : tr;
                  sv[a6][hf] = *(const u32x4*)(P + (size_t)tr * NCAT + (a6 & 1) * HALFCAT + (a6 >> 1) * 1024 + h * 64 + ch8); }
#pragma unroll
          for (int a6 = 0; a6 < 6; ++a6)
#pragma unroll
              for (int hf = 0; hf < 2; ++hf) *(u32x4*)(stg + (a6 * 16 + 8 * hf + srow) * 64 + ch8) = sv[a6][hf];
          asm volatile("s_waitcnt lgkmcnt(0)" ::: "memory"); }
#pragma unroll
        for (int nt = 0; nt < 4; ++nt) { const int c0 = h * 64 + nt * 16 + 4 * q; const int cl4 = nt * 16 + 4 * q;
            Lr[nt][0] = *(const u32x2*)(stg + (0 * 16 + tok) * 64 + cl4); Lr[nt][1] = *(const u32x2*)(stg + (1 * 16 + tok) * 64 + cl4);
            Lk[nt][0] = *(const u32x2*)(stg + (2 * 16 + tok) * 64 + cl4); Lk[nt][1] = *(const u32x2*)(stg + (3 * 16 + tok) * 64 + cl4);
            Lvv[nt][0] = *(const u32x2*)(stg + (4 * 16 + tok) * 64 + cl4); Lvv[nt][1] = *(const u32x2*)(stg + (5 * 16 + tok) * 64 + cl4);
            Lvf[nt] = (u32x2){0u, 0u}; if (l) Lvf[nt] = *(const u32x2*)(oV0 + (size_t)t * D + c0); }
        asm volatile("s_waitcnt lgkmcnt(0)" ::: "memory");
        bf16x8 actW[2], actA[2], actG[2], actV;
#pragma unroll
        for (int ks = 0; ks < 2; ++ks) { float c[8], p[8], x[8];
            up8(Lw[ks][0], c); up8(Lw[ks][1], p);
#pragma unroll
            for (int j = 0; j < 8; ++j) x[j] = tanh_fast(rs_c * c[j] + rs_p * p[j]);
            actW[ks] = pack8(x);
            up8(La[ks][0], c); up8(La[ks][1], p);
#pragma unroll
            for (int j = 0; j < 8; ++j) x[j] = rs_c * c[j] + rs_p * p[j];
            actA[ks] = pack8(x);
            up8(Lg[ks][0], c); up8(Lg[ks][1], p);
#pragma unroll
            for (int j = 0; j < 8; ++j) x[j] = sigm(rs_c * c[j] + rs_p * p[j]);
            actG[ks] = pack8(x); }
        { float c[8], p[8], x[8]; up8(Lv[0], c); up8(Lv[1], p);
#pragma unroll
          for (int j = 0; j < 8; ++j) x[j] = rs_c * c[j] + rs_p * p[j];
          actV = pack8(x); }
        f32x4 Dw[4], Da[4], Dv[4], Dg[4];
#pragma unroll
        for (int nt = 0; nt < 4; ++nt) { const f32x4 z = {0.f, 0.f, 0.f, 0.f}; Dw[nt] = z; Da[nt] = z; Dv[nt] = z; Dg[nt] = z;
            const int wo = (nt * 16 + tok) * 72 + q * 8;
#pragma unroll
            for (int ks = 0; ks < 2; ++ks) {
                Dw[nt] = MFMA16(*(const bf16x8*)(wl + wo + ks * 32), actW[ks], Dw[nt]);
                Da[nt] = MFMA16(*(const bf16x8*)(wl + 64 * 72 + wo + ks * 32), actA[ks], Da[nt]);
                Dg[nt] = MFMA16(*(const bf16x8*)(wl + 3 * 64 * 72 + wo + ks * 32), actG[ks], Dg[nt]); }
            if (l) Dv[nt] = MFMA16(*(const bf16x8*)(wl + 2 * 64 * 72 + wo), actV, Dv[nt]);
            __builtin_amdgcn_sched_barrier(0); }
        float kkv[4][4], asg[4][4]; float ssq = 0.f;
#pragma unroll
        for (int nt = 0; nt < 4; ++nt) { const int c0 = h * 64 + nt * 16 + 4 * q; const size_t off = (size_t)t * D + c0;
            float rc[4], rp[4], kc[4], kp[4], vc[4], vp[4];
            up4(Lr[nt][0], rc); up4(Lr[nt][1], rp); up4(Lk[nt][0], kc); up4(Lk[nt][1], kp); up4(Lvv[nt][0], vc); up4(Lvv[nt][1], vp);
            const int cl = nt * 16 + 4 * q; const f32x4 w0v = *(const f32x4*)(pl + cl), a0v = *(const f32x4*)(pl + 64 + cl), kkw = *(const f32x4*)(pl + 192 + cl), kaw = *(const f32x4*)(pl + 256 + cl);
            float vf[4] = {0.f, 0.f, 0.f, 0.f}; f32x4 v0v = {0.f, 0.f, 0.f, 0.f};
            if (l) { up4(Lvf[nt], vf); v0v = *(const f32x4*)(pl + 128 + cl); }
            float ro[4], ldo[4], ko[4], vo[4], go[4];
#pragma unroll
            for (int e = 0; e < 4; ++e) {
                const float rr = rs_c * rc[e] + rs_p * rp[e], kx = rs_c * kc[e] + rs_p * kp[e]; float vx = rs_c * vc[e] + rs_p * vp[e];
                const float wl = w0v[e] + Dw[nt][e]; const float xx = -wl; const float sp = fmaxf(xx, 0.f) + __logf(1.f + __expf(-fabsf(xx)));
                ldo[e] = -__expf(-sp - 0.5f);
                const float as = sigm(a0v[e] + Da[nt][e]);
                if (l) vx = vx + (vf[e] - vx) * sigm(v0v[e] + Dv[nt][e]);
                const float kk = kx * kkw[e]; ssq += kk * kk; kkv[nt][e] = kk; asg[nt][e] = as;
                ro[e] = rr; ko[e] = kx * (1.f + (as - 1.f) * kaw[e]); vo[e] = vx; go[e] = Dg[nt][e]; }
            { const int so = tok * 64 + nt * 16 + 4 * q; (void)off;
              st4(stg + 0 * 1024 + so, ro[0], ro[1], ro[2], ro[3]); st4(stg + 1 * 1024 + so, ldo[0], ldo[1], ldo[2], ldo[3]); st4(stg + 2 * 1024 + so, ko[0], ko[1], ko[2], ko[3]);
              st4(stg + 3 * 1024 + so, vo[0], vo[1], vo[2], vo[3]); st4(stg + 4 * 1024 + so, go[0], go[1], go[2], go[3]); } }
        asm volatile("s_waitcnt lgkmcnt(0)" ::: "memory");
        { const int srow = lane >> 3, ch8 = (lane & 7) * 8;
#define F1_OUT(ptr, sl) do { _Pragma("unroll") for (int hf = 0; hf < 2; ++hf) *(u32x4*)((ptr) + (size_t)(tt * 16 + 8 * hf + srow) * D + h * 64 + ch8) = *(const u32x4*)(stg + (sl) * 1024 + (8 * hf + srow) * 64 + ch8); } while (0)
          F1_OUT(oR, 0); F1_OUT(oLD, 1); F1_OUT(oK, 2); F1_OUT(oV, 3); F1_OUT(oG, 4); }
        asm volatile("s_waitcnt lgkmcnt(0)" ::: "memory");
        ssq += __shfl_xor(ssq, 16); ssq += __shfl_xor(ssq, 32);
        const float inv = 1.f / fmaxf(sqrtf(ssq), 1e-12f);
#pragma unroll
        for (int nt = 0; nt < 4; ++nt) { const size_t off = (size_t)t * D + h * 64 + nt * 16 + 4 * q;
            float av[4], bv[4];
#pragma unroll
            for (int e = 0; e < 4; ++e) { const float kn = kkv[nt][e] * inv; av[e] = -kn; bv[e] = kn * asg[nt][e]; }
            { const int so = tok * 64 + nt * 16 + 4 * q; (void)off; st4(stg + so, av[0], av[1], av[2], av[3]); st4(stg + 1024 + so, bv[0], bv[1], bv[2], bv[3]); } }
        asm volatile("s_waitcnt lgkmcnt(0)" ::: "memory");
        { const int srow = lane >> 3, ch8 = (lane & 7) * 8; F1_OUT(oA, 0); F1_OUT(oB, 1); }
        asm volatile("s_waitcnt lgkmcnt(0)" ::: "memory");
    }
}

__device__ __forceinline__ void rseq_phase(const Args& a, int l, float* lds) {
    if (pg8::opq_bid() >= 16) return;
    unsigned char* ws = pg8::opq_ptr(a.ws); const int tid = pg8::opq_tid(), h = pg8::opq_bid();
    const bf16_t* base = (const bf16_t*)(ws + WS_MIX);
    float* Y = (float*)(ws + WS_BIG + BIG_Y);
    const int row = tid >> 2, cgp = tid & 3;
    float s[16];
#pragma unroll
    for (int j = 0; j < 16; ++j) s[j] = 0.f;
    for (int c0 = 0; c0 < T; c0 += 16) {
        __syncthreads();
#pragma unroll
        for (int i = 0; i < 12; ++i) { const int idx = tid + i * 512; const int arr = idx >> 10, rem = idx & 1023, st = rem >> 6, j = rem & 63;
            const int ga = arr == 5 ? (5 + l) : arr;
            float v = bf2f(base[(size_t)ga * T * D + (size_t)(c0 + st) * D + h * 64 + j]); if (arr == 1) v = __expf(v);
            lds[idx] = v; }
        __syncthreads();
        if (tid < 256) {
#pragma unroll 4
            for (int st = 0; st < 16; ++st) {
                const float* pR = lds + 0 * 1024 + st * 64 + cgp * 16; const float* pD = lds + 1 * 1024 + st * 64 + cgp * 16; const float* pK = lds + 2 * 1024 + st * 64 + cgp * 16;
                const float* pA = lds + 3 * 1024 + st * 64 + cgp * 16; const float* pB = lds + 4 * 1024 + st * 64 + cgp * 16;
                const float vv = lds[5 * 1024 + st * 64 + row];
                float sa = 0.f;
#pragma unroll
                for (int j = 0; j < 16; ++j) sa += s[j] * pA[j];
                sa += __shfl_xor(sa, 1); sa += __shfl_xor(sa, 2);
                float y = 0.f;
#pragma unroll
                for (int j = 0; j < 16; ++j) { s[j] = s[j] * pD[j] + sa * pB[j] + vv * pK[j]; y += s[j] * pR[j]; }
                y += __shfl_xor(y, 1); y += __shfl_xor(y, 2);
                if (cgp == 0) Y[(size_t)(c0 + st) * D + h * 64 + row] = y;
            }
        }
    }
}

__device__ __forceinline__ void f2_phase(const Args& a, int l) {
    unsigned char* ws = pg8::opq_ptr(a.ws); const int lane = pg8::opq_tid() & 63; const int gw = pg8::opq_bid() * 8 + (pg8::opq_tid() >> 6), NGW = gridDim.x * 8;
    const bf16_t* base = (const bf16_t*)(ws + WS_MIX); const float* Y = (const float*)(ws + WS_BIG + BIG_Y); bf16_t* YG = (bf16_t*)(ws + WS_BIG + BIG_YG);
    const bf16_t* pR = base; const bf16_t* pK = base + (size_t)2 * T * D; const bf16_t* pV = base + (size_t)(5 + l) * T * D; const bf16_t* pG = base + (size_t)7 * T * D;
    const float* lnw = a.in[21] + l * D; const float* lnb = a.in[22] + l * D; const float* rk = a.in[20] + l * D;
    const int c0 = lane * 16;
    for (int t = gw; t < T; t += NGW) { const size_t off = (size_t)t * D + c0;
        float y[16], r[16], k[16], v[16], g[16];
#pragma unroll
        for (int j = 0; j < 4; ++j) { const f32x4 yy = *(const f32x4*)(Y + off + j * 4); y[j * 4] = yy[0]; y[j * 4 + 1] = yy[1]; y[j * 4 + 2] = yy[2]; y[j * 4 + 3] = yy[3]; }
        { float tmp[8]; ld8(pR + off, tmp);
#pragma unroll
          for (int j = 0; j < 8; ++j) r[j] = tmp[j];
          ld8(pR + off + 8, tmp);
#pragma unroll
          for (int j = 0; j < 8; ++j) r[8 + j] = tmp[j];
          ld8(pK + off, tmp);
#pragma unroll
          for (int j = 0; j < 8; ++j) k[j] = tmp[j];
          ld8(pK + off + 8, tmp);
#pragma unroll
          for (int j = 0; j < 8; ++j) k[8 + j] = tmp[j];
          ld8(pV + off, tmp);
#pragma unroll
          for (int j = 0; j < 8; ++j) v[j] = tmp[j];
          ld8(pV + off + 8, tmp);
#pragma unroll
          for (int j = 0; j < 8; ++j) v[8 + j] = tmp[j];
          ld8(pG + off, tmp);
#pragma unroll
          for (int j = 0; j < 8; ++j) g[j] = tmp[j];
          ld8(pG + off + 8, tmp);
#pragma unroll
          for (int j = 0; j < 8; ++j) g[8 + j] = tmp[j]; }
        float sm = 0.f, bs = 0.f;
#pragma unroll
        for (int j = 0; j < 16; ++j) { sm += y[j]; bs += r[j] * k[j] * rk[c0 + j]; }
        sm += __shfl_xor(sm, 1); sm += __shfl_xor(sm, 2); bs += __shfl_xor(bs, 1); bs += __shfl_xor(bs, 2);
        const float mean = sm * (1.f / 64.f); float vr = 0.f;
#pragma unroll
        for (int j = 0; j < 16; ++j) { const float d = y[j] - mean; vr += d * d; }
        vr += __shfl_xor(vr, 1); vr += __shfl_xor(vr, 2);
        const float rstd = rsqrtf(vr * (1.f / 64.f) + 64e-5f);
        float o[16];
#pragma unroll
        for (int j = 0; j < 16; ++j) o[j] = ((y[j] - mean) * rstd * lnw[c0 + j] + lnb[c0 + j] + bs * v[j]) * g[j];
        u32x4 w0, w1; w0.x = cvt_pk_bf16(o[0], o[1]); w0.y = cvt_pk_bf16(o[2], o[3]); w0.z = cvt_pk_bf16(o[4], o[5]); w0.w = cvt_pk_bf16(o[6], o[7]);
        w1.x = cvt_pk_bf16(o[8], o[9]); w1.y = cvt_pk_bf16(o[10], o[11]); w1.z = cvt_pk_bf16(o[12], o[13]); w1.w = cvt_pk_bf16(o[14], o[15]);
        *(u32x4*)(YG + off) = w0; *(u32x4*)(YG + off + 8) = w1; }
}
constexpr size_t BIG_RH = 0, BIG_Y0 = (size_t)4096 * 8192, BIG_MM = BIG_Y0 + (size_t)4096 * 16384, BIG_NT = BIG_MM + (size_t)4096 * 8192;
static_assert(BIG_NT + (size_t)4096 * 16384 <= SZ_BIG, "big2");
__device__ __forceinline__ f32x4 ldbf4(const bf16_t* p) { const u32x2 w = *(const u32x2*)p; return (f32x4){bflo(w.x), bfhi(w.x), bflo(w.y), bfhi(w.y)}; }
__device__ __forceinline__ int nat_frag(int rtile, int ks, int lane) { return ((rtile * 2 + ks) * 64 + lane) * 8; }
__device__ __forceinline__ int nat_st4(int rtile, int lq, int c0) { return ((rtile * 2 + (c0 >> 5)) * 64 + ((c0 >> 3) & 3) * 16 + lq) * 8 + (c0 & 7); }
constexpr int R4_RHS = 0, R4_AAB = 34816, R4_PL = 51200, R4_SEG = 51456, R4_BF = 53504, R4_ASZ = 9216, R4_LD = 72, XLD = 68;
__device__ __forceinline__ bf16x8 ldsfrag(const bf16_t* arr, int row, int koff) { return *(const bf16x8*)(arr + row * R4_LD + koff); }
__device__ __forceinline__ void r4_phase(const Args& a, int l, unsigned char* lds) {
    unsigned char* ws = pg8::opq_ptr(a.ws); const int tid = pg8::opq_tid(), lane = tid & 63, w = tid >> 6, lq = lane & 15, q = lane >> 4;
    const bf16_t* base = (const bf16_t*)(ws + WS_MIX);
    float* RHS = (float*)(lds + R4_RHS); float* AAB = (float*)(lds + R4_AAB); float* PL = (float*)(lds + R4_PL); float* SEG = (float*)(lds + R4_SEG);
    bf16_t* Arow = (bf16_t*)(lds + R4_BF); bf16_t* Brow = Arow + R4_ASZ / 2; bf16_t* Krow = Brow + R4_ASZ / 2; bf16_t* Rrow = Krow + R4_ASZ / 2;
    bf16_t* BT = Rrow + R4_ASZ / 2; bf16_t* KT = BT + R4_ASZ / 2; bf16_t* VT = KT + R4_ASZ / 2; bf16_t* AAK = VT + R4_ASZ / 2; bf16_t* ARB = AAK + R4_ASZ / 2; bf16_t* ARK = ARB + R4_ASZ / 2;
    bf16_t* AhT = Arow; bf16_t* W1T = Krow;
    const int bid = pg8::opq_bid();
    u32x4 pre[6]; bf16_t* raw = (bf16_t*)lds;
#define R4_PREFETCH(uu) do { const int h_ = (uu) & 15, c_ = (uu) >> 4; _Pragma("unroll") for (int k_ = 0; k_ < 6; ++k_) { const int idx_ = tid + 512 * k_; const int arr_ = idx_ >> 9, t_ = (idx_ >> 3) & 63, j8_ = (idx_ & 7) * 8; \
        pre[k_] = *(const u32x4*)(base + (size_t)(arr_ == 5 ? 5 + l : arr_) * T * D + (size_t)(c_ * 64 + t_) * D + h_ * 64 + j8_); } } while (0)
    for (int u = bid; u < 4096; u += gridDim.x) {
        const int h = u & 15, c = u >> 4;
        R4_PREFETCH(u);
        __syncthreads();
#pragma unroll
        for (int k_ = 0; k_ < 6; ++k_) { const int idx_ = tid + 512 * k_; *(u32x4*)(raw + (size_t)idx_ * 8) = pre[k_]; }
        __syncthreads();
#ifndef NO_S1
        { const int j = lane, seg = w; const size_t g0 = (size_t)(c * 64 + seg * 8) * D + h * 64 + j;
          float r[8], ld[8], k[8], v[8], aa[8], bb[8];
#pragma unroll
          for (int i = 0; i < 8; ++i) { const int o = (seg * 8 + i) * 64 + j; r[i] = bf2f(raw[o]); ld[i] = bf2f(raw[4096 + o]); k[i] = bf2f(raw[2 * 4096 + o]);
              aa[i] = bf2f(raw[3 * 4096 + o]); bb[i] = bf2f(raw[4 * 4096 + o]); v[i] = bf2f(raw[5 * 4096 + o]); }
          (void)g0;
          float cum[8]; float run = 0.f;
#pragma unroll
          for (int i = 0; i < 8; ++i) { run += ld[i]; cum[i] = run; }
          SEG[seg * 64 + j] = run;
          __syncthreads();
          float off = 0.f;
#pragma unroll
          for (int s = 0; s < 8; ++s) off += (s < seg) ? SEG[s * 64 + j] : 0.f;
          float at[8], rt[8], bt[8], kt[8];
#pragma unroll
          for (int i = 0; i < 8; ++i) { const float cm = cum[i] + off; const float ep = __expf(cm), em = __expf(-cm), epp = __expf(cm - ld[i]);
              at[i] = aa[i] * epp; rt[i] = r[i] * ep; bt[i] = bb[i] * em; kt[i] = k[i] * em;
              const int t = seg * 8 + i;
              Arow[t * R4_LD + j] = (bf16_t)(cvt_pk_bf16(at[i], 0.f) & 0xffffu); Brow[t * R4_LD + j] = (bf16_t)(cvt_pk_bf16(bt[i], 0.f) & 0xffffu);
              Krow[t * R4_LD + j] = (bf16_t)(cvt_pk_bf16(kt[i], 0.f) & 0xffffu); Rrow[t * R4_LD + j] = (bf16_t)(cvt_pk_bf16(rt[i], 0.f) & 0xffffu);
              if (i == 7 && seg == 7) PL[j] = ep; }
          *(f32x4*)(RHS + j * XLD + seg * 8) = (f32x4){at[0], at[1], at[2], at[3]}; *(f32x4*)(RHS + j * XLD + seg * 8 + 4) = (f32x4){at[4], at[5], at[6], at[7]};
          *(bf16x8*)(BT + j * R4_LD + seg * 8) = pack8(bt); *(bf16x8*)(KT + j * R4_LD + seg * 8) = pack8(kt); *(bf16x8*)(VT + j * R4_LD + seg * 8) = pack8(v); }
#endif
        __syncthreads();
        { const int tt = w >> 1; const int t = 16 * tt + lq;
          bf16x8 fa[2], fr[2];
#pragma unroll
          for (int ks = 0; ks < 2; ++ks) { fa[ks] = ldsfrag(Arow, t, ks * 32 + 8 * q); fr[ks] = ldsfrag(Rrow, t, ks * 32 + 8 * q); }
#pragma unroll
          for (int k2 = 0; k2 < 2; ++k2) { const int st = 2 * (w & 1) + k2; const int s0 = 16 * st + 4 * q;
              f32x4 dab = {0.f, 0.f, 0.f, 0.f}, dak = dab, drb = dab, drk = dab;
              if (st <= tt) {
#pragma unroll
                  for (int ks = 0; ks < 2; ++ks) { const bf16x8 fb = ldsfrag(Brow, 16 * st + lq, ks * 32 + 8 * q), fk = ldsfrag(Krow, 16 * st + lq, ks * 32 + 8 * q);
                      dab = MFMA16(fb, fa[ks], dab); dak = MFMA16(fk, fa[ks], dak); drb = MFMA16(fb, fr[ks], drb); drk = MFMA16(fk, fr[ks], drk); } }
#pragma unroll
              for (int e = 0; e < 4; ++e) { const int s = s0 + e; if (!(s < t)) { dab[e] = 0.f; dak[e] = 0.f; } if (!(s <= t)) { drb[e] = 0.f; drk[e] = 0.f; } }
              *(f32x4*)(AAB + t * 64 + s0) = dab;
              st4(AAK + t * R4_LD + s0, dak[0], dak[1], dak[2], dak[3]); st4(ARB + t * R4_LD + s0, drb[0], drb[1], drb[2], drb[3]); st4(ARK + t * R4_LD + s0, drk[0], drk[1], drk[2], drk[3]); } }
        __syncthreads();
        { bf16_t* AOFF = Brow; const int t = tid >> 3, s8 = (tid & 7) * 8; const f32x4 a0 = *(const f32x4*)(AAB + t * 64 + s8), a1 = *(const f32x4*)(AAB + t * 64 + s8 + 4);
          const bool keep = (s8 >> 4) < (t >> 4); const float o[8] = {keep ? a0[0] : 0.f, keep ? a0[1] : 0.f, keep ? a0[2] : 0.f, keep ? a0[3] : 0.f, keep ? a1[0] : 0.f, keep ? a1[1] : 0.f, keep ? a1[2] : 0.f, keep ? a1[3] : 0.f};
          *(bf16x8*)(AOFF + t * R4_LD + s8) = pack8(o); }
        { const int tt = w >> 1; const int t = 16 * tt + lq;
          bf16x8 fb[2];
#pragma unroll
          for (int ks = 0; ks < 2; ++ks) fb[ks] = ldsfrag(AAK, t, ks * 32 + 8 * q);
#pragma unroll
          for (int k2 = 0; k2 < 2; ++k2) { const int it = 2 * (w & 1) + k2; f32x4 d = {0.f, 0.f, 0.f, 0.f};
#pragma unroll
              for (int ks = 0; ks < 2; ++ks) d = MFMA16(ldsfrag(VT, 16 * it + lq, ks * 32 + 8 * q), fb[ks], d);
#pragma unroll
              for (int e = 0; e < 4; ++e) RHS[(64 + 16 * it + 4 * q + e) * XLD + t] = d[e]; } }
        __syncthreads();
        { bf16_t* AOFF = Brow;
#pragma unroll
          for (int b = 0; b < 4; ++b) {
              if (b > 0) { const bf16_t* xt = (w < 4 ? AhT : W1T); const int crow = 16 * (w & 3) + lq; f32x4 d = {0.f, 0.f, 0.f, 0.f};
#pragma unroll
                  for (int ks = 0; ks < (b + 1) / 2; ++ks) d = MFMA16(ldsfrag(xt, crow, ks * 32 + 8 * q), ldsfrag(AOFF, 16 * b + lq, ks * 32 + 8 * q), d);
                  const int t = 16 * b + lq; const int c0 = 16 * w + 4 * q;
#pragma unroll
                  for (int e = 0; e < 4; ++e) RHS[(c0 + e) * XLD + t] += d[e];
                  __syncthreads(); }
              if (tid < 128) { float* xr = RHS + tid * XLD + 16 * b; float x[16];
#pragma unroll
                  for (int k = 0; k < 4; ++k) { const f32x4 v = *(const f32x4*)(xr + 4 * k); x[4 * k] = v[0]; x[4 * k + 1] = v[1]; x[4 * k + 2] = v[2]; x[4 * k + 3] = v[3]; }
#pragma unroll
                  for (int t = 1; t < 16; ++t) { const float* ar = AAB + (16 * b + t) * 64 + 16 * b; float acc = x[t];
#pragma unroll
                      for (int k = 0; k < (t + 3) / 4; ++k) { const f32x4 av = *(const f32x4*)(ar + 4 * k);
#pragma unroll
                          for (int e = 0; e < 4; ++e) if (4 * k + e < t) acc += av[e] * x[4 * k + e]; }
                      x[t] = acc; }
#pragma unroll
                  for (int k = 0; k < 4; ++k) *(f32x4*)(xr + 4 * k) = (f32x4){x[4 * k], x[4 * k + 1], x[4 * k + 2], x[4 * k + 3]};
                  bf16_t* dst = (tid < 64 ? AhT : W1T) + (tid & 63) * R4_LD + 16 * b;
                  { const float o0[8] = {x[0], x[1], x[2], x[3], x[4], x[5], x[6], x[7]}; const float o1[8] = {x[8], x[9], x[10], x[11], x[12], x[13], x[14], x[15]};
                    *(bf16x8*)dst = pack8(o0); *(bf16x8*)(dst + 8) = pack8(o1); } }
              if (b < 3) __syncthreads();
          } }
        __syncthreads();
#ifndef NO_S5
        { const int rt_ = w >> 1; const int row = 16 * rt_ + lq;
          unsigned char* bigb = ws + WS_BIG;
          bf16_t* gRH = (bf16_t*)(bigb + BIG_RH) + (size_t)u * 4096; float* gY0 = (float*)((bf16_t*)(bigb + BIG_Y0) + (size_t)u * 4096);
          bf16_t* gMM = (bf16_t*)(bigb + BIG_MM) + (size_t)(h * 256 + c) * 4096; float* gNT = (float*)((bf16_t*)(bigb + BIG_NT) + (size_t)(h * 256 + c) * 4096);
          bf16x8 f_arb[2], f_ark[2], f_bt[2], f_w1[2], f_vt[2];
#pragma unroll
          for (int ks = 0; ks < 2; ++ks) { const int ko = ks * 32 + 8 * q; f_arb[ks] = ldsfrag(ARB, row, ko); f_ark[ks] = ldsfrag(ARK, row, ko); f_bt[ks] = ldsfrag(BT, row, ko); f_w1[ks] = ldsfrag(W1T, row, ko); f_vt[ks] = ldsfrag(VT, row, ko); }
          const float plrow = PL[row];
#pragma unroll
          for (int k2 = 0; k2 < 2; ++k2) { const int ct = 2 * (w & 1) + k2; const int c0 = 16 * ct + 4 * q;
              f32x4 drh = {0.f, 0.f, 0.f, 0.f}, dy0 = drh, dmm = drh, dnt = drh;
#pragma unroll
              for (int ks = 0; ks < 2; ++ks) { const int ko = ks * 32 + 8 * q;
                  const bf16x8 c_ah = ldsfrag(AhT, 16 * ct + lq, ko), c_w1 = ldsfrag(W1T, 16 * ct + lq, ko), c_vt = ldsfrag(VT, 16 * ct + lq, ko), c_bt = ldsfrag(BT, 16 * ct + lq, ko), c_kt = ldsfrag(KT, 16 * ct + lq, ko);
                  drh = MFMA16(c_ah, f_arb[ks], drh);
                  dy0 = MFMA16(c_w1, f_arb[ks], dy0); dy0 = MFMA16(c_vt, f_ark[ks], dy0);
                  dmm = MFMA16(c_ah, f_bt[ks], dmm);
                  dnt = MFMA16(c_bt, f_w1[ks], dnt); dnt = MFMA16(c_kt, f_vt[ks], dnt); }
              float rr[4]; ld4(Rrow + row * R4_LD + c0, rr);
              st4(gRH + nat_st4(rt_, lq, c0), drh[0] + rr[0], drh[1] + rr[1], drh[2] + rr[2], drh[3] + rr[3]);
              st4((bf16_t*)gY0 + ((rt_ * 4 + ct) * 64 + lane) * 4, dy0[0], dy0[1], dy0[2], dy0[3]);
#pragma unroll
              for (int e = 0; e < 4; ++e) { dmm[e] = plrow * (dmm[e] + ((c0 + e) == row ? 1.f : 0.f)); dnt[e] *= PL[c0 + e]; }
              st4(gMM + nat_st4(rt_, lq, c0), dmm[0], dmm[1], dmm[2], dmm[3]);
              st4((bf16_t*)gNT + ((rt_ * 4 + ct) * 64 + lane) * 4, dnt[0], dnt[1], dnt[2], dnt[3]); } }
#endif
    }
}
__device__ __forceinline__ void r5_phase(const Args& a, unsigned char* lds) {
    const int bid = pg8::opq_bid(); if (bid >= 64) return;
    unsigned char* ws = pg8::opq_ptr(a.ws); const int tid = pg8::opq_tid(), lane = tid & 63, w = tid >> 6, lq = lane & 15, q = lane >> 4; const int h = bid & 15, iq = bid >> 4;
    const bf16_t* gMM = (const bf16_t*)(ws + WS_BIG + BIG_MM); const float* gNT = (const float*)(ws + WS_BIG + BIG_NT);
    bf16_t* SC = (bf16_t*)(ws + WS_MIX + (size_t)1 * SZ_TD2);
    bf16_t* Sb = (bf16_t*)lds;
    for (int i = tid; i < 2 * 16 * R4_LD / 2; i += 512) ((unsigned*)Sb)[i] = 0u;
    for (int i = tid; i < 512; i += 512) ((unsigned*)(SC + (size_t)h * 4096 + iq * 1024))[i] = 0u;
    __syncthreads();
    if (w >= 4) {
        for (int c = 0; c < 256; ++c) { asm volatile("s_waitcnt lgkmcnt(0)" ::: "memory"); __builtin_amdgcn_s_barrier(); asm volatile("" ::: "memory"); }
        return; }
    const int jt = w; const int irow = 16 * iq + lq;
    bf16x8 Mr[8][2]; f32x4 Nr[8];
#pragma unroll
    for (int k = 0; k < 8; ++k) { const size_t ub = (size_t)(h * 256 + k) * 4096;
#pragma unroll
        for (int ks = 0; ks < 2; ++ks) Mr[k][ks] = *(const bf16x8*)(gMM + ub + nat_frag(jt, ks, lane));
        Nr[k] = ldbf4((const bf16_t*)gNT + ub + ((iq * 4 + jt) * 64 + lane) * 4); }
    for (int c0 = 0; c0 < 256; c0 += 8) {
#pragma unroll
        for (int k = 0; k < 8; ++k) { const int c = c0 + k;
            const bf16_t* Sc_ = Sb + (k & 1) * 16 * R4_LD; bf16_t* Sn_ = Sb + ((k & 1) ^ 1) * 16 * R4_LD;
            bf16_t* scn = SC + (size_t)((c + 1) * 16 + h) * 4096;
            f32x4 d = Nr[k];
#pragma unroll
            for (int ks = 0; ks < 2; ++ks) d = MFMA16(Mr[k][ks], ldsfrag(Sc_, lq, ks * 32 + 8 * q), d);
            st4(Sn_ + lq * R4_LD + 16 * jt + 4 * q, d[0], d[1], d[2], d[3]);
            if (c < 255) st4(scn + nat_st4(iq, lq, 16 * jt + 4 * q), d[0], d[1], d[2], d[3]);
            { const int cn = (c + 8 < 256) ? c + 8 : 255; const size_t ub = (size_t)(h * 256 + cn) * 4096;
#pragma unroll
              for (int ks = 0; ks < 2; ++ks) Mr[k][ks] = *(const bf16x8*)(gMM + ub + nat_frag(jt, ks, lane));
              Nr[k] = ldbf4((const bf16_t*)gNT + ub + ((iq * 4 + jt) * 64 + lane) * 4); }
            asm volatile("s_waitcnt lgkmcnt(0)" ::: "memory"); __builtin_amdgcn_s_barrier(); asm volatile("" ::: "memory");
        }
    }
}
__device__ __forceinline__ void r6_phase(const Args& a, int l) {
    unsigned char* ws = pg8::opq_ptr(a.ws); const int tid = pg8::opq_tid(), lane = tid & 63, lq = lane & 15, q = lane >> 4; const int gw = pg8::opq_bid() * 8 + (tid >> 6), NGW = gridDim.x * 8;
    const bf16_t* gRH = (const bf16_t*)(ws + WS_BIG + BIG_RH); const float* gY0 = (const float*)(ws + WS_BIG + BIG_Y0); const bf16_t* SC = (const bf16_t*)(ws + WS_MIX + (size_t)1 * SZ_TD2);
    const bf16_t* base = (const bf16_t*)(ws + WS_MIX); const bf16_t* pR = base; const bf16_t* pK = base + (size_t)2 * T * D; const bf16_t* pV = base + (size_t)(5 + l) * T * D; const bf16_t* pG = base + (size_t)7 * T * D;
    bf16_t* YG = (bf16_t*)(ws + WS_MIX + (size_t)3 * SZ_TD2);
    const float* lnw = a.in[21] + l * D; const float* lnb = a.in[22] + l * D; const float* rk = a.in[20] + l * D;
    for (int item = gw; item < 16384; item += NGW) { const int tt = item & 3, u = item >> 2; const int h = u & 15, c = u >> 4; const int t = c * 64 + tt * 16 + lq;
        const size_t ub = (size_t)u * 4096;
        bf16x8 fr[2];
#pragma unroll
        for (int ks = 0; ks < 2; ++ks) fr[ks] = *(const bf16x8*)(gRH + ub + nat_frag(tt, ks, lane));
        f32x4 y[4]; bf16x8 fs[4][2]; u32x2 Lr[4], Lk[4], Lv[4], Lg[4];
#pragma unroll
        for (int it = 0; it < 4; ++it) { y[it] = ldbf4((const bf16_t*)gY0 + ub + ((tt * 4 + it) * 64 + lane) * 4);
#pragma unroll
            for (int ks = 0; ks < 2; ++ks) fs[it][ks] = *(const bf16x8*)(SC + ub + nat_frag(it, ks, lane));
            const size_t off = (size_t)t * D + h * 64 + 16 * it + 4 * q; Lr[it] = *(const u32x2*)(pR + off); Lk[it] = *(const u32x2*)(pK + off); Lv[it] = *(const u32x2*)(pV + off); Lg[it] = *(const u32x2*)(pG + off); }
#pragma unroll
        for (int it = 0; it < 4; ++it)
#pragma unroll
            for (int ks = 0; ks < 2; ++ks) y[it] = MFMA16(fs[it][ks], fr[ks], y[it]);
        float sm = 0.f, bs = 0.f; float vv[4][4], gg[4][4];
#pragma unroll
        for (int it = 0; it < 4; ++it) { const int c0 = h * 64 + 16 * it + 4 * q; float r4[4], k4[4];
            up4(Lr[it], r4); up4(Lk[it], k4); up4(Lv[it], vv[it]); up4(Lg[it], gg[it]); const f32x4 rkv = *(const f32x4*)(rk + c0);
#pragma unroll
            for (int e = 0; e < 4; ++e) { sm += y[it][e]; bs += r4[e] * k4[e] * rkv[e]; } }
        sm += __shfl_xor(sm, 16); sm += __shfl_xor(sm, 32); bs += __shfl_xor(bs, 16); bs += __shfl_xor(bs, 32);
        const float mean = sm * (1.f / 64.f); float vr = 0.f;
#pragma unroll
        for (int it = 0; it < 4; ++it)
#pragma unroll
            for (int e = 0; e < 4; ++e) { const float dd = y[it][e] - mean; vr += dd * dd; }
        vr += __shfl_xor(vr, 16); vr += __shfl_xor(vr, 32);
        const float rstd = rsqrtf(vr * (1.f / 64.f) + 64e-5f);
#pragma unroll
        for (int it = 0; it < 4; ++it) { const int c0 = h * 64 + 16 * it + 4 * q; const f32x4 lw = *(const f32x4*)(lnw + c0), lb = *(const f32x4*)(lnb + c0); float o[4];
#pragma unroll
            for (int e = 0; e < 4; ++e) o[e] = ((y[it][e] - mean) * rstd * lw[e] + lb[e] + bs * vv[it][e]) * gg[it][e];
            st4(YG + (size_t)t * D + c0, o[0], o[1], o[2], o[3]); }
    }
}
constexpr int VT_LD = 136;
__device__ __forceinline__ int vt_addr(int dim, int kp) { return dim * VT_LD + (dim >> 4) * 8 + kp; }
constexpr int KL_LD = 72;
struct AttRegs { u32x4 k[4], v0a, v0b, v1a, v1b; bf16x8 q[2]; };
__device__ __forceinline__ void att_decode(int u, int& g, int& h, int& d, int& rsd, int& n) { g = u >> 11; const int rem = u & 2047; h = rem >> 7; const int rr = rem & 127; const int sh = 2 * g; d = 1 << sh; rsd = rr & (d - 1); n = rr >> sh; }
__device__ __forceinline__ void att_load(const bf16_t* Q, const bf16_t* KV, int u, int tid, AttRegs& R) {
    int g, h, d, rsd, n; att_decode(u, g, h, d, rsd, n); const int hc = g * 1024 + h * 64; const int lane = tid & 63, w = tid >> 6, lq = lane & 15, qp = lane >> 4;
    const int sh = 2 * g; const size_t plane = ((size_t)(g * 16 + h) * T + (size_t)rsd * (T >> sh)) * 64; (void)hc;
    { const int key = tid >> 1, half = tid & 1; int mk = 128 * (n - 1) + key; mk = mk < 0 ? 0 : mk; const bf16_t* p = KV + plane + (size_t)mk * 64 + half * 32;
#pragma unroll
      for (int i = 0; i < 4; ++i) R.k[i] = *(const u32x4*)(p + 8 * i); }
    { const int kp = tid >> 2, dg = tid & 3; const u32x4 z = {0u, 0u, 0u, 0u}; R.v0a = z; R.v0b = z; R.v1a = z; R.v1b = z; const int m0 = 128 * (n - 1) + 2 * kp;
      if (m0 >= 0) { const bf16_t* p0 = KV + (size_t)48 * T * 64 + plane + (size_t)m0 * 64 + dg * 16; const bf16_t* p1 = p0 + 64;
          R.v0a = *(const u32x4*)p0; R.v0b = *(const u32x4*)(p0 + 8); R.v1a = *(const u32x4*)p1; R.v1b = *(const u32x4*)(p1 + 8); } }
    { const int qi = 16 * w + lq; const int tq = (128 * n + qi) * d + rsd;
#pragma unroll
      for (int ks = 0; ks < 2; ++ks) R.q[ks] = *(const bf16x8*)(Q + plane + (size_t)(128 * n + qi) * 64 + ks * 32 + qp * 8); (void)tq; }
}
__device__ __forceinline__ void attn_phase(const Args& a, unsigned* vt) {
    unsigned char* ws = pg8::opq_ptr(a.ws); const int tid = pg8::opq_tid(), lane = tid & 63, w = tid >> 6, lq = lane & 15, qp = lane >> 4;
    const bf16_t* Q = (const bf16_t*)(ws + WS_BIG + BIG_Q); const bf16_t* KV = (const bf16_t*)(ws + WS_MIX);
    bf16_t* OG = (bf16_t*)(ws + WS_BIG + BIG_OG); float* LSE = (float*)(ws + WS_BIG + BIG_LSE);
    bf16_t* kl = (bf16_t*)(vt + 9216);
    const int G = gridDim.x; int u = pg8::opq_bid();
    AttRegs R, R2; if (u < 6144) { att_load(Q, KV, u, tid, R); att_load(Q, KV, (u + G < 6144) ? u + G : u, tid, R2); }
    for (; u < 6144; u += G) {
        int g, h, d, rsd, n; att_decode(u, g, h, d, rsd, n);
        asm volatile("s_waitcnt lgkmcnt(0)" ::: "memory"); __builtin_amdgcn_s_barrier(); asm volatile("" ::: "memory");
        { const int key = tid >> 1, half = tid & 1;
#pragma unroll
          for (int i = 0; i < 4; ++i) *(u32x4*)(kl + key * KL_LD + half * 32 + 8 * i) = R.k[i]; }
        { const int kp = tid >> 2, dg = tid & 3;
          const unsigned e0[8] = {R.v0a.x, R.v0a.y, R.v0a.z, R.v0a.w, R.v0b.x, R.v0b.y, R.v0b.z, R.v0b.w}; const unsigned e1[8] = {R.v1a.x, R.v1a.y, R.v1a.z, R.v1a.w, R.v1b.x, R.v1b.y, R.v1b.z, R.v1b.w};
#pragma unroll
          for (int j = 0; j < 8; ++j) { const int dim = dg * 16 + 2 * j;
              vt[vt_addr(dim, kp)] = (e0[j] & 0xffffu) | (e1[j] << 16);
              vt[vt_addr(dim + 1, kp)] = (e0[j] >> 16) | (e1[j] & 0xffff0000u); } }
        bf16x8 bq[2]; bq[0] = R.q[0]; bq[1] = R.q[1];
        asm volatile("s_waitcnt lgkmcnt(0)" ::: "memory"); __builtin_amdgcn_s_barrier(); asm volatile("" ::: "memory");
        R = R2; { const int un = (u + 2 * G < 6144) ? u + 2 * G : u; att_load(Q, KV, un, tid, R2); }
        const int qi = 16 * w + lq; const int tq = (128 * n + qi) * d + rsd;
        const int kt0 = 2 * (w >> 1);
        f32x4 sc[10];
#pragma unroll
        for (int kl_ = 0; kl_ < 10; ++kl_) { const int krow = 16 * (kt0 + kl_) + lq; f32x4 acc = {0.f, 0.f, 0.f, 0.f};
            acc = MFMA16(*(const bf16x8*)(kl + krow * KL_LD + qp * 8), bq[0], acc); acc = MFMA16(*(const bf16x8*)(kl + krow * KL_LD + 32 + qp * 8), bq[1], acc); sc[kl_] = acc; }
        float mx = -3.0e38f;
#pragma unroll
        for (int kl_ = 0; kl_ < 10; ++kl_)
#pragma unroll
            for (int e = 0; e < 4; ++e) { const int kj = 16 * (kt0 + kl_) + 4 * qp + e; const bool valid = (kj >= qi) && (kj <= qi + 128) && (n > 0 || kj >= 128);
                const float sv = valid ? sc[kl_][e] : -1e30f; sc[kl_][e] = sv; mx = fmaxf(mx, sv); }
        mx = fmaxf(mx, __shfl_xor(mx, 16)); mx = fmaxf(mx, __shfl_xor(mx, 32));
        float lsum = 0.f;
#pragma unroll
        for (int kl_ = 0; kl_ < 10; ++kl_)
#pragma unroll
            for (int e = 0; e < 4; ++e) { const float p = __expf(sc[kl_][e] - mx); sc[kl_][e] = p; lsum += p; }
        lsum += __shfl_xor(lsum, 16); lsum += __shfl_xor(lsum, 32);
        f32x4 oacc[4];
#pragma unroll
        for (int dt = 0; dt < 4; ++dt) oacc[dt] = (f32x4){0.f, 0.f, 0.f, 0.f};
#pragma unroll
        for (int sl = 0; sl < 5; ++sl) { u32x4 pw; pw.x = cvt_pk_bf16(sc[2 * sl][0], sc[2 * sl][1]); pw.y = cvt_pk_bf16(sc[2 * sl][2], sc[2 * sl][3]);
            pw.z = cvt_pk_bf16(sc[2 * sl + 1][0], sc[2 * sl + 1][1]); pw.w = cvt_pk_bf16(sc[2 * sl + 1][2], sc[2 * sl + 1][3]);
            const bf16x8 bp = __builtin_bit_cast(bf16x8, pw); const int kpb = 16 * ((kt0 >> 1) + sl) + 2 * qp;
#pragma unroll
            for (int dt = 0; dt < 4; ++dt) { const int dim = dt * 16 + lq; const u32x2 lo = *(const u32x2*)(vt + vt_addr(dim, kpb)); const u32x2 hi = *(const u32x2*)(vt + vt_addr(dim, kpb + 8));
                u32x4 aw; aw.x = lo.x; aw.y = lo.y; aw.z = hi.x; aw.w = hi.y;
                oacc[dt] = MFMA16(__builtin_bit_cast(bf16x8, aw), bp, oacc[dt]); } }
        const float il = 1.f / lsum;
        bf16_t* op = OG + (size_t)g * T * D + (size_t)tq * D + h * 64 + 4 * qp;
#pragma unroll
        for (int dt = 0; dt < 4; ++dt) st4(op + dt * 16, oacc[dt][0] * il, oacc[dt][1] * il, oacc[dt][2] * il, oacc[dt][3] * il);
        if (qp == 0) LSE[(size_t)g * T * 16 + (size_t)tq * 16 + h] = mx + __logf(lsum);
    }
}
__device__ __forceinline__ void comb_phase(const Args& a) {
    unsigned char* ws = pg8::opq_ptr(a.ws); const int lane = pg8::opq_tid() & 63; const int gw = pg8::opq_bid() * 8 + (pg8::opq_tid() >> 6), NGW = gridDim.x * 8;
    const bf16_t* OG = (const bf16_t*)(ws + WS_BIG + BIG_OG); const float* LSE = (const float*)(ws + WS_BIG + BIG_LSE); bf16_t* O = (bf16_t*)(ws + WS_MIX + (size_t)T * KVW * 2);
    const int c0 = lane * 16, h = lane >> 2;
    for (int t = gw; t < T; t += NGW) {
        const float l0 = LSE[(size_t)t * 16 + h], l1 = LSE[(size_t)T * 16 + (size_t)t * 16 + h], l2 = LSE[(size_t)2 * T * 16 + (size_t)t * 16 + h];
        const float mx = fmaxf(l0, fmaxf(l1, l2)); float e0 = __expf(l0 - mx), e1 = __expf(l1 - mx), e2 = __expf(l2 - mx); const float is = 1.f / (e0 + e1 + e2); e0 *= is; e1 *= is; e2 *= is;
        float o[16];
#pragma unroll
        for (int hf = 0; hf < 2; ++hf) { float x0[8], x1[8], x2[8]; const size_t off = (size_t)t * D + c0 + hf * 8;
            ld8(OG + off, x0); ld8(OG + (size_t)T * D + off, x1); ld8(OG + (size_t)2 * T * D + off, x2);
#pragma unroll
            for (int j = 0; j < 8; ++j) o[hf * 8 + j] = e0 * x0[j] + e1 * x1[j] + e2 * x2[j]; }
        u32x4 w0, w1; w0.x = cvt_pk_bf16(o[0], o[1]); w0.y = cvt_pk_bf16(o[2], o[3]); w0.z = cvt_pk_bf16(o[4], o[5]); w0.w = cvt_pk_bf16(o[6], o[7]);
        w1.x = cvt_pk_bf16(o[8], o[9]); w1.y = cvt_pk_bf16(o[10], o[11]); w1.z = cvt_pk_bf16(o[12], o[13]); w1.w = cvt_pk_bf16(o[14], o[15]);
        *(u32x4*)(O + (size_t)t * D + c0) = w0; *(u32x4*)(O + (size_t)t * D + c0 + 8) = w1; }
}
__global__ void __launch_bounds__(512, 2) mega(Args a) {
    extern __shared__ __attribute__((aligned(16))) unsigned char lds[];
    { volatile LAS unsigned* stw = (volatile LAS unsigned*)((LAS unsigned char*)lds + (LDS_BYTES - 64)); if (threadIdx.x < 2) stw[threadIdx.x] = 0u; }
    __syncthreads();
    { cg::grid_group grid = cg::this_grid(); if (a.ph_hi < 0) grid.sync(); }
    XcdBarrier bar = xcd_barrier_post((unsigned*)(a.ws + WS_BAR), (volatile LAS unsigned*)((LAS unsigned char*)lds + (LDS_BYTES - 64)));
    for (int s = a.ph_lo; s < a.ph_hi; ++s) {
        if (s > a.ph_lo) xcd_barrier(bar);
        unsigned char* ws = pg8::opq_ptr(a.ws); PG8_LAS unsigned char* glds = (PG8_LAS unsigned char*)lds; float* ssb = (float*)(ws + WS_SS); bf16_t* XB = (bf16_t*)(ws + WS_XB); const int bid = pg8::opq_bid();
        int type, l = 0, j = 0;
        if (s == 0) type = 0; else if (s == 21) type = 8;
        else { int o; if (s <= 10) { l = 0; o = s - 1; } else if (s <= 20) { l = 1; o = s - 11; } else if (s <= 29) { l = 2; o = s - 22; } else { l = 3; o = s - 30; }
            if (l < 2) { if (o < 2) type = 1 + o; else if (o < 6) type = o + 1; else if (o == 6) type = 13; else if (o == 7) type = 7; else { type = o - 7; j = 1; } }
            else { if (o < 2) type = 1 + o; else if (o < 6) type = o + 7; else { type = o - 5; j = 1; } } }
#ifndef DUP_MASK
#define DUP_MASK 0
#endif
        for (int rep = 0; rep < (((DUP_MASK >> type) & 1) ? 2 : 1); ++rep) {
        if (type == 0) { p0_phase(a, (float*)lds); }
        else if (type == 1) { pg8::Gemm g{XB, (const bf16_t*)(ws + WS_WIN + (size_t)(l * 2 + j) * SZ_WIN), T, 2 * FF, D}; pg8::StaticOrder S; S.init(T, 2 * FF, gridDim.x, bid);
            EpiSwiglu E{(bf16_t*)(ws + WS_BIG), ssb + (size_t)(3 * l + (j ? 2 : 0)) * T * 16};
            pg8::gemm_phase<EpiSwiglu, pg8::StaticOrder, true, true>(glds, g, S, E); }
        else if (type == 2 || type == 7 || type == 12) {
            pg8::Gemm g; EpiResid E; E.xnew = a.out; E.xb = XB; E.xold = a.out;
            if (type == 2) { g = pg8::Gemm{(const bf16_t*)(ws + WS_BIG), (const bf16_t*)(ws + WS_WOUT + (size_t)(l * 2 + j) * SZ_WOUT), T, D, FF}; E.alpha = 0.5f; E.ssn = ssb + (size_t)(3 * l + (j ? 3 : 1)) * T * 16; if (l == 0 && j == 0) E.xold = a.in[0]; }
            else if (type == 7) { g = pg8::Gemm{(const bf16_t*)(ws + WS_MIX + (size_t)3 * SZ_TD2), (const bf16_t*)(ws + WS_WOR + (size_t)l * SZ_SQ), T, D, D}; E.alpha = 1.f; E.ssn = ssb + (size_t)(3 * l + 2) * T * 16; }
            else { g = pg8::Gemm{(const bf16_t*)(ws + WS_MIX + (size_t)T * KVW * 2), (const bf16_t*)(ws + WS_WOA + (size_t)(l - 2) * SZ_SQ), T, D, D}; E.alpha = 1.f; E.ssn = ssb + (size_t)(3 * l + 2) * T * 16; }
            pg8::StaticOrder S; S.init(T, D, gridDim.x, bid);
            pg8::gemm_phase<EpiResid, pg8::StaticOrder, true, true>(glds, g, S, E); }
        else if (type == 3) { pg8::Gemm g{XB, (const bf16_t*)(ws + WS_WCAT + (size_t)l * SZ_WCAT), T, NCAT, D}; pg8::StaticOrder S; S.init(T, NCAT, gridDim.x, bid);
            EpiPlain E{(bf16_t*)(ws + WS_BIG), NCAT};
            pg8::gemm_phase<EpiPlain, pg8::StaticOrder, true, true>(glds, g, S, E); }
        else if (type == 4) f1_phase(a, l, lds);
        else if (type == 5) r4_phase(a, l, lds);
        else if (type == 6) { if (bid >= 64 && gridDim.x > 64) p0_convert(a, (float*)lds, l + 1, bid - 64, gridDim.x - 64); else r5_phase(a, lds); }
        else if (type == 13) r6_phase(a, l);
        else if (type == 8 || type == 9) {
            pg8::Gemm g; EpiHeadNorm E; E.nnorm = 48;
            if (type == 8) { g = pg8::Gemm{XB, (const bf16_t*)(ws + WS_WKV), T, KVW, D}; E.O = (bf16_t*)(ws + WS_MIX); E.ldc = KVW; E.ss = ssb + (size_t)6 * T * 16; E.gain = a.in[26]; E.scale = 1.f; }
            else { g = pg8::Gemm{XB, (const bf16_t*)(ws + WS_WQ + (size_t)(l - 2) * SZ_WQ), T, QW, D}; E.O = (bf16_t*)(ws + WS_BIG + BIG_Q); E.ldc = QW; E.ss = ssb + (size_t)(3 * l + 1) * T * 16; E.gain = a.in[28] + (l - 2) * 192; E.scale = 0.125f; }
            pg8::StaticOrder S; S.init(T, g.N, gridDim.x, bid);
            pg8::gemm_phase<EpiHeadNorm, pg8::StaticOrder, true, true>(glds, g, S, E); }
        else if (type == 10) attn_phase(a, (unsigned*)lds);
        else if (type == 11) comb_phase(a);
        }
    }
}

extern "C" void kernel_launch(void* const* d_in, const int* in_sizes, int n_in, void* d_out, int out_size, void* d_ws, size_t ws_size, hipStream_t stream) {
    static int grid = 0;
    if (grid == 0) {
        if (n_in != 30 || out_size != T * D || ws_size < WS_END) { fprintf(stderr, "kernel_launch: unexpected shapes: n_in %d out %d ws %zu (need %zu)\n", n_in, out_size, ws_size, (size_t)WS_END); grid = -1; return; }
        int dev = 0, cus = 0, per_cu = 0;
        (void)hipGetDevice(&dev); (void)hipDeviceGetAttribute(&cus, hipDeviceAttributeMultiprocessorCount, dev);
        if (hipFuncSetAttribute((const void*)mega, hipFuncAttributeMaxDynamicSharedMemorySize, LDS_BYTES) != hipSuccess) { fprintf(stderr, "kernel_launch: hipFuncSetAttribute failed\n"); grid = -1; return; }
        if (hipOccupancyMaxActiveBlocksPerMultiprocessor(&per_cu, (const void*)mega, 512, LDS_BYTES) != hipSuccess || per_cu < 1) { fprintf(stderr, "kernel_launch: occupancy query says %d\n", per_cu); per_cu = 1; }
        (void)hipGetLastError();
        grid = cus * 1;
        if (grid <= 0) grid = 256;
    }
    if (grid < 0) return;
    if (hipMemsetAsync((char*)d_ws + WS_BAR, 0, XCD_BAR_WORDS * 4, stream) != hipSuccess) { fprintf(stderr, "kernel_launch: memset failed\n"); return; }
    Args a{};
    for (int i = 0; i < 30; ++i) a.in[i] = (const float*)d_in[i];
    a.out = (float*)d_out; a.ws = (unsigned char*)d_ws;
#if ONE_LAUNCH
    a.ph_lo = 0; a.ph_hi = NSTEPS;
    void* args[] = {&a};
    hipError_t e = hipLaunchCooperativeKernel((const void*)mega, dim3(grid), dim3(512), args, LDS_BYTES, stream);
    if (e != hipSuccess) fprintf(stderr, "cooperative launch failed: %s (grid %d)\n", hipGetErrorString(e), grid);
#else
    for (int s = 0; s < NSTEPS; ++s) { a.ph_lo = s; a.ph_hi = s + 1; hipLaunchKernelGGL(mega, dim3(grid), dim3(512), LDS_BYTES, stream, a); }
#endif
}
```

```cpp
#include <hip/hip_runtime.h>
#include <hip/hip_cooperative_groups.h>
#include <cstdio>
#include <cstdint>
namespace cg = cooperative_groups;
namespace pg8 {
#define PG8_LAS __attribute__((address_space(3)))
typedef unsigned short bf16_t;
typedef short bf16x8 __attribute__((ext_vector_type(8)));
typedef float f32x4 __attribute__((ext_vector_type(4)));
typedef unsigned u32x4 __attribute__((ext_vector_type(4)));
__device__ __forceinline__ int opq_tid() { int t = threadIdx.x; asm volatile("" : "+v"(t)); return t; }
__device__ __forceinline__ int opq_bid() { int t = blockIdx.x; asm volatile("" : "+s"(t)); return t; }
__device__ __forceinline__ unsigned char* opq_ptr(unsigned char* q) { size_t off = 0; asm volatile("" : "+s"(off)); return q + off; }
constexpr int BM = 256, BK = 64, HALF = 128, HTB = HALF * BK * 2  , STAGE_BYTES = 8 * HTB, NXCD = 8, WGM = 8;

__host__ __device__ __forceinline__ int lds_byte(int r, int c) { const int st = (r >> 4) * 2 + (c >> 5), rr = r & 15, cc = c & 31, ob = rr * 64 + cc * 2; return st * 1024 + (ob ^ (((ob >> 9) & 1) << 5)); }
__host__ __device__ __forceinline__ void stage_rc(int b, int& R, int& C) { const int st = b / 1024, sb = b % 1024, swz = sb ^ (((sb >> 9) & 1) << 5); R = (st >> 1) * 16 + swz / 64; C = (st & 1) * 32 + (swz % 64) / 2; }
__host__ __device__ __forceinline__ int perm32(int rho) { const int n = rho >> 4, i = rho & 15; return 8 * (i >> 2) + 4 * n + (i & 3); }

struct Unit { int pm, pn, ord; };
struct Gemm { const bf16_t* A; const bf16_t* Bt; int M, N, K; };

struct StaticOrder {
    int nM, nN, nwg, G, c;
    __host__ __device__ void init(int M, int N, int G_, int c_) { nM = M / BM; nN = N / BM; nwg = nM * nN; G = G_; c = c_; }
    __host__ __device__ __forceinline__ bool next(int i, Unit& u) const {
        const long L = (long)i * G + c; if (L >= nwg) return false;
        int wgid = (int)L; { const int q = nwg / NXCD, r = nwg % NXCD, xcd = wgid % NXCD, off = wgid / NXCD; wgid = (xcd < r ? xcd * (q + 1) : r * (q + 1) + (xcd - r) * q) + off; }
        const int nig = WGM * nN, gid = wgid / nig, fm = gid * WGM, gsz = (nM - fm) < WGM ? (nM - fm) : WGM;
        u.pm = fm + ((wgid % nig) % gsz); u.pn = (wgid % nig) / gsz; u.ord = i; return true;
    }
    __device__ __forceinline__ void a_ready(const Unit&) const {}
    __device__ __forceinline__ void done(const Unit&) const {}
};

typedef __bf16 bf16x2v_ __attribute__((ext_vector_type(2))); typedef float f32x2v_ __attribute__((ext_vector_type(2)));
__device__ __forceinline__ unsigned cvt_pk_bf16(float lo, float hi) { const f32x2v_ v = {lo, hi}; const bf16x2v_ b = __builtin_convertvector(v, bf16x2v_); return __builtin_bit_cast(unsigned, b); }
typedef float f32x2 __attribute__((ext_vector_type(2)));
template <class Epi, class Sched, bool ALIGN_EPI = false, bool SP2 = false>
__device__ __forceinline__ void gemm_phase(PG8_LAS unsigned char* lds, const Gemm g, const Sched& S, const Epi& E) {
    const int tid = opq_tid(), wid = __builtin_amdgcn_readfirstlane(tid >> 6), lane = tid & 63, wr = wid >> 2, wc = wid & 3, fr = lane & 15, fq = lane >> 4;
    const int K = g.K, nt = K / BK;
    unsigned voffA[2], voffB[2];
#pragma unroll
    for (int i = 0; i < 2; ++i) { int R, C; stage_rc(tid * 16 + i * 8192, R, C); const int Rb = Epi::PERM ? ((R & ~31) + perm32(R & 31)) : R;
        voffA[i] = (unsigned)(R * K + C) * 2u; voffB[i] = (unsigned)(Rb * K + C) * 2u; }
    const size_t kstep = (size_t)(BK * 2);
    const size_t hstep = (size_t)HALF * K * 2;
    const size_t tstep = 2 * hstep;
    const unsigned ldsw = (unsigned)wid * 1024u;
    const int aoff = lds_byte(wr * 64 + fr, fq * 8), boff = lds_byte(wc * 32 + fr, fq * 8);
#define PG8_SA(b, h) (((b) * 2 + (h)) * HTB)
#define PG8_SB(b, h) ((4 + (b) * 2 + (h)) * HTB)
#define PG8_STAGE(bufoff, gbase, voff) do { _Pragma("unroll") for (int _i = 0; _i < 2; ++_i) \
        __builtin_amdgcn_global_load_lds((const unsigned*)((const char*)(gbase) + (voff)[_i]), (PG8_LAS unsigned*)(lds + (bufoff) + ldsw + _i * 8192), 16, 0, 0); } while (0)
#define PG8_LDA(dst, b, h) do { _Pragma("unroll") for (int m = 0; m < 4; ++m) _Pragma("unroll") for (int k = 0; k < 2; ++k) dst[m][k] = *(const PG8_LAS bf16x8*)(lds + PG8_SA(b, h) + aoff + m * 2048 + k * 1024); } while (0)
#define PG8_LDB(dst, b, h) do { _Pragma("unroll") for (int n = 0; n < 2; ++n) _Pragma("unroll") for (int k = 0; k < 2; ++k) dst[n][k] = *(const PG8_LAS bf16x8*)(lds + PG8_SB(b, h) + boff + n * 2048 + k * 1024); } while (0)
#define PG8_MMA(ai, bj, At, Bt) do { __builtin_amdgcn_s_setprio(1); _Pragma("unroll") for (int m = 0; m < 4; ++m) _Pragma("unroll") for (int n = 0; n < 2; ++n) _Pragma("unroll") for (int k = 0; k < 2; ++k) \
        acc[ai][bj][m][n] = __builtin_amdgcn_mfma_f32_16x16x32_bf16(Bt[n][k], At[m][k], acc[ai][bj][m][n], 0, 0, 0); __builtin_amdgcn_s_setprio(0); } while (0)
#define PG8_WAIT_V(n) asm volatile("s_waitcnt vmcnt(" #n ")" ::: "memory")
#define PG8_WAIT_L(n) asm volatile("s_waitcnt lgkmcnt(" #n ")" ::: "memory")
#define PG8_BAR __builtin_amdgcn_s_barrier()
#define PG8_SCHED __builtin_amdgcn_sched_barrier(0)
    Unit cur, nxt; int ui = 0;
    if (!S.next(0, cur)) return;
    f32x4 acc[2][2][4][2];
#pragma unroll
    for (int a = 0; a < 2; ++a)
#pragma unroll
        for (int b = 0; b < 2; ++b)
#pragma unroll
            for (int m = 0; m < 4; ++m)
#pragma unroll
                for (int n = 0; n < 2; ++n) acc[a][b][m][n] = (f32x4){0.f, 0.f, 0.f, 0.f};
    bf16x8 At[4][2], B0[2][2], B1[2][2];
    const char* cA = (const char*)g.A + (size_t)cur.pm * tstep; const char* cB = (const char*)g.Bt + (size_t)cur.pn * tstep;
    S.a_ready(cur);
    if constexpr (SP2) {
        PG8_STAGE(PG8_SB(0, 0), cB, voffB); PG8_STAGE(PG8_SB(0, 1), cB + hstep, voffB); PG8_STAGE(PG8_SA(0, 0), cA, voffA); PG8_STAGE(PG8_SA(0, 1), cA + hstep, voffA);
        if (wr == 1) PG8_BAR;
        PG8_WAIT_V(2); PG8_BAR;
        PG8_STAGE(PG8_SB(1, 0), cB + kstep, voffB); PG8_STAGE(PG8_SA(1, 0), cA + kstep, voffA); PG8_STAGE(PG8_SB(1, 1), cB + hstep + kstep, voffB);
        PG8_WAIT_V(6); PG8_BAR;
    } else {
        PG8_STAGE(PG8_SB(0, 0), cB, voffB); PG8_STAGE(PG8_SA(0, 0), cA, voffA); PG8_STAGE(PG8_SB(0, 1), cB + hstep, voffB); PG8_STAGE(PG8_SA(0, 1), cA + hstep, voffA);
        if (wr == 1) PG8_BAR;
        PG8_WAIT_V(4); PG8_BAR;
        PG8_STAGE(PG8_SB(1, 0), cB + kstep, voffB); PG8_STAGE(PG8_SA(1, 0), cA + kstep, voffA); PG8_STAGE(PG8_SB(1, 1), cB + hstep + kstep, voffB);
        PG8_WAIT_V(6); PG8_BAR;
    }
    for (;;) {
        const bool has_next = S.next(ui + 1, nxt);
        const char* nA = has_next ? (const char*)g.A + (size_t)nxt.pm * tstep : cA; const char* nB = has_next ? (const char*)g.Bt + (size_t)nxt.pn * tstep : cB;
        for (int t = 0; t < nt; t += 2) {
            const bool last = (t == nt - 2);
            const char* a1 = cA + (size_t)(t + 1) * kstep;
            const char* a2 = last ? nA : cA + (size_t)(t + 2) * kstep; const char* b2 = last ? nB : cB + (size_t)(t + 2) * kstep;
            const char* a3 = a2 + kstep; const char* b3 = b2 + kstep;
            if (last && has_next) S.a_ready(nxt);
            if constexpr (SP2) {
            PG8_LDB(B0, 0, 0); PG8_LDB(B1, 0, 1); PG8_SCHED; PG8_LDA(At, 0, 0); PG8_STAGE(PG8_SA(1, 1), a1 + hstep, voffA);
            PG8_WAIT_V(8); PG8_WAIT_L(0); PG8_BAR; PG8_MMA(0, 0, At, B0); PG8_MMA(0, 1, At, B1); PG8_BAR; PG8_SCHED;
            PG8_LDA(At, 0, 1); PG8_STAGE(PG8_SB(0, 0), b2, voffB); PG8_STAGE(PG8_SB(0, 1), b2 + hstep, voffB); PG8_STAGE(PG8_SA(0, 0), a2, voffA);
            PG8_WAIT_V(8); PG8_WAIT_L(0); PG8_BAR; PG8_MMA(1, 0, At, B0); PG8_MMA(1, 1, At, B1); PG8_BAR; PG8_SCHED;
            PG8_LDB(B0, 1, 0); PG8_LDB(B1, 1, 1); PG8_SCHED; PG8_LDA(At, 1, 0); PG8_STAGE(PG8_SA(0, 1), a2 + hstep, voffA);
            PG8_WAIT_V(8); PG8_WAIT_L(0); PG8_BAR; PG8_MMA(0, 0, At, B0); PG8_MMA(0, 1, At, B1); PG8_BAR; PG8_SCHED;
            PG8_LDA(At, 1, 1); PG8_STAGE(PG8_SB(1, 0), b3, voffB); PG8_STAGE(PG8_SB(1, 1), b3 + hstep, voffB); PG8_STAGE(PG8_SA(1, 0), a3, voffA);
            PG8_WAIT_V(8); PG8_WAIT_L(0); PG8_BAR; PG8_MMA(1, 0, At, B0); PG8_MMA(1, 1, At, B1); PG8_BAR; PG8_SCHED;
            } else {
            PG8_LDB(B0, 0, 0); PG8_SCHED; PG8_LDA(At, 0, 0); PG8_STAGE(PG8_SA(1, 1), a1 + hstep, voffA);
            PG8_WAIT_L(8); PG8_BAR; PG8_WAIT_L(0); PG8_MMA(0, 0, At, B0); PG8_BAR; PG8_SCHED;
            PG8_LDB(B1, 0, 1); PG8_STAGE(PG8_SB(0, 0), b2, voffB);
            PG8_BAR; PG8_WAIT_L(0); PG8_MMA(0, 1, At, B1); PG8_BAR;
            PG8_LDA(At, 0, 1); PG8_STAGE(PG8_SA(0, 0), a2, voffA);
            PG8_BAR; PG8_WAIT_L(0); PG8_MMA(1, 0, At, B0); PG8_BAR; PG8_SCHED;
            PG8_STAGE(PG8_SB(0, 1), b2 + hstep, voffB);
            PG8_WAIT_V(6); PG8_BAR; PG8_MMA(1, 1, At, B1); PG8_BAR;
            PG8_LDB(B0, 1, 0); PG8_SCHED; PG8_LDA(At, 1, 0); PG8_STAGE(PG8_SA(0, 1), a2 + hstep, voffA);
            PG8_WAIT_L(8); PG8_BAR; PG8_WAIT_L(0); PG8_MMA(0, 0, At, B0); PG8_BAR; PG8_SCHED;
            PG8_LDB(B1, 1, 1); PG8_STAGE(PG8_SB(1, 0), b3, voffB);
            PG8_BAR; PG8_WAIT_L(0); PG8_MMA(0, 1, At, B1); PG8_BAR;
            PG8_LDA(At, 1, 1); PG8_STAGE(PG8_SA(1, 0), a3, voffA);
            PG8_BAR; PG8_WAIT_L(0); PG8_MMA(1, 0, At, B0); PG8_BAR; PG8_SCHED;
            PG8_STAGE(PG8_SB(1, 1), b3 + hstep, voffB);
            PG8_WAIT_V(6); PG8_BAR; PG8_MMA(1, 1, At, B1); PG8_BAR;
            }
        }
        if constexpr (ALIGN_EPI) { if (wr == 0) PG8_BAR; }
        if constexpr (!Epi::AFTER_DRAIN) { E(acc, cur, wr, wc, fr, fq); S.done(cur); }
        if (!has_next) break;
#pragma unroll
        for (int a = 0; a < 2; ++a)
#pragma unroll
            for (int b = 0; b < 2; ++b)
#pragma unroll
                for (int m = 0; m < 4; ++m)
#pragma unroll
                    for (int n = 0; n < 2; ++n) acc[a][b][m][n] = (f32x4){0.f, 0.f, 0.f, 0.f};
        cur = nxt; cA = nA; cB = nB; ++ui;
        if constexpr (ALIGN_EPI) { if (wr == 1) PG8_BAR; }
    }
    PG8_WAIT_V(0);
    if constexpr (!ALIGN_EPI) { if (wr == 0) PG8_BAR; }
    PG8_BAR;
    if constexpr (Epi::AFTER_DRAIN) { E.fused(acc, cur, wr, wc, fr, fq, lds, wid, lane); S.done(cur); }
#undef PG8_SA
#undef PG8_SB
#undef PG8_STAGE
#undef PG8_LDA
#undef PG8_LDB
#undef PG8_MMA
#undef PG8_WAIT_V
#undef PG8_WAIT_L
#undef PG8_BAR
#undef PG8_SCHED
}
}

#ifndef ONE_LAUNCH
#define ONE_LAUNCH 1
#endif
using pg8::bf16_t; using pg8::bf16x8; using pg8::f32x4; using pg8::u32x4; using pg8::Unit; using pg8::cvt_pk_bf16;
typedef unsigned u32x2 __attribute__((ext_vector_type(2)));
typedef unsigned short u16x4 __attribute__((ext_vector_type(4)));

constexpr int T = 16384, D = 1024, FF = 2816, NCAT = 6656, HALFCAT = 3328, QW = 3072, KVW = 6144;
constexpr float RMS_EPS = 1e-6f;
constexpr int LDS_BYTES = 147456;
constexpr int NSTEPS = 38;

constexpr size_t WS_BAR = 0;
constexpr size_t WS_WIN = 1u << 20;
constexpr size_t SZ_WIN = (size_t)5632 * 1024 * 2;
constexpr size_t WS_WOUT = WS_WIN + 8 * SZ_WIN;
constexpr size_t SZ_WOUT = (size_t)1024 * 2816 * 2;
constexpr size_t WS_WCAT = WS_WOUT + 8 * SZ_WOUT;
constexpr size_t SZ_WCAT = (size_t)NCAT * 1024 * 2;
constexpr size_t WS_WOR = WS_WCAT + 2 * SZ_WCAT;
constexpr size_t SZ_SQ = (size_t)1024 * 1024 * 2;
constexpr size_t WS_WUP = WS_WOR + 2 * SZ_SQ;
constexpr size_t SZ_UP = (size_t)1024 * 64 * 2;
constexpr size_t WS_WKV = WS_WUP + 8 * SZ_UP;
constexpr size_t WS_WQ = WS_WKV + (size_t)KVW * 1024 * 2;
constexpr size_t SZ_WQ = (size_t)QW * 1024 * 2;
constexpr size_t WS_WOA = WS_WQ + 2 * SZ_WQ;
constexpr size_t WS_XB = WS_WOA + 2 * SZ_SQ;
constexpr size_t SZ_TD2 = (size_t)T * 1024 * 2;
constexpr size_t WS_BIG = WS_XB + SZ_TD2;
constexpr size_t SZ_BIG = (size_t)T * NCAT * 2;
constexpr size_t WS_MIX = WS_BIG + SZ_BIG;
constexpr size_t WS_SS = WS_MIX + 8 * SZ_TD2;
constexpr size_t SZ_SS = (size_t)T * 16 * 4;
constexpr size_t WS_END = WS_SS + 13 * SZ_SS;
constexpr size_t BIG_Y = 0, BIG_YG = (size_t)T * 1024 * 4;
constexpr size_t BIG_Q = 0, BIG_OG = (size_t)T * QW * 2, BIG_LSE = BIG_OG + 3 * SZ_TD2;
static_assert(BIG_LSE + (size_t)3 * T * 16 * 4 <= SZ_BIG, "big");

struct Args { const float* in[30]; float* out; unsigned char* ws; int ph_lo, ph_hi; };

__device__ __forceinline__ float bf2f(unsigned short v) { return __uint_as_float((unsigned)v << 16); }
__device__ __forceinline__ float bflo(unsigned v) { return __uint_as_float(v << 16); }
__device__ __forceinline__ float bfhi(unsigned v) { return __uint_as_float(v & 0xffff0000u); }
__device__ __forceinline__ float row_rs(const float* ssp, int row) { const f32x4* q = (const f32x4*)(ssp + (size_t)row * 16); const f32x4 a = q[0], b = q[1], c = q[2], d = q[3];
    const float s = ((a[0] + a[1]) + (a[2] + a[3])) + ((b[0] + b[1]) + (b[2] + b[3])) + (((c[0] + c[1]) + (c[2] + c[3])) + ((d[0] + d[1]) + (d[2] + d[3]))); return rsqrtf(s * (1.f / 1024.f) + RMS_EPS); }
__device__ __forceinline__ float sigm(float x) { return __builtin_amdgcn_rcpf(1.f + __expf(-x)); }
__device__ __forceinline__ float tanh_fast(float x) { const float e = __expf(2.f * x); return 1.f - 2.f * __builtin_amdgcn_rcpf(e + 1.f); }
#define LAS __attribute__((address_space(3)))
#define XB_TMO      128
#define XB_XCNT(j)  (256  + 64 * (j))
#define XB_XSUB(j)  (1280 + 64 * (j))
#define XB_XGEN(j)  (2304 + 64 * (j))
#define XB_TOP      3328
#define XB_TOPGEN   3392
#define XCD_BAR_WORDS 3456
#define XB_SPIN_CAP (1u << 18)

__device__ __forceinline__ unsigned xb_ld(unsigned* p)              { return __hip_atomic_load(p, __ATOMIC_RELAXED, __HIP_MEMORY_SCOPE_AGENT); }
__device__ __forceinline__ unsigned xb_add(unsigned* p, unsigned v) { return __hip_atomic_fetch_add(p, v, __ATOMIC_RELAXED, __HIP_MEMORY_SCOPE_AGENT); }
__device__ __forceinline__ unsigned xb_xcc_id() { return (unsigned)__builtin_amdgcn_s_getreg((3 << 11) | 20) & 0xFu; }
#define XB_SPIN(cond, bar) do { unsigned _sp = 0; while (cond) { __builtin_amdgcn_s_sleep(1); \
    if ((++_sp & 255u) == 0u) { if (xb_ld(&(bar)[XB_TMO])) break; if (_sp > XB_SPIN_CAP) { atomicAdd(&(bar)[XB_TMO], 1u); break; } } } } while (0)

struct XcdBarrier {
    unsigned* bar; unsigned x;
    volatile LAS unsigned* st;
};

__device__ __forceinline__ XcdBarrier xcd_barrier_post(unsigned* bar, volatile LAS unsigned* st) {
    XcdBarrier b; b.bar = bar; b.x = xb_xcc_id(); b.st = st;
    if (threadIdx.x == 0) (void)xb_add(&bar[XB_XCNT(b.x)], 1u);
    return b;
}
__device__ __forceinline__ void xcd_barrier_complete(unsigned* bar, unsigned x, unsigned& nloc, unsigned& nx) {
    const unsigned G = gridDim.x * gridDim.y * gridDim.z;
    unsigned sum, cnt, mine, sp = 0u;
    for (;;) {
        sum = 0u; cnt = 0u; mine = 0u;
#pragma unroll
        for (unsigned j = 0; j < 16; ++j) { const unsigned c = xb_ld(&bar[XB_XCNT(j)]); sum += c; cnt += (c > 0u) ? 1u : 0u; mine = (j == x) ? c : mine; }
        if (sum == G) break;
        __builtin_amdgcn_s_sleep(1);
        if ((++sp & 255u) == 0u) { if (xb_ld(&bar[XB_TMO])) break; if (sp > XB_SPIN_CAP) { atomicAdd(&bar[XB_TMO], 1u); break; } }
    }
    nloc = mine > 0u ? mine : 1u; nx = cnt > 0u ? cnt : 1u;
}

__device__ __forceinline__ void xcd_barrier(const XcdBarrier& b) {
    asm volatile("s_waitcnt vmcnt(0)" ::: "memory");
    __syncthreads();
    if (threadIdx.x == 0) {
        unsigned* bar = b.bar;
        __builtin_amdgcn_s_waitcnt(0);
        unsigned nloc = b.st[0], nx = b.st[1];
        if (nloc == 0u) { xcd_barrier_complete(bar, b.x, nloc, nx); b.st[0] = nloc; b.st[1] = nx; }
        const unsigned old = xb_add(&bar[XB_XSUB(b.x)], 1u);
        const unsigned gen = old / nloc;
        if (old + 1u == (gen + 1u) * nloc) {
            __builtin_amdgcn_fence(__ATOMIC_RELEASE, "agent");
            asm volatile("s_waitcnt vmcnt(0)" ::: "memory");
            const unsigned og = xb_add(&bar[XB_TOP], 1u);
            const unsigned tg = og / nx;
            if (og + 1u == (tg + 1u) * nx) xb_add(&bar[XB_TOPGEN], 1u);
            else XB_SPIN(xb_ld(&bar[XB_TOPGEN]) == tg, bar);
            __builtin_amdgcn_fence(__ATOMIC_ACQUIRE, "agent");
            xb_add(&bar[XB_XGEN(b.x)], 1u);
            asm volatile("s_waitcnt vmcnt(0)" ::: "memory");
        } else {
            XB_SPIN(xb_ld(&bar[XB_XGEN(b.x)]) == gen, bar);
            __builtin_amdgcn_fence(__ATOMIC_ACQUIRE, "agent");
            asm volatile("s_waitcnt vmcnt(0)" ::: "memory");
        }
    }
    __syncthreads();
}
struct EpiPlain {
    static constexpr bool PERM = true, AFTER_DRAIN = false;
    bf16_t* O; int ldc;
    __device__ __forceinline__ void operator()(const f32x4 (&acc)[2][2][4][2], const Unit& u, int wr, int wc, int fr, int fq) const {
        const int row0 = u.pm * 256 + wr * 64 + fr, col0 = u.pn * 256 + wc * 32 + 8 * fq;
#pragma unroll
        for (int ai = 0; ai < 2; ++ai)
#pragma unroll
            for (int m = 0; m < 4; ++m) { bf16_t* rowp = O + (size_t)(row0 + ai * 128 + m * 16) * ldc + col0;
#pragma unroll
                for (int bj = 0; bj < 2; ++bj) { const f32x4 v0 = acc[ai][bj][m][0], v1 = acc[ai][bj][m][1]; u32x4 w;
                    w.x = cvt_pk_bf16(v0[0], v0[1]); w.y = cvt_pk_bf16(v0[2], v0[3]); w.z = cvt_pk_bf16(v1[0], v1[1]); w.w = cvt_pk_bf16(v1[2], v1[3]);
                    *(u32x4*)(rowp + bj * 128) = w; } }
    }
};
struct EpiSwiglu {
    static constexpr bool PERM = true, AFTER_DRAIN = false;
    bf16_t* O; const float* ss; const PG8_LAS float* rtab;
    __device__ __forceinline__ void operator()(const f32x4 (&acc)[2][2][4][2], const Unit& u, int wr, int wc, int fr, int fq) const {
        const int row0 = u.pm * 256 + wr * 64 + fr, col0 = u.pn * 128 + wc * 32 + 8 * fq; const PG8_LAS float* rt = rtab + u.ord * 256 + wr * 64 + fr;
#pragma unroll
        for (int ai = 0; ai < 2; ++ai)
#pragma unroll
            for (int m = 0; m < 4; ++m) { const int row = row0 + ai * 128 + m * 16; const float rs = rt[ai * 128 + m * 16];
                float o[8];
#pragma unroll
                for (int n = 0; n < 2; ++n)
#pragma unroll
                    for (int e = 0; e < 4; ++e) { const float g = acc[ai][0][m][n][e] * rs, up = acc[ai][1][m][n][e] * rs; o[n * 4 + e] = g * sigm(g) * up; }
                u32x4 w; w.x = cvt_pk_bf16(o[0], o[1]); w.y = cvt_pk_bf16(o[2], o[3]); w.z = cvt_pk_bf16(o[4], o[5]); w.w = cvt_pk_bf16(o[6], o[7]);
                *(u32x4*)(O + (size_t)row * FF + col0) = w; }
    }
};
struct EpiResid {
    static constexpr bool PERM = true, AFTER_DRAIN = false;
    const float* xold; float* xnew; bf16_t* xb; float* ssn; float alpha;
    __device__ __forceinline__ void operator()(const f32x4 (&acc)[2][2][4][2], const Unit& u, int wr, int wc, int fr, int fq) const {
        const int row0 = u.pm * 256 + wr * 64 + fr, col0 = u.pn * 256 + wc * 32 + 8 * fq;
#pragma unroll
        for (int ai = 0; ai < 2; ++ai)
#pragma unroll
            for (int m = 0; m < 4; ++m) { const int row = row0 + ai * 128 + m * 16; float s = 0.f;
#pragma unroll
                for (int bj = 0; bj < 2; ++bj) { const size_t off = (size_t)row * D + col0 + bj * 128;
                    const f32x4 xo0 = *(const f32x4*)(xold + off), xo1 = *(const f32x4*)(xold + off + 4);
                    const f32x4 xn0 = xo0 + acc[ai][bj][m][0] * alpha, xn1 = xo1 + acc[ai][bj][m][1] * alpha;
                    *(f32x4*)(xnew + off) = xn0; *(f32x4*)(xnew + off + 4) = xn1;
                    s += ((xn0[0] * xn0[0] + xn0[1] * xn0[1]) + (xn0[2] * xn0[2] + xn0[3] * xn0[3])) + ((xn1[0] * xn1[0] + xn1[1] * xn1[1]) + (xn1[2] * xn1[2] + xn1[3] * xn1[3]));
                    u32x4 w; w.x = cvt_pk_bf16(xn0[0], xn0[1]); w.y = cvt_pk_bf16(xn0[2], xn0[3]); w.z = cvt_pk_bf16(xn1[0], xn1[1]); w.w = cvt_pk_bf16(xn1[2], xn1[3]); *(u32x4*)(xb + off) = w; }
                s += __shfl_xor(s, 16); s += __shfl_xor(s, 32);
                if (fq == 0) ssn[(size_t)row * 16 + u.pn * 4 + wc] = s; }
    }
};
struct EpiHeadNorm {
    static constexpr bool PERM = true, AFTER_DRAIN = false;
    bf16_t* O; int ldc; const float* ss; const float* gain; int nnorm; float scale; const PG8_LAS float* rtab;
    __device__ __forceinline__ void operator()(const f32x4 (&acc)[2][2][4][2], const Unit& u, int wr, int wc, int fr, int fq) const {
        const int row0 = u.pm * 256 + wr * 64 + fr; const int head = u.pn * 4 + wc; const bool normed = head < nnorm; const int g = (head >> 4) % 3;
        float gn[2][8];
#pragma unroll
        for (int bj = 0; bj < 2; ++bj)
#pragma unroll
            for (int j = 0; j < 8; ++j) gn[bj][j] = normed ? gain[g * 64 + bj * 32 + 8 * fq + j] * scale : 1.f;
#pragma unroll
        for (int ai = 0; ai < 2; ++ai)
#pragma unroll
            for (int m = 0; m < 4; ++m) { const int row = row0 + ai * 128 + m * 16; const float rs = rtab[u.ord * 256 + wr * 64 + fr + ai * 128 + m * 16];
                float v[2][8]; float s = 0.f;
#pragma unroll
                for (int bj = 0; bj < 2; ++bj)
#pragma unroll
                    for (int n = 0; n < 2; ++n)
#pragma unroll
                        for (int e = 0; e < 4; ++e) { const float x = acc[ai][bj][m][n][e] * rs; v[bj][n * 4 + e] = x; s += x * x; }
                s += __shfl_xor(s, 16); s += __shfl_xor(s, 32);
                const float inv = normed ? rsqrtf(s * (1.f / 64.f) + RMS_EPS) : 1.f;
#pragma unroll
                for (int bj = 0; bj < 2; ++bj) { float o[8];
#pragma unroll
                    for (int j = 0; j < 8; ++j) o[j] = v[bj][j] * inv * gn[bj][j];
                    u32x4 w; w.x = cvt_pk_bf16(o[0], o[1]); w.y = cvt_pk_bf16(o[2], o[3]); w.z = cvt_pk_bf16(o[4], o[5]); w.w = cvt_pk_bf16(o[6], o[7]);
                    const int hh = head % 48, pg_ = hh >> 4, sh_ = 2 * pg_; const int pos = (row & ((1 << sh_) - 1)) * (T >> sh_) + (row >> sh_);
                    *(u32x4*)(O + (head >= 48 ? (size_t)48 * T * 64 : (size_t)0) + ((size_t)hh * T + pos) * 64 + bj * 32 + 8 * fq) = w; } }
    }
};
struct MatDesc { const float* W; int K, N; bf16_t* dst; int dstK, row_off, maptype; const float* s1; const float* s2; int s2mode; };
__device__ __forceinline__ int map_row(int maptype, int n) {
    if (maptype == 1) { const int u = n % FF, isup = n / FF; return (u >> 7) * 256 + isup * 128 + (u & 127); }
    if (maptype == 2) { const int tile = n >> 8, w = n & 255, head = w >> 6, d = w & 63; return tile * 256 + (d >> 5) * 128 + head * 32 + (d & 31); }
    return n;
}
struct ConvRegs { f32x4 v[2]; float sc[2]; };
__device__ __forceinline__ void conv_load(const MatDesc& md, int tile, ConvRegs& R) {
    const int tid = pg8::opq_tid(); const int ntn = (md.N + 63) >> 6; const int kt = tile / ntn, nt = tile - kt * ntn; const int k0 = kt * 64, n0 = nt * 64;
#pragma unroll
    for (int p = 0; p < 2; ++p) { const int kk = p * 32 + (tid >> 4), nn = (tid & 15) * 4, k = k0 + kk;
        f32x4 v = {0.f, 0.f, 0.f, 0.f}; float sc = 1.f;
        if (k < md.K) { if (n0 + nn < md.N) v = *(const f32x4*)(md.W + (size_t)k * md.N + n0 + nn);
            if (md.s1) sc = md.s1[k]; if (md.s2mode == 1) sc *= md.s2[k]; else if (md.s2mode == 2) sc *= (1.f - md.s2[k]); }
        R.v[p] = v; R.sc[p] = sc; }
}
__device__ __forceinline__ void conv_store(const MatDesc& md, int tile, const ConvRegs& R, float* tl) {
    const int tid = pg8::opq_tid(); const int ntn = (md.N + 63) >> 6; const int kt = tile / ntn, nt = tile - kt * ntn; const int k0 = kt * 64, n0 = nt * 64;
#pragma unroll
    for (int p = 0; p < 2; ++p) { const int kk = p * 32 + (tid >> 4), nn = (tid & 15) * 4; const f32x4 v = R.v[p]; const float sc = R.sc[p];
        tl[kk * 65 + nn + 0] = v[0] * sc; tl[kk * 65 + nn + 1] = v[1] * sc; tl[kk * 65 + nn + 2] = v[2] * sc; tl[kk * 65 + nn + 3] = v[3] * sc; }
    asm volatile("s_waitcnt lgkmcnt(0)" ::: "memory"); __builtin_amdgcn_s_barrier(); asm volatile("" ::: "memory");
    { const int n = tid >> 3, kc = tid & 7;
      if (n0 + n < md.N && k0 + kc * 8 < md.dstK) { float o[8];
#pragma unroll
          for (int j = 0; j < 8; ++j) o[j] = tl[(kc * 8 + j) * 65 + n];
          u32x4 w; w.x = cvt_pk_bf16(o[0], o[1]); w.y = cvt_pk_bf16(o[2], o[3]); w.z = cvt_pk_bf16(o[4], o[5]); w.w = cvt_pk_bf16(o[6], o[7]);
          const int drow = md.row_off + map_row(md.maptype, n0 + n);
          *(u32x4*)(md.dst + (size_t)drow * md.dstK + k0 + kc * 8) = w; } }
    asm volatile("s_waitcnt lgkmcnt(0)" ::: "memory"); __builtin_amdgcn_s_barrier(); asm volatile("" ::: "memory");
}
__device__ __forceinline__ bool get_mat(const Args& a, int mi, MatDesc& md) {
    unsigned char* ws = pg8::opq_ptr(a.ws); md.s1 = nullptr; md.s2 = nullptr; md.s2mode = 0; md.row_off = 0; md.maptype = 0;
    if (mi < 8) { md.W = a.in[2] + (size_t)mi * 1024 * 5632; md.K = 1024; md.N = 5632; md.dst = (bf16_t*)(ws + WS_WIN + mi * SZ_WIN); md.dstK = 1024; md.maptype = 1; md.s1 = a.in[1] + mi * 1024; return true; }
    mi -= 8;
    if (mi < 8) { md.W = a.in[3] + (size_t)mi * 2816 * 1024; md.K = 2816; md.N = 1024; md.dst = (bf16_t*)(ws + WS_WOUT + mi * SZ_WOUT); md.dstK = 2816; return true; }
    mi -= 8;
    if (mi < 38) { const int l = mi / 19, r = mi % 19;
        if (r < 14) { const int part = r / 7, s = r % 7; md.K = 1024; md.dstK = 1024; md.dst = (bf16_t*)(ws + WS_WCAT + l * SZ_WCAT); md.s1 = a.in[4] + l * 1024; md.s2mode = part ? 1 : 2;
            const float* mu = a.in[5] + (size_t)l * 6 * 1024; int off;
            if (s == 0) { md.W = a.in[6] + (size_t)(l * 3 + 0) * 1024 * 1024; md.N = 1024; md.s2 = mu + 0 * 1024; off = 0; }
            else if (s == 1) { md.W = a.in[6] + (size_t)(l * 3 + 1) * 1024 * 1024; md.N = 1024; md.s2 = mu + 2 * 1024; off = 1024; }
            else if (s == 2) { md.W = a.in[6] + (size_t)(l * 3 + 2) * 1024 * 1024; md.N = 1024; md.s2 = mu + 3 * 1024; off = 2048; }
            else if (s == 3) { md.W = a.in[8] + (size_t)l * 1024 * 64; md.N = 64; md.s2 = mu + 1 * 1024; off = 3072; }
            else if (s == 4) { md.W = a.in[11] + (size_t)l * 1024 * 64; md.N = 64; md.s2 = mu + 4 * 1024; off = 3136; }
            else if (s == 5) { if (l == 0) return false; md.W = a.in[14]; md.N = 32; md.s2 = mu + 3 * 1024; off = 3200; }
            else { md.W = a.in[16] + (size_t)l * 1024 * 64; md.N = 64; md.s2 = mu + 5 * 1024; off = 3232; }
            md.row_off = off + part * HALFCAT; return true; }
        if (r == 14) { md.W = a.in[23] + (size_t)l * 1024 * 1024; md.K = 1024; md.N = 1024; md.dst = (bf16_t*)(ws + WS_WOR + l * SZ_SQ); md.dstK = 1024; return true; }
        const int ui = r - 15; md.N = 1024; md.dstK = 64; md.K = 64; md.dst = (bf16_t*)(ws + WS_WUP + (size_t)(l * 4 + ui) * SZ_UP);
        if (ui == 0) md.W = a.in[9] + (size_t)l * 64 * 1024;
        else if (ui == 1) md.W = a.in[12] + (size_t)l * 64 * 1024;
        else if (ui == 2) { if (l == 0) return false; md.W = a.in[15]; md.K = 32; }
        else md.W = a.in[17] + (size_t)l * 64 * 1024;
        return true; }
    mi -= 38;
    if (mi == 0) { md.W = a.in[25]; md.K = 1024; md.N = KVW; md.dst = (bf16_t*)(ws + WS_WKV); md.dstK = 1024; md.maptype = 2; md.s1 = a.in[24]; return true; }
    mi -= 1;
    if (mi < 2) { md.W = a.in[27] + (size_t)mi * 1024 * QW; md.K = 1024; md.N = QW; md.dst = (bf16_t*)(ws + WS_WQ + mi * SZ_WQ); md.dstK = 1024; md.maptype = 2; md.s1 = a.in[4] + (2 + mi) * 1024; return true; }
    mi -= 2;
    md.W = a.in[29] + (size_t)mi * 1024 * 1024; md.K = 1024; md.N = 1024; md.dst = (bf16_t*)(ws + WS_WOA + mi * SZ_SQ); md.dstK = 1024; return true;
}
constexpr int NMAT = 8 + 8 + 38 + 1 + 2 + 2;
__device__ __forceinline__ void zero_rows(bf16_t* base, int row0, int nrows) {
    const int gt = pg8::opq_bid() * 512 + pg8::opq_tid(), NT = gridDim.x * 512;
    for (int i = gt; i < nrows * 128; i += NT) *(u32x4*)(base + (size_t)row0 * 1024 + (size_t)i * 8) = (u32x4){0u, 0u, 0u, 0u};
}
__device__ __forceinline__ int conv_sel(int mi) {
    if (mi < 16) { const int idx = mi & 7; return idx == 0 ? 0 : (idx < 4 ? 1 : 2); }
    if (mi < 54) return (mi - 16) / 19;
    return 2;
}
__device__ __forceinline__ void p0_convert(const Args& a, float* tl, int sel, int vbid, int vG) {
    for (int mi = 0; mi < NMAT; ++mi) { if (conv_sel(mi) != sel) continue; MatDesc md; if (!get_mat(a, mi, md)) continue;
        const int ntiles = ((md.K + 63) >> 6) * ((md.N + 63) >> 6);
        const int G = vG; int tile = (vbid + mi * 37) % G; ConvRegs R[4];
#pragma unroll
        for (int k = 0; k < 4; ++k) if (tile + k * G < ntiles) conv_load(md, tile + k * G, R[k]);
        for (; tile < ntiles; tile += 4 * G) {
#pragma unroll
            for (int k = 0; k < 4; ++k) { const int tk = tile + k * G; if (tk < ntiles) { conv_store(md, tk, R[k], tl); const int tn = tk + 4 * G; if (tn < ntiles) conv_load(md, tn, R[k]); } } } }
}
__device__ __forceinline__ void p0_phase(const Args& a, float* tl) {
    unsigned char* ws = pg8::opq_ptr(a.ws);
    p0_convert(a, tl, 0, pg8::opq_bid(), gridDim.x);
    if (gridDim.x <= 64) { p0_convert(a, tl, 1, pg8::opq_bid(), gridDim.x); p0_convert(a, tl, 2, pg8::opq_bid(), gridDim.x); }
    for (int l = 0; l < 2; ++l) { bf16_t* wc = (bf16_t*)(ws + WS_WCAT + l * SZ_WCAT);
        zero_rows(wc, 3296, 32); zero_rows(wc, HALFCAT + 3296, 32);
        if (l == 0) { zero_rows(wc, 3200, 32); zero_rows(wc, HALFCAT + 3200, 32); } }
    { const int gw = pg8::opq_bid() * 8 + (pg8::opq_tid() >> 6), NGW = gridDim.x * 8, lane = pg8::opq_tid() & 63;
      const float* x = a.in[0]; bf16_t* xb = (bf16_t*)(ws + WS_XB); float* ss = (float*)(ws + WS_SS);
      for (int m = gw; m < T; m += NGW) { float s = 0.f;
#pragma unroll
          for (int j = 0; j < 4; ++j) { const f32x4 v = *(const f32x4*)(x + (size_t)m * D + j * 256 + lane * 4); s += (v[0] * v[0] + v[1] * v[1]) + (v[2] * v[2] + v[3] * v[3]);
              u32x2 w; w.x = cvt_pk_bf16(v[0], v[1]); w.y = cvt_pk_bf16(v[2], v[3]); *(u32x2*)(xb + (size_t)m * D + j * 256 + lane * 4) = w; }
#pragma unroll
          for (int o = 1; o < 64; o <<= 1) s += __shfl_xor(s, o);
          if (lane < 16) ss[(size_t)m * 16 + lane] = lane == 0 ? s : 0.f; }
    }
}
#define MFMA16(a, b, c) __builtin_amdgcn_mfma_f32_16x16x32_bf16((a), (b), (c), 0, 0, 0)
__device__ __forceinline__ void ld8(const bf16_t* p, float (&o)[8]) { const u32x4 w = *(const u32x4*)p; o[0] = bflo(w.x); o[1] = bfhi(w.x); o[2] = bflo(w.y); o[3] = bfhi(w.y); o[4] = bflo(w.z); o[5] = bfhi(w.z); o[6] = bflo(w.w); o[7] = bfhi(w.w); }
__device__ __forceinline__ void ld4(const bf16_t* p, float (&o)[4]) { const u32x2 w = *(const u32x2*)p; o[0] = bflo(w.x); o[1] = bfhi(w.x); o[2] = bflo(w.y); o[3] = bfhi(w.y); }
__device__ __forceinline__ void up8(const u32x4 w, float (&o)[8]) { o[0] = bflo(w.x); o[1] = bfhi(w.x); o[2] = bflo(w.y); o[3] = bfhi(w.y); o[4] = bflo(w.z); o[5] = bfhi(w.z); o[6] = bflo(w.w); o[7] = bfhi(w.w); }
__device__ __forceinline__ void up4(const u32x2 w, float (&o)[4]) { o[0] = bflo(w.x); o[1] = bfhi(w.x); o[2] = bflo(w.y); o[3] = bfhi(w.y); }
__device__ __forceinline__ bf16x8 pack8(const float (&o)[8]) { u32x4 w; w.x = cvt_pk_bf16(o[0], o[1]); w.y = cvt_pk_bf16(o[2], o[3]); w.z = cvt_pk_bf16(o[4], o[5]); w.w = cvt_pk_bf16(o[6], o[7]); return __builtin_bit_cast(bf16x8, w); }
__device__ __forceinline__ void st4(bf16_t* p, float a, float b, float c, float d) { u32x2 w; w.x = cvt_pk_bf16(a, b); w.y = cvt_pk_bf16(c, d); *(u32x2*)p = w; }

__device__ __forceinline__ void f1_phase(const Args& a, int l, unsigned char* lds) {
    unsigned char* ws = pg8::opq_ptr(a.ws); const int lane = pg8::opq_tid() & 63, wave = pg8::opq_tid() >> 6; const int gw = pg8::opq_bid() * 8 + wave, NGW = gridDim.x * 8;
    const int tok = lane & 15, q = lane >> 4;
    const bf16_t* P = (const bf16_t*)(ws + WS_BIG); const float* ss = (const float*)(ws + WS_SS) + (size_t)(3 * l + 1) * T * 16;
    const bf16_t* WUP = (const bf16_t*)(ws + WS_WUP + (size_t)l * 4 * SZ_UP);
    bf16_t* oR = (bf16_t*)(ws + WS_MIX); bf16_t* oLD = oR + (size_t)T * D; bf16_t* oK = oLD + (size_t)T * D; bf16_t* oA = oK + (size_t)T * D; bf16_t* oB = oA + (size_t)T * D;
    bf16_t* oV0 = oB + (size_t)T * D; bf16_t* oV1 = oV0 + (size_t)T * D; bf16_t* oG = oV1 + (size_t)T * D;
    bf16_t* oV = l ? oV1 : oV0;
    const float* w0 = a.in[7] + l * D; const float* a0 = a.in[10] + l * D; const float* v0 = a.in[13]; const float* kkp = a.in[18] + l * D; const float* kap = a.in[19] + l * D;
    const int bidf = pg8::opq_bid(); const int h = bidf & 15, grp = bidf >> 4, ngrp = gridDim.x >> 4; (void)gw; (void)NGW;
    bf16_t* wl = (bf16_t*)lds; float* pl = (float*)(lds + 4 * 64 * 72 * 2);
    { const int tidf = pg8::opq_tid();
      for (int i = tidf; i < 4 * 64 * 8; i += 512) { const int m = i >> 9, r = (i >> 3) & 63, c8 = (i & 7) * 8;
          u32x4 v = {0u, 0u, 0u, 0u}; if (m != 2 || l) v = *(const u32x4*)(WUP + (size_t)m * 1024 * 64 + (size_t)(h * 64 + r) * 64 + c8);
          *(u32x4*)(wl + (m * 64 + r) * 72 + c8) = v; }
      if (tidf < 320) { const int m = tidf >> 6, c = tidf & 63; float v = 0.f;
          if (m == 0) v = w0[h * 64 + c]; else if (m == 1) v = a0[h * 64 + c]; else if (m == 2) { if (l) v = v0[h * 64 + c]; } else if (m == 3) v = kkp[h * 64 + c]; else v = kap[h * 64 + c];
          pl[m * 64 + c] = v; } }
    __syncthreads();
    bf16_t* stg = (bf16_t*)(lds + 38400 + wave * 12288);
    for (int tt = grp * 8 + wave; tt < T / 16 && grp < ngrp; tt += ngrp * 8) {
        const int t = tt * 16 + tok;
        const float rs_c = row_rs(ss, t); const float rs_p = t > 0 ? row_rs(ss, t > 0 ? t - 1 : 0) : 0.f;
        const bf16_t* Pc = P + (size_t)t * NCAT; const bf16_t* Pp = P + (size_t)(t > 0 ? t - 1 : 0) * NCAT + HALFCAT;
        u32x4 Lw[2][2], La[2][2], Lg[2][2], Lv[2]; u32x2 Lr[4][2], Lk[4][2], Lvv[4][2], Lvf[4];
#pragma unroll
        for (int ks = 0; ks < 2; ++ks) { const int ko = ks * 32 + q * 8;
            Lw[ks][0] = *(const u32x4*)(Pc + 3072 + ko); Lw[ks][1] = *(const u32x4*)(Pp + 3072 + ko); La[ks][0] = *(const u32x4*)(Pc + 3136 + ko); La[ks][1] = *(const u32x4*)(Pp + 3136 + ko);
            Lg[ks][0] = *(const u32x4*)(Pc + 3232 + ko); Lg[ks][1] = *(const u32x4*)(Pp + 3232 + ko); }
        Lv[0] = *(const u32x4*)(Pc + 3200 + q * 8); Lv[1] = *(const u32x4*)(Pp + 3200 + q * 8);
        { const int srow = lane >> 3, ch8 = (lane & 7) * 8; const int t0 = tt * 16; u32x4 sv[6][2];
#pragma unroll
          for (int a6 = 0; a6 < 6; ++a6)
#pragma unroll
              for (int hf = 0; hf < 2; ++hf) { int tr = t0 + 8 * hf + srow - (a6 & 1); tr = tr < 0 ? 0 : tr;
                  sv[a6][hf] = *(const u32x4*)(P + (size_t)tr * NCAT + (a6 & 1) * HALFCAT + (a6 >> 1) * 1024 + h * 64 + ch8); }
#pragma unroll
          for (int a6 = 0; a6 < 6; ++a6)
#pragma unroll
              for (int hf = 0; hf < 2; ++hf) *(u32x4*)(stg + (a6 * 16 + 8 * hf + srow) * 64 + ch8) = sv[a6][hf];
          asm volatile("s_waitcnt lgkmcnt(0)" ::: "memory"); }
#pragma unroll
        for (int nt = 0; nt < 4; ++nt) { const int c0 = h * 64 + nt * 16 + 4 * q; const int cl4 = nt * 16 + 4 * q;
            Lr[nt][0] = *(const u32x2*)(stg + (0 * 16 + tok) * 64 + cl4); Lr[nt][1] = *(const u32x2*)(stg + (1 * 16 + tok) * 64 + cl4);
            Lk[nt][0] = *(const u32x2*)(stg + (2 * 16 + tok) * 64 + cl4); Lk[nt][1] = *(const u32x2*)(stg + (3 * 16 + tok) * 64 + cl4);
            Lvv[nt][0] = *(const u32x2*)(stg + (4 * 16 + tok) * 64 + cl4); Lvv[nt][1] = *(const u32x2*)(stg + (5 * 16 + tok) * 64 + cl4);
            Lvf[nt] = (u32x2){0u, 0u}; if (l) Lvf[nt] = *(const u32x2*)(oV0 + (size_t)t * D + c0); }
        asm volatile("s_waitcnt lgkmcnt(0)" ::: "memory");
        bf16x8 actW[2], actA[2], actG[2], actV;
#pragma unroll
        for (int ks = 0; ks < 2; ++ks) { float c[8], p[8], x[8];
            up8(Lw[ks][0], c); up8(Lw[ks][1], p);
#pragma unroll
            for (int j = 0; j < 8; ++j) x[j] = tanh_fast(rs_c * c[j] + rs_p * p[j]);
            actW[ks] = pack8(x);
            up8(La[ks][0], c); up8(La[ks][1], p);
#pragma unroll
            for (int j = 0; j < 8; ++j) x[j] = rs_c * c[j] + rs_p * p[j];
            actA[ks] = pack8(x);
            up8(Lg[ks][0], c); up8(Lg[ks][1], p);
#pragma unroll
            for (int j = 0; j < 8; ++j) x[j] = sigm(rs_c * c[j] + rs_p * p[j]);
            actG[ks] = pack8(x); }
        { float c[8], p[8], x[8]; up8(Lv[0], c); up8(Lv[1], p);
#pragma unroll
          for (int j = 0; j < 8; ++j) x[j] = rs_c * c[j] + rs_p * p[j];
          actV = pack8(x); }
        f32x4 Dw[4], Da[4], Dv[4], Dg[4];
#pragma unroll
        for (int nt = 0; nt < 4; ++nt) { const f32x4 z = {0.f, 0.f, 0.f, 0.f}; Dw[nt] = z; Da[nt] = z; Dv[nt] = z; Dg[nt] = z;
            const int wo = (nt * 16 + tok) * 72 + q * 8;
#pragma unroll
            for (int ks = 0; ks < 2; ++ks) {
                Dw[nt] = MFMA16(*(const bf16x8*)(wl + wo + ks * 32), actW[ks], Dw[nt]);
                Da[nt] = MFMA16(*(const bf16x8*)(wl + 64 * 72 + wo + ks * 32), actA[ks], Da[nt]);
                Dg[nt] = MFMA16(*(const bf16x8*)(wl + 3 * 64 * 72 + wo + ks * 32), actG[ks], Dg[nt]); }
            if (l) Dv[nt] = MFMA16(*(const bf16x8*)(wl + 2 * 64 * 72 + wo), actV, Dv[nt]);
            __builtin_amdgcn_sched_barrier(0); }
        float kkv[4][4], asg[4][4]; float ssq = 0.f;
#pragma unroll
        for (int nt = 0; nt < 4; ++nt) { const int c0 = h * 64 + nt * 16 + 4 * q; const size_t off = (size_t)t * D + c0;
            float rc[4], rp[4], kc[4], kp[4], vc[4], vp[4];
            up4(Lr[nt][0], rc); up4(Lr[nt][1], rp); up4(Lk[nt][0], kc); up4(Lk[nt][1], kp); up4(Lvv[nt][0], vc); up4(Lvv[nt][1], vp);
            const int cl = nt * 16 + 4 * q; const f32x4 w0v = *(const f32x4*)(pl + cl), a0v = *(const f32x4*)(pl + 64 + cl), kkw = *(const f32x4*)(pl + 192 + cl), kaw = *(const f32x4*)(pl + 256 + cl);
            float vf[4] = {0.f, 0.f, 0.f, 0.f}; f32x4 v0v = {0.f, 0.f, 0.f, 0.f};
            if (l) { up4(Lvf[nt], vf); v0v = *(const f32x4*)(pl + 128 + cl); }
            float ro[4], ldo[4], ko[4], vo[4], go[4];
#pragma unroll
            for (int e = 0; e < 4; ++e) {
                const float rr = rs_c * rc[e] + rs_p * rp[e], kx = rs_c * kc[e] + rs_p * kp[e]; float vx = rs_c * vc[e] + rs_p * vp[e];
                const float wl = w0v[e] + Dw[nt][e]; const float xx = -wl; const float sp = fmaxf(xx, 0.f) + __logf(1.f + __expf(-fabsf(xx)));
                ldo[e] = -__expf(-sp - 0.5f);
                const float as = sigm(a0v[e] + Da[nt][e]);
                if (l) vx = vx + (vf[e] - vx) * sigm(v0v[e] + Dv[nt][e]);
                const float kk = kx * kkw[e]; ssq += kk * kk; kkv[nt][e] = kk; asg[nt][e] = as;
                ro[e] = rr; ko[e] = kx * (1.f + (as - 1.f) * kaw[e]); vo[e] = vx; go[e] = Dg[nt][e]; }
            { const int so = tok * 64 + nt * 16 + 4 * q; (void)off;
              st4(stg + 0 * 1024 + so, ro[0], ro[1], ro[2], ro[3]); st4(stg + 1 * 1024 + so, ldo[0], ldo[1], ldo[2], ldo[3]); st4(stg + 2 * 1024 + so, ko[0], ko[1], ko[2], ko[3]);
              st4(stg + 3 * 1024 + so, vo[0], vo[1], vo[2], vo[3]); st4(stg + 4 * 1024 + so, go[0], go[1], go[2], go[3]); } }
        asm volatile("s_waitcnt lgkmcnt(0)" ::: "memory");
        { const int srow = lane >> 3, ch8 = (lane & 7) * 8;
#define F1_OUT(ptr, sl) do { _Pragma("unroll") for (int hf = 0; hf < 2; ++hf) *(u32x4*)((ptr) + (size_t)(tt * 16 + 8 * hf + srow) * D + h * 64 + ch8) = *(const u32x4*)(stg + (sl) * 1024 + (8 * hf + srow) * 64 + ch8); } while (0)
          F1_OUT(oR, 0); F1_OUT(oLD, 1); F1_OUT(oK, 2); F1_OUT(oV, 3); F1_OUT(oG, 4); }
        asm volatile("s_waitcnt lgkmcnt(0)" ::: "memory");
        ssq += __shfl_xor(ssq, 16); ssq += __shfl_xor(ssq, 32);
        const float inv = 1.f / fmaxf(sqrtf(ssq), 1e-12f);
#pragma unroll
        for (int nt = 0; nt < 4; ++nt) { const size_t off = (size_t)t * D + h * 64 + nt * 16 + 4 * q;
            float av[4], bv[4];
#pragma unroll
            for (int e = 0; e < 4; ++e) { const float kn = kkv[nt][e] * inv; av[e] = -kn; bv[e] = kn * asg[nt][e]; }
            { const int so = tok * 64 + nt * 16 + 4 * q; (void)off; st4(stg + so, av[0], av[1], av[2], av[3]); st4(stg + 1024 + so, bv[0], bv[1], bv[2], bv[3]); } }
        asm volatile("s_waitcnt lgkmcnt(0)" ::: "memory");
        { const int srow = lane >> 3, ch8 = (lane & 7) * 8; F1_OUT(oA, 0); F1_OUT(oB, 1); }
        asm volatile("s_waitcnt lgkmcnt(0)" ::: "memory");
    }
}

__device__ __forceinline__ void rseq_phase(const Args& a, int l, float* lds) {
    if (pg8::opq_bid() >= 16) return;
    unsigned char* ws = pg8::opq_ptr(a.ws); const int tid = pg8::opq_tid(), h = pg8::opq_bid();
    const bf16_t* base = (const bf16_t*)(ws + WS_MIX);
    float* Y = (float*)(ws + WS_BIG + BIG_Y);
    const int row = tid >> 2, cgp = tid & 3;
    float s[16];
#pragma unroll
    for (int j = 0; j < 16; ++j) s[j] = 0.f;
    for (int c0 = 0; c0 < T; c0 += 16) {
        __syncthreads();
#pragma unroll
        for (int i = 0; i < 12; ++i) { const int idx = tid + i * 512; const int arr = idx >> 10, rem = idx & 1023, st = rem >> 6, j = rem & 63;
            const int ga = arr == 5 ? (5 + l) : arr;
            float v = bf2f(base[(size_t)ga * T * D + (size_t)(c0 + st) * D + h * 64 + j]); if (arr == 1) v = __expf(v);
            lds[idx] = v; }
        __syncthreads();
        if (tid < 256) {
#pragma unroll 4
            for (int st = 0; st < 16; ++st) {
                const float* pR = lds + 0 * 1024 + st * 64 + cgp * 16; const float* pD = lds + 1 * 1024 + st * 64 + cgp * 16; const float* pK = lds + 2 * 1024 + st * 64 + cgp * 16;
                const float* pA = lds + 3 * 1024 + st * 64 + cgp * 16; const float* pB = lds + 4 * 1024 + st * 64 + cgp * 16;
                const float vv = lds[5 * 1024 + st * 64 + row];
                float sa = 0.f;
#pragma unroll
                for (int j = 0; j < 16; ++j) sa += s[j] * pA[j];
                sa += __shfl_xor(sa, 1); sa += __shfl_xor(sa, 2);
                float y = 0.f;
#pragma unroll
                for (int j = 0; j < 16; ++j) { s[j] = s[j] * pD[j] + sa * pB[j] + vv * pK[j]; y += s[j] * pR[j]; }
                y += __shfl_xor(y, 1); y += __shfl_xor(y, 2);
                if (cgp == 0) Y[(size_t)(c0 + st) * D + h * 64 + row] = y;
            }
        }
    }
}

__device__ __forceinline__ void f2_phase(const Args& a, int l) {
    unsigned char* ws = pg8::opq_ptr(a.ws); const int lane = pg8::opq_tid() & 63; const int gw = pg8::opq_bid() * 8 + (pg8::opq_tid() >> 6), NGW = gridDim.x * 8;
    const bf16_t* base = (const bf16_t*)(ws + WS_MIX); const float* Y = (const float*)(ws + WS_BIG + BIG_Y); bf16_t* YG = (bf16_t*)(ws + WS_BIG + BIG_YG);
    const bf16_t* pR = base; const bf16_t* pK = base + (size_t)2 * T * D; const bf16_t* pV = base + (size_t)(5 + l) * T * D; const bf16_t* pG = base + (size_t)7 * T * D;
    const float* lnw = a.in[21] + l * D; const float* lnb = a.in[22] + l * D; const float* rk = a.in[20] + l * D;
    const int c0 = lane * 16;
    for (int t = gw; t < T; t += NGW) { const size_t off = (size_t)t * D + c0;
        float y[16], r[16], k[16], v[16], g[16];
#pragma unroll
        for (int j = 0; j < 4; ++j) { const f32x4 yy = *(const f32x4*)(Y + off + j * 4); y[j * 4] = yy[0]; y[j * 4 + 1] = yy[1]; y[j * 4 + 2] = yy[2]; y[j * 4 + 3] = yy[3]; }
        { float tmp[8]; ld8(pR + off, tmp);
#pragma unroll
          for (int j = 0; j < 8; ++j) r[j] = tmp[j];
          ld8(pR + off + 8, tmp);
#pragma unroll
          for (int j = 0; j < 8; ++j) r[8 + j] = tmp[j];
          ld8(pK + off, tmp);
#pragma unroll
          for (int j = 0; j < 8; ++j) k[j] = tmp[j];
          ld8(pK + off + 8, tmp);
#pragma unroll
          for (int j = 0; j < 8; ++j) k[8 + j] = tmp[j];
          ld8(pV + off, tmp);
#pragma unroll
          for (int j = 0; j < 8; ++j) v[j] = tmp[j];
          ld8(pV + off + 8, tmp);
#pragma unroll
          for (int j = 0; j < 8; ++j) v[8 + j] = tmp[j];
          ld8(pG + off, tmp);
#pragma unroll
          for (int j = 0; j < 8; ++j) g[j] = tmp[j];
          ld8(pG + off + 8, tmp);
#pragma unroll
          for (int j = 0; j < 8; ++j) g[8 + j] = tmp[j]; }
        float sm = 0.f, bs = 0.f;
#pragma unroll
        for (int j = 0; j < 16; ++j) { sm += y[j]; bs += r[j] * k[j] * rk[c0 + j]; }
        sm += __shfl_xor(sm, 1); sm += __shfl_xor(sm, 2); bs += __shfl_xor(bs, 1); bs += __shfl_xor(bs, 2);
        const float mean = sm * (1.f / 64.f); float vr = 0.f;
#pragma unroll
        for (int j = 0; j < 16; ++j) { const float d = y[j] - mean; vr += d * d; }
        vr += __shfl_xor(vr, 1); vr += __shfl_xor(vr, 2);
        const float rstd = rsqrtf(vr * (1.f / 64.f) + 64e-5f);
        float o[16];
#pragma unroll
        for (int j = 0; j < 16; ++j) o[j] = ((y[j] - mean) * rstd * lnw[c0 + j] + lnb[c0 + j] + bs * v[j]) * g[j];
        u32x4 w0, w1; w0.x = cvt_pk_bf16(o[0], o[1]); w0.y = cvt_pk_bf16(o[2], o[3]); w0.z = cvt_pk_bf16(o[4], o[5]); w0.w = cvt_pk_bf16(o[6], o[7]);
        w1.x = cvt_pk_bf16(o[8], o[9]); w1.y = cvt_pk_bf16(o[10], o[11]); w1.z = cvt_pk_bf16(o[12], o[13]); w1.w = cvt_pk_bf16(o[14], o[15]);
        *(u32x4*)(YG + off) = w0; *(u32x4*)(YG + off + 8) = w1; }
}
constexpr size_t BIG_RH = 0, BIG_Y0 = (size_t)4096 * 8192, BIG_MM = BIG_Y0 + (size_t)4096 * 16384, BIG_NT = BIG_MM + (size_t)4096 * 8192;
static_assert(BIG_NT + (size_t)4096 * 16384 <= SZ_BIG, "big2");
__device__ __forceinline__ f32x4 ldbf4(const bf16_t* p) { const u32x2 w = *(const u32x2*)p; return (f32x4){bflo(w.x), bfhi(w.x), bflo(w.y), bfhi(w.y)}; }
__device__ __forceinline__ int nat_frag(int rtile, int ks, int lane) { return ((rtile * 2 + ks) * 64 + lane) * 8; }
__device__ __forceinline__ int nat_st4(int rtile, int lq, int c0) { return ((rtile * 2 + (c0 >> 5)) * 64 + ((c0 >> 3) & 3) * 16 + lq) * 8 + (c0 & 7); }
constexpr int R4_RHS = 0, R4_AAB = 34816, R4_PL = 51200, R4_SEG = 51456, R4_BF = 53504, R4_ASZ = 9216, R4_LD = 72, XLD = 68;
__device__ __forceinline__ bf16x8 ldsfrag(const bf16_t* arr, int row, int koff) { return *(const bf16x8*)(arr + row * R4_LD + koff); }
__device__ __forceinline__ void r4_phase(const Args& a, int l, unsigned char* lds) {
    unsigned char* ws = pg8::opq_ptr(a.ws); const int tid = pg8::opq_tid(), lane = tid & 63, w = tid >> 6, lq = lane & 15, q = lane >> 4;
    const bf16_t* base = (const bf16_t*)(ws + WS_MIX);
    float* RHS = (float*)(lds + R4_RHS); float* AAB = (float*)(lds + R4_AAB); float* PL = (float*)(lds + R4_PL); float* SEG = (float*)(lds + R4_SEG);
    bf16_t* Arow = (bf16_t*)(lds + R4_BF); bf16_t* Brow = Arow + R4_ASZ / 2; bf16_t* Krow = Brow + R4_ASZ / 2; bf16_t* Rrow = Krow + R4_ASZ / 2;
    bf16_t* BT = Rrow + R4_ASZ / 2; bf16_t* KT = BT + R4_ASZ / 2; bf16_t* VT = KT + R4_ASZ / 2; bf16_t* AAK = VT + R4_ASZ / 2; bf16_t* ARB = AAK + R4_ASZ / 2; bf16_t* ARK = ARB + R4_ASZ / 2;
    bf16_t* AhT = Arow; bf16_t* W1T = Krow;
    const int bid = pg8::opq_bid();
    u32x4 pre[6]; bf16_t* raw = (bf16_t*)lds;
#define R4_PREFETCH(uu) do { const int h_ = (uu) & 15, c_ = (uu) >> 4; _Pragma("unroll") for (int k_ = 0; k_ < 6; ++k_) { const int idx_ = tid + 512 * k_; const int arr_ = idx_ >> 9, t_ = (idx_ >> 3) & 63, j8_ = (idx_ & 7) * 8; \
        pre[k_] = *(const u32x4*)(base + (size_t)(arr_ == 5 ? 5 + l : arr_) * T * D + (size_t)(c_ * 64 + t_) * D + h_ * 64 + j8_); } } while (0)
    for (int u = bid; u < 4096; u += gridDim.x) {
        const int h = u & 15, c = u >> 4;
        R4_PREFETCH(u);
        __syncthreads();
#pragma unroll
        for (int k_ = 0; k_ < 6; ++k_) { const int idx_ = tid + 512 * k_; *(u32x4*)(raw + (size_t)idx_ * 8) = pre[k_]; }
        __syncthreads();
#ifndef NO_S1
        { const int j = lane, seg = w; const size_t g0 = (size_t)(c * 64 + seg * 8) * D + h * 64 + j;
          float r[8], ld[8], k[8], v[8], aa[8], bb[8];
#pragma unroll
          for (int i = 0; i < 8; ++i) { const int o = (seg * 8 + i) * 64 + j; r[i] = bf2f(raw[o]); ld[i] = bf2f(raw[4096 + o]); k[i] = bf2f(raw[2 * 4096 + o]);
              aa[i] = bf2f(raw[3 * 4096 + o]); bb[i] = bf2f(raw[4 * 4096 + o]); v[i] = bf2f(raw[5 * 4096 + o]); }
          (void)g0;
          float cum[8]; float run = 0.f;
#pragma unroll
          for (int i = 0; i < 8; ++i) { run += ld[i]; cum[i] = run; }
          SEG[seg * 64 + j] = run;
          __syncthreads();
          float off = 0.f;
#pragma unroll
          for (int s = 0; s < 8; ++s) off += (s < seg) ? SEG[s * 64 + j] : 0.f;
          float at[8], rt[8], bt[8], kt[8];
#pragma unroll
          for (int i = 0; i < 8; ++i) { const float cm = cum[i] + off; const float ep = __expf(cm), em = __expf(-cm), epp = __expf(cm - ld[i]);
              at[i] = aa[i] * epp; rt[i] = r[i] * ep; bt[i] = bb[i] * em; kt[i] = k[i] * em;
              const int t = seg * 8 + i;
              Arow[t * R4_LD + j] = (bf16_t)(cvt_pk_bf16(at[i], 0.f) & 0xffffu); Brow[t * R4_LD + j] = (bf16_t)(cvt_pk_bf16(bt[i], 0.f) & 0xffffu);
              Krow[t * R4_LD + j] = (bf16_t)(cvt_pk_bf16(kt[i], 0.f) & 0xffffu); Rrow[t * R4_LD + j] = (bf16_t)(cvt_pk_bf16(rt[i], 0.f) & 0xffffu);
              if (i == 7 && seg == 7) PL[j] = ep; }
          *(f32x4*)(RHS + j * XLD + seg * 8) = (f32x4){at[0], at[1], at[2], at[3]}; *(f32x4*)(RHS + j * XLD + seg * 8 + 4) = (f32x4){at[4], at[5], at[6], at[7]};
          *(bf16x8*)(BT + j * R4_LD + seg * 8) = pack8(bt); *(bf16x8*)(KT + j * R4_LD + seg * 8) = pack8(kt); *(bf16x8*)(VT + j * R4_LD + seg * 8) = pack8(v); }
#endif
        __syncthreads();
        { const int tt = w >> 1; const int t = 16 * tt + lq;
          bf16x8 fa[2], fr[2];
#pragma unroll
          for (int ks = 0; ks < 2; ++ks) { fa[ks] = ldsfrag(Arow, t, ks * 32 + 8 * q); fr[ks] = ldsfrag(Rrow, t, ks * 32 + 8 * q); }
#pragma unroll
          for (int k2 = 0; k2 < 2; ++k2) { const int st = 2 * (w & 1) + k2; const int s0 = 16 * st + 4 * q;
              f32x4 dab = {0.f, 0.f, 0.f, 0.f}, dak = dab, drb = dab, drk = dab;
              if (st <= tt) {
#pragma unroll
                  for (int ks = 0; ks < 2; ++ks) { const bf16x8 fb = ldsfrag(Brow, 16 * st + lq, ks * 32 + 8 * q), fk = ldsfrag(Krow, 16 * st + lq, ks * 32 + 8 * q);
                      dab = MFMA16(fb, fa[ks], dab); dak = MFMA16(fk, fa[ks], dak); drb = MFMA16(fb, fr[ks], drb); drk = MFMA16(fk, fr[ks], drk); } }
#pragma unroll
              for (int e = 0; e < 4; ++e) { const int s = s0 + e; if (!(s < t)) { dab[e] = 0.f; dak[e] = 0.f; } if (!(s <= t)) { drb[e] = 0.f; drk[e] = 0.f; } }
              *(f32x4*)(AAB + t * 64 + s0) = dab;
              st4(AAK + t * R4_LD + s0, dak[0], dak[1], dak[2], dak[3]); st4(ARB + t * R4_LD + s0, drb[0], drb[1], drb[2], drb[3]); st4(ARK + t * R4_LD + s0, drk[0], drk[1], drk[2], drk[3]); } }
        __syncthreads();
        { bf16_t* AOFF = Brow; const int t = tid >> 3, s8 = (tid & 7) * 8; const f32x4 a0 = *(const f32x4*)(AAB + t * 64 + s8), a1 = *(const f32x4*)(AAB + t * 64 + s8 + 4);
          const bool keep = (s8 >> 4) < (t >> 4); const float o[8] = {keep ? a0[0] : 0.f, keep ? a0[1] : 0.f, keep ? a0[2] : 0.f, keep ? a0[3] : 0.f, keep ? a1[0] : 0.f, keep ? a1[1] : 0.f, keep ? a1[2] : 0.f, keep ? a1[3] : 0.f};
          *(bf16x8*)(AOFF + t * R4_LD + s8) = pack8(o); }
        { const int tt = w >> 1; const int t = 16 * tt + lq;
          bf16x8 fb[2];
#pragma unroll
          for (int ks = 0; ks < 2; ++ks) fb[ks] = ldsfrag(AAK, t, ks * 32 + 8 * q);
#pragma unroll
          for (int k2 = 0; k2 < 2; ++k2) { const int it = 2 * (w & 1) + k2; f32x4 d = {0.f, 0.f, 0.f, 0.f};
#pragma unroll
              for (int ks = 0; ks < 2; ++ks) d = MFMA16(ldsfrag(VT, 16 * it + lq, ks * 32 + 8 * q), fb[ks], d);
#pragma unroll
              for (int e = 0; e < 4; ++e) RHS[(64 + 16 * it + 4 * q + e) * XLD + t] = d[e]; } }
        __syncthreads();
        { bf16_t* AOFF = Brow;
#pragma unroll
          for (int b = 0; b < 4; ++b) {
              if (b > 0) { const bf16_t* xt = (w < 4 ? AhT : W1T); const int crow = 16 * (w & 3) + lq; f32x4 d = {0.f, 0.f, 0.f, 0.f};
#pragma unroll
                  for (int ks = 0; ks < (b + 1) / 2; ++ks) d = MFMA16(ldsfrag(xt, crow, ks * 32 + 8 * q), ldsfrag(AOFF, 16 * b + lq, ks * 32 + 8 * q), d);
                  const int t = 16 * b + lq; const int c0 = 16 * w + 4 * q;
#pragma unroll
                  for (int e = 0; e < 4; ++e) RHS[(c0 + e) * XLD + t] += d[e];
                  __syncthreads(); }
              if (tid < 128) { float* xr = RHS + tid * XLD + 16 * b; float x[16];
#pragma unroll
                  for (int k = 0; k < 4; ++k) { const f32x4 v = *(const f32x4*)(xr + 4 * k); x[4 * k] = v[0]; x[4 * k + 1] = v[1]; x[4 * k + 2] = v[2]; x[4 * k + 3] = v[3]; }
#pragma unroll
                  for (int t = 1; t < 16; ++t) { const float* ar = AAB + (16 * b + t) * 64 + 16 * b; float acc = x[t];
#pragma unroll
                      for (int k = 0; k < (t + 3) / 4; ++k) { const f32x4 av = *(const f32x4*)(ar + 4 * k);
#pragma unroll
                          for (int e = 0; e < 4; ++e) if (4 * k + e < t) acc += av[e] * x[4 * k + e]; }
                      x[t] = acc; }
#pragma unroll
                  for (int k = 0; k < 4; ++k) *(f32x4*)(xr + 4 * k) = (f32x4){x[4 * k], x[4 * k + 1], x[4 * k + 2], x[4 * k + 3]};
                  bf16_t* dst = (tid < 64 ? AhT : W1T) + (tid & 63) * R4_LD + 16 * b;
                  { const float o0[8] = {x[0], x[1], x[2], x[3], x[4], x[5], x[6], x[7]}; const float o1[8] = {x[8], x[9], x[10], x[11], x[12], x[13], x[14], x[15]};
                    *(bf16x8*)dst = pack8(o0); *(bf16x8*)(dst + 8) = pack8(o1); } }
              if (b < 3) __syncthreads();
          } }
        __syncthreads();
#ifndef NO_S5
        { const int rt_ = w >> 1; const int row = 16 * rt_ + lq;
          unsigned char* bigb = ws + WS_BIG;
          bf16_t* gRH = (bf16_t*)(bigb + BIG_RH) + (size_t)u * 4096; float* gY0 = (float*)((bf16_t*)(bigb + BIG_Y0) + (size_t)u * 4096);
          bf16_t* gMM = (bf16_t*)(bigb + BIG_MM) + (size_t)(h * 256 + c) * 4096; float* gNT = (float*)((bf16_t*)(bigb + BIG_NT) + (size_t)(h * 256 + c) * 4096);
          bf16x8 f_arb[2], f_ark[2], f_bt[2], f_w1[2], f_vt[2];
#pragma unroll
          for (int ks = 0; ks < 2; ++ks) { const int ko = ks * 32 + 8 * q; f_arb[ks] = ldsfrag(ARB, row, ko); f_ark[ks] = ldsfrag(ARK, row, ko); f_bt[ks] = ldsfrag(BT, row, ko); f_w1[ks] = ldsfrag(W1T, row, ko); f_vt[ks] = ldsfrag(VT, row, ko); }
          const float plrow = PL[row];
#pragma unroll
          for (int k2 = 0; k2 < 2; ++k2) { const int ct = 2 * (w & 1) + k2; const int c0 = 16 * ct + 4 * q;
              f32x4 drh = {0.f, 0.f, 0.f, 0.f}, dy0 = drh, dmm = drh, dnt = drh;
#pragma unroll
              for (int ks = 0; ks < 2; ++ks) { const int ko = ks * 32 + 8 * q;
                  const bf16x8 c_ah = ldsfrag(AhT, 16 * ct + lq, ko), c_w1 = ldsfrag(W1T, 16 * ct + lq, ko), c_vt = ldsfrag(VT, 16 * ct + lq, ko), c_bt = ldsfrag(BT, 16 * ct + lq, ko), c_kt = ldsfrag(KT, 16 * ct + lq, ko);
                  drh = MFMA16(c_ah, f_arb[ks], drh);
                  dy0 = MFMA16(c_w1, f_arb[ks], dy0); dy0 = MFMA16(c_vt, f_ark[ks], dy0);
                  dmm = MFMA16(c_ah, f_bt[ks], dmm);
                  dnt = MFMA16(c_bt, f_w1[ks], dnt); dnt = MFMA16(c_kt, f_vt[ks], dnt); }
              float rr[4]; ld4(Rrow + row * R4_LD + c0, rr);
              st4(gRH + nat_st4(rt_, lq, c0), drh[0] + rr[0], drh[1] + rr[1], drh[2] + rr[2], drh[3] + rr[3]);
              st4((bf16_t*)gY0 + ((rt_ * 4 + ct) * 64 + lane) * 4, dy0[0], dy0[1], dy0[2], dy0[3]);
#pragma unroll
              for (int e = 0; e < 4; ++e) { dmm[e] = plrow * (dmm[e] + ((c0 + e) == row ? 1.f : 0.f)); dnt[e] *= PL[c0 + e]; }
              st4(gMM + nat_st4(rt_, lq, c0), dmm[0], dmm[1], dmm[2], dmm[3]);
              st4((bf16_t*)gNT + ((rt_ * 4 + ct) * 64 + lane) * 4, dnt[0], dnt[1], dnt[2], dnt[3]); } }
#endif
    }
}
__device__ __forceinline__ void r5_phase(const Args& a, unsigned char* lds) {
    const int bid = pg8::opq_bid(); if (bid >= 64) return;
    unsigned char* ws = pg8::opq_ptr(a.ws); const int tid = pg8::opq_tid(), lane = tid & 63, w = tid >> 6, lq = lane & 15, q = lane >> 4; const int h = bid & 15, iq = bid >> 4;
    const bf16_t* gMM = (const bf16_t*)(ws + WS_BIG + BIG_MM); const float* gNT = (const float*)(ws + WS_BIG + BIG_NT);
    bf16_t* SC = (bf16_t*)(ws + WS_MIX + (size_t)1 * SZ_TD2);
    bf16_t* Sb = (bf16_t*)lds;
    for (int i = tid; i < 2 * 16 * R4_LD / 2; i += 512) ((unsigned*)Sb)[i] = 0u;
    for (int i = tid; i < 512; i += 512) ((unsigned*)(SC + (size_t)h * 4096 + iq * 1024))[i] = 0u;
    __syncthreads();
    if (w >= 4) {
        for (int c = 0; c < 256; ++c) { asm volatile("s_waitcnt lgkmcnt(0)" ::: "memory"); __builtin_amdgcn_s_barrier(); asm volatile("" ::: "memory"); }
        return; }
    const int jt = w; const int irow = 16 * iq + lq;
    bf16x8 Mr[8][2]; f32x4 Nr[8];
#pragma unroll
    for (int k = 0; k < 8; ++k) { const size_t ub = (size_t)(h * 256 + k) * 4096;
#pragma unroll
        for (int ks = 0; ks < 2; ++ks) Mr[k][ks] = *(const bf16x8*)(gMM + ub + nat_frag(jt, ks, lane));
        Nr[k] = ldbf4((const bf16_t*)gNT + ub + ((iq * 4 + jt) * 64 + lane) * 4); }
    for (int c0 = 0; c0 < 256; c0 += 8) {
#pragma unroll
        for (int k = 0; k < 8; ++k) { const int c = c0 + k;
            const bf16_t* Sc_ = Sb + (k & 1) * 16 * R4_LD; bf16_t* Sn_ = Sb + ((k & 1) ^ 1) * 16 * R4_LD;
            bf16_t* scn = SC + (size_t)((c + 1) * 16 + h) * 4096;
            f32x4 d = Nr[k];
#pragma unroll
            for (int ks = 0; ks < 2; ++ks) d = MFMA16(Mr[k][ks], ldsfrag(Sc_, lq, ks * 32 + 8 * q), d);
            st4(Sn_ + lq * R4_LD + 16 * jt + 4 * q, d[0], d[1], d[2], d[3]);
            if (c < 255) st4(scn + nat_st4(iq, lq, 16 * jt + 4 * q), d[0], d[1], d[2], d[3]);
            { const int cn = (c + 8 < 256) ? c + 8 : 255; const size_t ub = (size_t)(h * 256 + cn) * 4096;
#pragma unroll
              for (int ks = 0; ks < 2; ++ks) Mr[k][ks] = *(const bf16x8*)(gMM + ub + nat_frag(jt, ks, lane));
              Nr[k] = ldbf4((const bf16_t*)gNT + ub + ((iq * 4 + jt) * 64 + lane) * 4); }
            asm volatile("s_waitcnt lgkmcnt(0)" ::: "memory"); __builtin_amdgcn_s_barrier(); asm volatile("" ::: "memory");
        }
    }
}
__device__ __forceinline__ void r6_phase(const Args& a, int l) {
    unsigned char* ws = pg8::opq_ptr(a.ws); const int tid = pg8::opq_tid(), lane = tid & 63, lq = lane & 15, q = lane >> 4; const int gw = pg8::opq_bid() * 8 + (tid >> 6), NGW = gridDim.x * 8;
    const bf16_t* gRH = (const bf16_t*)(ws + WS_BIG + BIG_RH); const float* gY0 = (const float*)(ws + WS_BIG + BIG_Y0); const bf16_t* SC = (const bf16_t*)(ws + WS_MIX + (size_t)1 * SZ_TD2);
    const bf16_t* base = (const bf16_t*)(ws + WS_MIX); const bf16_t* pR = base; const bf16_t* pK = base + (size_t)2 * T * D; const bf16_t* pV = base + (size_t)(5 + l) * T * D; const bf16_t* pG = base + (size_t)7 * T * D;
    bf16_t* YG = (bf16_t*)(ws + WS_MIX + (size_t)3 * SZ_TD2);
    const float* lnw = a.in[21] + l * D; const float* lnb = a.in[22] + l * D; const float* rk = a.in[20] + l * D;
    for (int item = gw; item < 16384; item += NGW) { const int tt = item & 3, u = item >> 2; const int h = u & 15, c = u >> 4; const int t = c * 64 + tt * 16 + lq;
        const size_t ub = (size_t)u * 4096;
        bf16x8 fr[2];
#pragma unroll
        for (int ks = 0; ks < 2; ++ks) fr[ks] = *(const bf16x8*)(gRH + ub + nat_frag(tt, ks, lane));
        f32x4 y[4]; bf16x8 fs[4][2]; u32x2 Lr[4], Lk[4], Lv[4], Lg[4];
#pragma unroll
        for (int it = 0; it < 4; ++it) { y[it] = ldbf4((const bf16_t*)gY0 + ub + ((tt * 4 + it) * 64 + lane) * 4);
#pragma unroll
            for (int ks = 0; ks < 2; ++ks) fs[it][ks] = *(const bf16x8*)(SC + ub + nat_frag(it, ks, lane));
            const size_t off = (size_t)t * D + h * 64 + 16 * it + 4 * q; Lr[it] = *(const u32x2*)(pR + off); Lk[it] = *(const u32x2*)(pK + off); Lv[it] = *(const u32x2*)(pV + off); Lg[it] = *(const u32x2*)(pG + off); }
#pragma unroll
        for (int it = 0; it < 4; ++it)
#pragma unroll
            for (int ks = 0; ks < 2; ++ks) y[it] = MFMA16(fs[it][ks], fr[ks], y[it]);
        float sm = 0.f, bs = 0.f; float vv[4][4], gg[4][4];
#pragma unroll
        for (int it = 0; it < 4; ++it) { const int c0 = h * 64 + 16 * it + 4 * q; float r4[4], k4[4];
            up4(Lr[it], r4); up4(Lk[it], k4); up4(Lv[it], vv[it]); up4(Lg[it], gg[it]); const f32x4 rkv = *(const f32x4*)(rk + c0);
#pragma unroll
            for (int e = 0; e < 4; ++e) { sm += y[it][e]; bs += r4[e] * k4[e] * rkv[e]; } }
        sm += __shfl_xor(sm, 16); sm += __shfl_xor(sm, 32); bs += __shfl_xor(bs, 16); bs += __shfl_xor(bs, 32);
        const float mean = sm * (1.f / 64.f); float vr = 0.f;
#pragma unroll
        for (int it = 0; it < 4; ++it)
#pragma unroll
            for (int e = 0; e < 4; ++e) { const float dd = y[it][e] - mean; vr += dd * dd; }
        vr += __shfl_xor(vr, 16); vr += __shfl_xor(vr, 32);
        const float rstd = rsqrtf(vr * (1.f / 64.f) + 64e-5f);
#pragma unroll
        for (int it = 0; it < 4; ++it) { const int c0 = h * 64 + 16 * it + 4 * q; const f32x4 lw = *(const f32x4*)(lnw + c0), lb = *(const f32x4*)(lnb + c0); float o[4];
#pragma unroll
            for (int e = 0; e < 4; ++e) o[e] = ((y[it][e] - mean) * rstd * lw[e] + lb[e] + bs * vv[it][e]) * gg[it][e];
            st4(YG + (size_t)t * D + c0, o[0], o[1], o[2], o[3]); }
    }
}
constexpr int VT_LD = 136;
__device__ __forceinline__ int vt_addr(int dim, int kp) { return dim * VT_LD + (dim >> 4) * 8 + kp; }
constexpr int KL_LD = 72;
struct AttRegs { u32x4 k[4], v0a, v0b, v1a, v1b; bf16x8 q[2]; };
__device__ __forceinline__ void att_decode(int u, int& g, int& h, int& d, int& rsd, int& n) { g = u >> 11; const int rem = u & 2047; h = rem >> 7; const int rr = rem & 127; const int sh = 2 * g; d = 1 << sh; rsd = rr & (d - 1); n = rr >> sh; }
__device__ __forceinline__ void att_load(const bf16_t* Q, const bf16_t* KV, int u, int tid, AttRegs& R) {
    int g, h, d, rsd, n; att_decode(u, g, h, d, rsd, n); const int hc = g * 1024 + h * 64; const int lane = tid & 63, w = tid >> 6, lq = lane & 15, qp = lane >> 4;
    const int sh = 2 * g; const size_t plane = ((size_t)(g * 16 + h) * T + (size_t)rsd * (T >> sh)) * 64; (void)hc;
    { const int key = tid >> 1, half = tid & 1; int mk = 128 * (n - 1) + key; mk = mk < 0 ? 0 : mk; const bf16_t* p = KV + plane + (size_t)mk * 64 + half * 32;
#pragma unroll
      for (int i = 0; i < 4; ++i) R.k[i] = *(const u32x4*)(p + 8 * i); }
    { const int kp = tid >> 2, dg = tid & 3; const u32x4 z = {0u, 0u, 0u, 0u}; R.v0a = z; R.v0b = z; R.v1a = z; R.v1b = z; const int m0 = 128 * (n - 1) + 2 * kp;
      if (m0 >= 0) { const bf16_t* p0 = KV + (size_t)48 * T * 64 + plane + (size_t)m0 * 64 + dg * 16; const bf16_t* p1 = p0 + 64;
          R.v0a = *(const u32x4*)p0; R.v0b = *(const u32x4*)(p0 + 8); R.v1a = *(const u32x4*)p1; R.v1b = *(const u32x4*)(p1 + 8); } }
    { const int qi = 16 * w + lq; const int tq = (128 * n + qi) * d + rsd;
#pragma unroll
      for (int ks = 0; ks < 2; ++ks) R.q[ks] = *(const bf16x8*)(Q + plane + (size_t)(128 * n + qi) * 64 + ks * 32 + qp * 8); (void)tq; }
}
__device__ __forceinline__ void attn_phase(const Args& a, unsigned* vt) {
    unsigned char* ws = pg8::opq_ptr(a.ws); const int tid = pg8::opq_tid(), lane = tid & 63, w = tid >> 6, lq = lane & 15, qp = lane >> 4;
    const bf16_t* Q = (const bf16_t*)(ws + WS_BIG + BIG_Q); const bf16_t* KV = (const bf16_t*)(ws + WS_MIX);
    bf16_t* OG = (bf16_t*)(ws + WS_BIG + BIG_OG); float* LSE = (float*)(ws + WS_BIG + BIG_LSE);
    bf16_t* kl = (bf16_t*)(vt + 9216);
    const int G = gridDim.x; int u = pg8::opq_bid();
    AttRegs R, R2; if (u < 6144) { att_load(Q, KV, u, tid, R); att_load(Q, KV, (u + G < 6144) ? u + G : u, tid, R2); }
    for (; u < 6144; u += G) {
        int g, h, d, rsd, n; att_decode(u, g, h, d, rsd, n);
        asm volatile("s_waitcnt lgkmcnt(0)" ::: "memory"); __builtin_amdgcn_s_barrier(); asm volatile("" ::: "memory");
        { const int key = tid >> 1, half = tid & 1;
#pragma unroll
          for (int i = 0; i < 4; ++i) *(u32x4*)(kl + key * KL_LD + half * 32 + 8 * i) = R.k[i]; }
        { const int kp = tid >> 2, dg = tid & 3;
          const unsigned e0[8] = {R.v0a.x, R.v0a.y, R.v0a.z, R.v0a.w, R.v0b.x, R.v0b.y, R.v0b.z, R.v0b.w}; const unsigned e1[8] = {R.v1a.x, R.v1a.y, R.v1a.z, R.v1a.w, R.v1b.x, R.v1b.y, R.v1b.z, R.v1b.w};
#pragma unroll
          for (int j = 0; j < 8; ++j) { const int dim = dg * 16 + 2 * j;
              vt[vt_addr(dim, kp)] = (e0[j] & 0xffffu) | (e1[j] << 16);
              vt[vt_addr(dim + 1, kp)] = (e0[j] >> 16) | (e1[j] & 0xffff0000u); } }
        bf16x8 bq[2]; bq[0] = R.q[0]; bq[1] = R.q[1];
        asm volatile("s_waitcnt lgkmcnt(0)" ::: "memory"); __builtin_amdgcn_s_barrier(); asm volatile("" ::: "memory");
        R = R2; { const int un = (u + 2 * G < 6144) ? u + 2 * G : u; att_load(Q, KV, un, tid, R2); }
        const int qi = 16 * w + lq; const int tq = (128 * n + qi) * d + rsd;
        const int kt0 = 2 * (w >> 1);
        f32x4 sc[10];
#pragma unroll
        for (int kl_ = 0; kl_ < 10; ++kl_) { const int krow = 16 * (kt0 + kl_) + lq; f32x4 acc = {0.f, 0.f, 0.f, 0.f};
            acc = MFMA16(*(const bf16x8*)(kl + krow * KL_LD + qp * 8), bq[0], acc); acc = MFMA16(*(const bf16x8*)(kl + krow * KL_LD + 32 + qp * 8), bq[1], acc); sc[kl_] = acc; }
        float mx = -3.0e38f;
#pragma unroll
        for (int kl_ = 0; kl_ < 10; ++kl_)
#pragma unroll
            for (int e = 0; e < 4; ++e) { const int kj = 16 * (kt0 + kl_) + 4 * qp + e; const bool valid = (kj >= qi) && (kj <= qi + 128) && (n > 0 || kj >= 128);
                const float sv = valid ? sc[kl_][e] : -1e30f; sc[kl_][e] = sv; mx = fmaxf(mx, sv); }
        mx = fmaxf(mx, __shfl_xor(mx, 16)); mx = fmaxf(mx, __shfl_xor(mx, 32));
        float lsum = 0.f;
#pragma unroll
        for (int kl_ = 0; kl_ < 10; ++kl_)
#pragma unroll
            for (int e = 0; e < 4; ++e) { const float p = __expf(sc[kl_][e] - mx); sc[kl_][e] = p; lsum += p; }
        lsum += __shfl_xor(lsum, 16); lsum += __shfl_xor(lsum, 32);
        f32x4 oacc[4];
#pragma unroll
        for (int dt = 0; dt < 4; ++dt) oacc[dt] = (f32x4){0.f, 0.f, 0.f, 0.f};
#pragma unroll
        for (int sl = 0; sl < 5; ++sl) { u32x4 pw; pw.x = cvt_pk_bf16(sc[2 * sl][0], sc[2 * sl][1]); pw.y = cvt_pk_bf16(sc[2 * sl][2], sc[2 * sl][3]);
            pw.z = cvt_pk_bf16(sc[2 * sl + 1][0], sc[2 * sl + 1][1]); pw.w = cvt_pk_bf16(sc[2 * sl + 1][2], sc[2 * sl + 1][3]);
            const bf16x8 bp = __builtin_bit_cast(bf16x8, pw); const int kpb = 16 * ((kt0 >> 1) + sl) + 2 * qp;
#pragma unroll
            for (int dt = 0; dt < 4; ++dt) { const int dim = dt * 16 + lq; const u32x2 lo = *(const u32x2*)(vt + vt_addr(dim, kpb)); const u32x2 hi = *(const u32x2*)(vt + vt_addr(dim, kpb + 8));
                u32x4 aw; aw.x = lo.x; aw.y = lo.y; aw.z = hi.x; aw.w = hi.y;
                oacc[dt] = MFMA16(__builtin_bit_cast(bf16x8, aw), bp, oacc[dt]); } }
        const float il = 1.f / lsum;
        bf16_t* op = OG + (size_t)g * T * D + (size_t)tq * D + h * 64 + 4 * qp;
#pragma unroll
        for (int dt = 0; dt < 4; ++dt) st4(op + dt * 16, oacc[dt][0] * il, oacc[dt][1] * il, oacc[dt][2] * il, oacc[dt][3] * il);
        if (qp == 0) LSE[(size_t)g * T * 16 + (size_t)tq * 16 + h] = mx + __logf(lsum);
    }
}
__device__ __forceinline__ void comb_phase(const Args& a) {
    unsigned char* ws = pg8::opq_ptr(a.ws); const int lane = pg8::opq_tid() & 63; const int gw = pg8::opq_bid() * 8 + (pg8::opq_tid() >> 6), NGW = gridDim.x * 8;
    const bf16_t* OG = (const bf16_t*)(ws + WS_BIG + BIG_OG); const float* LSE = (const float*)(ws + WS_BIG + BIG_LSE); bf16_t* O = (bf16_t*)(ws + WS_MIX + (size_t)T * KVW * 2);
    const int c0 = lane * 16, h = lane >> 2;
    for (int t = gw; t < T; t += NGW) {
        const float l0 = LSE[(size_t)t * 16 + h], l1 = LSE[(size_t)T * 16 + (size_t)t * 16 + h], l2 = LSE[(size_t)2 * T * 16 + (size_t)t * 16 + h];
        const float mx = fmaxf(l0, fmaxf(l1, l2)); float e0 = __expf(l0 - mx), e1 = __expf(l1 - mx), e2 = __expf(l2 - mx); const float is = 1.f / (e0 + e1 + e2); e0 *= is; e1 *= is; e2 *= is;
        float o[16];
#pragma unroll
        for (int hf = 0; hf < 2; ++hf) { float x0[8], x1[8], x2[8]; const size_t off = (size_t)t * D + c0 + hf * 8;
            ld8(OG + off, x0); ld8(OG + (size_t)T * D + off, x1); ld8(OG + (size_t)2 * T * D + off, x2);
#pragma unroll
            for (int j = 0; j < 8; ++j) o[hf * 8 + j] = e0 * x0[j] + e1 * x1[j] + e2 * x2[j]; }
        u32x4 w0, w1; w0.x = cvt_pk_bf16(o[0], o[1]); w0.y = cvt_pk_bf16(o[2], o[3]); w0.z = cvt_pk_bf16(o[4], o[5]); w0.w = cvt_pk_bf16(o[6], o[7]);
        w1.x = cvt_pk_bf16(o[8], o[9]); w1.y = cvt_pk_bf16(o[10], o[11]); w1.z = cvt_pk_bf16(o[12], o[13]); w1.w = cvt_pk_bf16(o[14], o[15]);
        *(u32x4*)(O + (size_t)t * D + c0) = w0; *(u32x4*)(O + (size_t)t * D + c0 + 8) = w1; }
}
__global__ void __launch_bounds__(512, 2) mega(Args a) {
    extern __shared__ __attribute__((aligned(16))) unsigned char lds[];
    { volatile LAS unsigned* stw = (volatile LAS unsigned*)((LAS unsigned char*)lds + (LDS_BYTES - 64)); if (threadIdx.x < 2) stw[threadIdx.x] = 0u; }
    __syncthreads();
    { cg::grid_group grid = cg::this_grid(); if (a.ph_hi < 0) grid.sync(); }
    XcdBarrier bar = xcd_barrier_post((unsigned*)(a.ws + WS_BAR), (volatile LAS unsigned*)((LAS unsigned char*)lds + (LDS_BYTES - 64)));
    for (int s = a.ph_lo; s < a.ph_hi; ++s) {
        if (s > a.ph_lo) xcd_barrier(bar);
        unsigned char* ws = pg8::opq_ptr(a.ws); PG8_LAS unsigned char* glds = (PG8_LAS unsigned char*)lds; float* ssb = (float*)(ws + WS_SS); bf16_t* XB = (bf16_t*)(ws + WS_XB); const int bid = pg8::opq_bid();
        int type, l = 0, j = 0;
        if (s == 0) type = 0; else if (s == 21) type = 8;
        else { int o; if (s <= 10) { l = 0; o = s - 1; } else if (s <= 20) { l = 1; o = s - 11; } else if (s <= 29) { l = 2; o = s - 22; } else { l = 3; o = s - 30; }
            if (l < 2) { if (o < 2) type = 1 + o; else if (o < 6) type = o + 1; else if (o == 6) type = 13; else if (o == 7) type = 7; else { type = o - 7; j = 1; } }
            else { if (o < 2) type = 1 + o; else if (o < 6) type = o + 7; else { type = o - 5; j = 1; } } }
#ifndef DUP_MASK
#define DUP_MASK 0
#endif
        for (int rep = 0; rep < (((DUP_MASK >> type) & 1) ? 2 : 1); ++rep) {
#define FILL_RTAB(S_, ssp_) do { PG8_LAS float* rt_ = (PG8_LAS float*)(glds + 131072); for (int i_ = 0; i_ < 8; ++i_) { pg8::Unit u_; if (!(S_).next(i_, u_)) break; \
            if (threadIdx.x < 256) rt_[i_ * 256 + threadIdx.x] = row_rs((ssp_), u_.pm * 256 + (int)threadIdx.x); } __syncthreads(); } while (0)
        if (type == 0) { p0_phase(a, (float*)lds); }
        else if (type == 1) { pg8::Gemm g{XB, (const bf16_t*)(ws + WS_WIN + (size_t)(l * 2 + j) * SZ_WIN), T, 2 * FF, D}; pg8::StaticOrder S; S.init(T, 2 * FF, gridDim.x, bid);
            EpiSwiglu E{(bf16_t*)(ws + WS_BIG), ssb + (size_t)(3 * l + (j ? 2 : 0)) * T * 16, (const PG8_LAS float*)(glds + 131072)}; FILL_RTAB(S, E.ss);
            pg8::gemm_phase<EpiSwiglu, pg8::StaticOrder, true, true>(glds, g, S, E); }
        else if (type == 2 || type == 7 || type == 12) {
            pg8::Gemm g; EpiResid E; E.xnew = a.out; E.xb = XB; E.xold = a.out;
            if (type == 2) { g = pg8::Gemm{(const bf16_t*)(ws + WS_BIG), (const bf16_t*)(ws + WS_WOUT + (size_t)(l * 2 + j) * SZ_WOUT), T, D, FF}; E.alpha = 0.5f; E.ssn = ssb + (size_t)(3 * l + (j ? 3 : 1)) * T * 16; if (l == 0 && j == 0) E.xold = a.in[0]; }
            else if (type == 7) { g = pg8::Gemm{(const bf16_t*)(ws + WS_MIX + (size_t)3 * SZ_TD2), (const bf16_t*)(ws + WS_WOR + (size_t)l * SZ_SQ), T, D, D}; E.alpha = 1.f; E.ssn = ssb + (size_t)(3 * l + 2) * T * 16; }
            else { g = pg8::Gemm{(const bf16_t*)(ws + WS_MIX + (size_t)T * KVW * 2), (const bf16_t*)(ws + WS_WOA + (size_t)(l - 2) * SZ_SQ), T, D, D}; E.alpha = 1.f; E.ssn = ssb + (size_t)(3 * l + 2) * T * 16; }
            pg8::StaticOrder S; S.init(T, D, gridDim.x, bid);
            pg8::gemm_phase<EpiResid, pg8::StaticOrder, true, true>(glds, g, S, E); }
        else if (type == 3) { pg8::Gemm g{XB, (const bf16_t*)(ws + WS_WCAT + (size_t)l * SZ_WCAT), T, NCAT, D}; pg8::StaticOrder S; S.init(T, NCAT, gridDim.x, bid);
            EpiPlain E{(bf16_t*)(ws + WS_BIG), NCAT};
            pg8::gemm_phase<EpiPlain, pg8::StaticOrder, true, true>(glds, g, S, E); }
        else if (type == 4) f1_phase(a, l, lds);
        else if (type == 5) r4_phase(a, l, lds);
        else if (type == 6) { if (bid >= 64 && gridDim.x > 64) p0_convert(a, (float*)lds, l + 1, bid - 64, gridDim.x - 64); else r5_phase(a, lds); }
        else if (type == 13) r6_phase(a, l);
        else if (type == 8 || type == 9) {
            pg8::Gemm g; EpiHeadNorm E; E.nnorm = 48;
            if (type == 8) { g = pg8::Gemm{XB, (const bf16_t*)(ws + WS_WKV), T, KVW, D}; E.O = (bf16_t*)(ws + WS_MIX); E.ldc = KVW; E.ss = ssb + (size_t)6 * T * 16; E.gain = a.in[26]; E.scale = 1.f; }
            else { g = pg8::Gemm{XB, (const bf16_t*)(ws + WS_WQ + (size_t)(l - 2) * SZ_WQ), T, QW, D}; E.O = (bf16_t*)(ws + WS_BIG + BIG_Q); E.ldc = QW; E.ss = ssb + (size_t)(3 * l + 1) * T * 16; E.gain = a.in[28] + (l - 2) * 192; E.scale = 0.125f; }
            pg8::StaticOrder S; S.init(T, g.N, gridDim.x, bid); E.rtab = (const PG8_LAS float*)(glds + 131072); FILL_RTAB(S, E.ss);
            pg8::gemm_phase<EpiHeadNorm, pg8::StaticOrder, true, true>(glds, g, S, E); }
        else if (type == 10) attn_phase(a, (unsigned*)lds);
        else if (type == 11) comb_phase(a);
        }
    }
}

extern "C" void kernel_launch(void* const* d_in, const int* in_sizes, int n_in, void* d_out, int out_size, void* d_ws, size_t ws_size, hipStream_t stream) {
    static int grid = 0;
    if (grid == 0) {
        if (n_in != 30 || out_size != T * D || ws_size < WS_END) { fprintf(stderr, "kernel_launch: unexpected shapes: n_in %d out %d ws %zu (need %zu)\n", n_in, out_size, ws_size, (size_t)WS_END); grid = -1; return; }
        int dev = 0, cus = 0, per_cu = 0;
        (void)hipGetDevice(&dev); (void)hipDeviceGetAttribute(&cus, hipDeviceAttributeMultiprocessorCount, dev);
        if (hipFuncSetAttribute((const void*)mega, hipFuncAttributeMaxDynamicSharedMemorySize, LDS_BYTES) != hipSuccess) { fprintf(stderr, "kernel_launch: hipFuncSetAttribute failed\n"); grid = -1; return; }
        if (hipOccupancyMaxActiveBlocksPerMultiprocessor(&per_cu, (const void*)mega, 512, LDS_BYTES) != hipSuccess || per_cu < 1) { fprintf(stderr, "kernel_launch: occupancy query says %d\n", per_cu); per_cu = 1; }
        (void)hipGetLastError();
        grid = cus * 1;
        if (grid <= 0) grid = 256;
    }
    if (grid < 0) return;
    if (hipMemsetAsync((char*)d_ws + WS_BAR, 0, XCD_BAR_WORDS * 4, stream) != hipSuccess) { fprintf(stderr, "kernel_launch: memset failed\n"); return; }
    Args a{};
    for (int i = 0; i < 30; ++i) a.in[i] = (const float*)d_in[i];
    a.out = (float*)d_out; a.ws = (unsigned char*)d_ws;
#if ONE_LAUNCH
    a.ph_lo = 0; a.ph_hi = NSTEPS;
    void* args[] = {&a};
    hipError_t e = hipLaunchCooperativeKernel((const void*)mega, dim3(grid), dim3(512), args, LDS_BYTES, stream);
    if (e != hipSuccess) fprintf(stderr, "cooperative launch failed: %s (grid %d)\n", hipGetErrorString(e), grid);
#else
    for (int s = 0; s < NSTEPS; ++s) { a.ph_lo = s; a.ph_hi = s + 1; hipLaunchKernelGGL(mega, dim3(grid), dim3(512), LDS_BYTES, stream, a); }
#endif
}
```

```cpp
#include <hip/hip_runtime.h>
#include <hip/hip_cooperative_groups.h>
#include <cstdio>
#include <cstdint>
namespace cg = cooperative_groups;
namespace pg8 {
#define PG8_LAS __attribute__((address_space(3)))
typedef unsigned short bf16_t;
typedef short bf16x8 __attribute__((ext_vector_type(8)));
typedef float f32x4 __attribute__((ext_vector_type(4)));
typedef unsigned u32x4 __attribute__((ext_vector_type(4)));
__device__ __forceinline__ int opq_tid() { int t = threadIdx.x; asm volatile("" : "+v"(t)); return t; }
__device__ __forceinline__ int opq_bid() { int t = blockIdx.x; asm volatile("" : "+s"(t)); return t; }
__device__ __forceinline__ unsigned char* opq_ptr(unsigned char* q) { size_t off = 0; asm volatile("" : "+s"(off)); return q + off; }
constexpr int BM = 256, BK = 64, HALF = 128, HTB = HALF * BK * 2  , STAGE_BYTES = 8 * HTB, NXCD = 8, WGM = 8;

__host__ __device__ __forceinline__ int lds_byte(int r, int c) { const int st = (r >> 4) * 2 + (c >> 5), rr = r & 15, cc = c & 31, ob = rr * 64 + cc * 2; return st * 1024 + (ob ^ (((ob >> 9) & 1) << 5)); }
__host__ __device__ __forceinline__ void stage_rc(int b, int& R, int& C) { const int st = b / 1024, sb = b % 1024, swz = sb ^ (((sb >> 9) & 1) << 5); R = (st >> 1) * 16 + swz / 64; C = (st & 1) * 32 + (swz % 64) / 2; }
__host__ __device__ __forceinline__ int perm32(int rho) { const int n = rho >> 4, i = rho & 15; return 8 * (i >> 2) + 4 * n + (i & 3); }

struct Unit { int pm, pn, ord; };
struct Gemm { const bf16_t* A; const bf16_t* Bt; int M, N, K; };

struct StaticOrder {
    int nM, nN, nwg, G, c;
    __host__ __device__ void init(int M, int N, int G_, int c_) { nM = M / BM; nN = N / BM; nwg = nM * nN; G = G_; c = c_; }
    __host__ __device__ __forceinline__ bool next(int i, Unit& u) const {
        const long L = (long)i * G + c; if (L >= nwg) return false;
        int wgid = (int)L; { const int q = nwg / NXCD, r = nwg % NXCD, xcd = wgid % NXCD, off = wgid / NXCD; wgid = (xcd < r ? xcd * (q + 1) : r * (q + 1) + (xcd - r) * q) + off; }
        const int nig = WGM * nN, gid = wgid / nig, fm = gid * WGM, gsz = (nM - fm) < WGM ? (nM - fm) : WGM;
        u.pm = fm + ((wgid % nig) % gsz); u.pn = (wgid % nig) / gsz; u.ord = i; return true;
    }
    __device__ __forceinline__ void a_ready(const Unit&) const {}
    __device__ __forceinline__ void done(const Unit&) const {}
};

typedef __bf16 bf16x2v_ __attribute__((ext_vector_type(2))); typedef float f32x2v_ __attribute__((ext_vector_type(2)));
__device__ __forceinline__ unsigned cvt_pk_bf16(float lo, float hi) { const f32x2v_ v = {lo, hi}; const bf16x2v_ b = __builtin_convertvector(v, bf16x2v_); return __builtin_bit_cast(unsigned, b); }
typedef float f32x2 __attribute__((ext_vector_type(2)));
template <class Epi, class Sched, bool ALIGN_EPI = false, bool SP2 = false>
__device__ __forceinline__ void gemm_phase(PG8_LAS unsigned char* lds, const Gemm g, const Sched& S, const Epi& E) {
    const int tid = opq_tid(), wid = __builtin_amdgcn_readfirstlane(tid >> 6), lane = tid & 63, wr = wid >> 2, wc = wid & 3, fr = lane & 15, fq = lane >> 4;
    const int K = g.K, nt = K / BK;
    unsigned voffA[2], voffB[2];
#pragma unroll
    for (int i = 0; i < 2; ++i) { int R, C; stage_rc(tid * 16 + i * 8192, R, C); const int Rb = Epi::PERM ? ((R & ~31) + perm32(R & 31)) : R;
        voffA[i] = (unsigned)(R * K + C) * 2u; voffB[i] = (unsigned)(Rb * K + C) * 2u; }
    const size_t kstep = (size_t)(BK * 2);
    const size_t hstep = (size_t)HALF * K * 2;
    const size_t tstep = 2 * hstep;
    const unsigned ldsw = (unsigned)wid * 1024u;
    const int aoff = lds_byte(wr * 64 + fr, fq * 8), boff = lds_byte(wc * 32 + fr, fq * 8);
#define PG8_SA(b, h) (((b) * 2 + (h)) * HTB)
#define PG8_SB(b, h) ((4 + (b) * 2 + (h)) * HTB)
#define PG8_STAGE(bufoff, gbase, voff) do { _Pragma("unroll") for (int _i = 0; _i < 2; ++_i) \
        __builtin_amdgcn_global_load_lds((const unsigned*)((const char*)(gbase) + (voff)[_i]), (PG8_LAS unsigned*)(lds + (bufoff) + ldsw + _i * 8192), 16, 0, 0); } while (0)
#define PG8_LDA(dst, b, h) do { _Pragma("unroll") for (int m = 0; m < 4; ++m) _Pragma("unroll") for (int k = 0; k < 2; ++k) dst[m][k] = *(const PG8_LAS bf16x8*)(lds + PG8_SA(b, h) + aoff + m * 2048 + k * 1024); } while (0)
#define PG8_LDB(dst, b, h) do { _Pragma("unroll") for (int n = 0; n < 2; ++n) _Pragma("unroll") for (int k = 0; k < 2; ++k) dst[n][k] = *(const PG8_LAS bf16x8*)(lds + PG8_SB(b, h) + boff + n * 2048 + k * 1024); } while (0)
#define PG8_MMA(ai, bj, At, Bt) do { __builtin_amdgcn_s_setprio(1); _Pragma("unroll") for (int m = 0; m < 4; ++m) _Pragma("unroll") for (int n = 0; n < 2; ++n) _Pragma("unroll") for (int k = 0; k < 2; ++k) \
        acc[ai][bj][m][n] = __builtin_amdgcn_mfma_f32_16x16x32_bf16(Bt[n][k], At[m][k], acc[ai][bj][m][n], 0, 0, 0); __builtin_amdgcn_s_setprio(0); } while (0)
#define PG8_WAIT_V(n) asm volatile("s_waitcnt vmcnt(" #n ")" ::: "memory")
#define PG8_WAIT_L(n) asm volatile("s_waitcnt lgkmcnt(" #n ")" ::: "memory")
#define PG8_BAR __builtin_amdgcn_s_barrier()
#define PG8_SCHED __builtin_amdgcn_sched_barrier(0)
    Unit cur, nxt; int ui = 0;
    if (!S.next(0, cur)) return;
    f32x4 acc[2][2][4][2];
#pragma unroll
    for (int a = 0; a < 2; ++a)
#pragma unroll
        for (int b = 0; b < 2; ++b)
#pragma unroll
            for (int m = 0; m < 4; ++m)
#pragma unroll
                for (int n = 0; n < 2; ++n) acc[a][b][m][n] = (f32x4){0.f, 0.f, 0.f, 0.f};
    bf16x8 At[4][2], B0[2][2], B1[2][2];
    const char* cA = (const char*)g.A + (size_t)cur.pm * tstep; const char* cB = (const char*)g.Bt + (size_t)cur.pn * tstep;
    S.a_ready(cur);
    if constexpr (SP2) {
        PG8_STAGE(PG8_SB(0, 0), cB, voffB); PG8_STAGE(PG8_SB(0, 1), cB + hstep, voffB); PG8_STAGE(PG8_SA(0, 0), cA, voffA); PG8_STAGE(PG8_SA(0, 1), cA + hstep, voffA);
        if (wr == 1) PG8_BAR;
        PG8_WAIT_V(2); PG8_BAR;
        PG8_STAGE(PG8_SB(1, 0), cB + kstep, voffB); PG8_STAGE(PG8_SA(1, 0), cA + kstep, voffA); PG8_STAGE(PG8_SB(1, 1), cB + hstep + kstep, voffB);
        PG8_WAIT_V(6); PG8_BAR;
    } else {
        PG8_STAGE(PG8_SB(0, 0), cB, voffB); PG8_STAGE(PG8_SA(0, 0), cA, voffA); PG8_STAGE(PG8_SB(0, 1), cB + hstep, voffB); PG8_STAGE(PG8_SA(0, 1), cA + hstep, voffA);
        if (wr == 1) PG8_BAR;
        PG8_WAIT_V(4); PG8_BAR;
        PG8_STAGE(PG8_SB(1, 0), cB + kstep, voffB); PG8_STAGE(PG8_SA(1, 0), cA + kstep, voffA); PG8_STAGE(PG8_SB(1, 1), cB + hstep + kstep, voffB);
        PG8_WAIT_V(6); PG8_BAR;
    }
    for (;;) {
        const bool has_next = S.next(ui + 1, nxt);
        const char* nA = has_next ? (const char*)g.A + (size_t)nxt.pm * tstep : cA; const char* nB = has_next ? (const char*)g.Bt + (size_t)nxt.pn * tstep : cB;
        for (int t = 0; t < nt; t += 2) {
            const bool last = (t == nt - 2);
            const char* a1 = cA + (size_t)(t + 1) * kstep;
            const char* a2 = last ? nA : cA + (size_t)(t + 2) * kstep; const char* b2 = last ? nB : cB + (size_t)(t + 2) * kstep;
            const char* a3 = a2 + kstep; const char* b3 = b2 + kstep;
            if (last && has_next) S.a_ready(nxt);
            if constexpr (SP2) {
            PG8_LDB(B0, 0, 0); PG8_LDB(B1, 0, 1); PG8_SCHED; PG8_LDA(At, 0, 0); PG8_STAGE(PG8_SA(1, 1), a1 + hstep, voffA);
            PG8_WAIT_V(8); PG8_WAIT_L(0); PG8_BAR; PG8_MMA(0, 0, At, B0); PG8_MMA(0, 1, At, B1); PG8_BAR; PG8_SCHED;
            PG8_LDA(At, 0, 1); PG8_STAGE(PG8_SB(0, 0), b2, voffB); PG8_STAGE(PG8_SB(0, 1), b2 + hstep, voffB); PG8_STAGE(PG8_SA(0, 0), a2, voffA);
            PG8_WAIT_V(8); PG8_WAIT_L(0); PG8_BAR; PG8_MMA(1, 0, At, B0); PG8_MMA(1, 1, At, B1); PG8_BAR; PG8_SCHED;
            PG8_LDB(B0, 1, 0); PG8_LDB(B1, 1, 1); PG8_SCHED; PG8_LDA(At, 1, 0); PG8_STAGE(PG8_SA(0, 1), a2 + hstep, voffA);
            PG8_WAIT_V(8); PG8_WAIT_L(0); PG8_BAR; PG8_MMA(0, 0, At, B0); PG8_MMA(0, 1, At, B1); PG8_BAR; PG8_SCHED;
            PG8_LDA(At, 1, 1); PG8_STAGE(PG8_SB(1, 0), b3, voffB); PG8_STAGE(PG8_SB(1, 1), b3 + hstep, voffB); PG8_STAGE(PG8_SA(1, 0), a3, voffA);
            PG8_WAIT_V(8); PG8_WAIT_L(0); PG8_BAR; PG8_MMA(1, 0, At, B0); PG8_MMA(1, 1, At, B1); PG8_BAR; PG8_SCHED;
            } else {
            PG8_LDB(B0, 0, 0); PG8_SCHED; PG8_LDA(At, 0, 0); PG8_STAGE(PG8_SA(1, 1), a1 + hstep, voffA);
            PG8_WAIT_L(8); PG8_BAR; PG8_WAIT_L(0); PG8_MMA(0, 0, At, B0); PG8_BAR; PG8_SCHED;
            PG8_LDB(B1, 0, 1); PG8_STAGE(PG8_SB(0, 0), b2, voffB);
            PG8_BAR; PG8_WAIT_L(0); PG8_MMA(0, 1, At, B1); PG8_BAR;
            PG8_LDA(At, 0, 1); PG8_STAGE(PG8_SA(0, 0), a2, voffA);
            PG8_BAR; PG8_WAIT_L(0); PG8_MMA(1, 0, At, B0); PG8_BAR; PG8_SCHED;
            PG8_STAGE(PG8_SB(0, 1), b2 + hstep, voffB);
            PG8_WAIT_V(6); PG8_BAR; PG8_MMA(1, 1, At, B1); PG8_BAR;
            PG8_LDB(B0, 1, 0); PG8_SCHED; PG8_LDA(At, 1, 0); PG8_STAGE(PG8_SA(0, 1), a2 + hstep, voffA);
            PG8_WAIT_L(8); PG8_BAR; PG8_WAIT_L(0); PG8_MMA(0, 0, At, B0); PG8_BAR; PG8_SCHED;
            PG8_LDB(B1, 1, 1); PG8_STAGE(PG8_SB(1, 0), b3, voffB);
            PG8_BAR; PG8_WAIT_L(0); PG8_MMA(0, 1, At, B1); PG8_BAR;
            PG8_LDA(At, 1, 1); PG8_STAGE(PG8_SA(1, 0), a3, voffA);
            PG8_BAR; PG8_WAIT_L(0); PG8_MMA(1, 0, At, B0); PG8_BAR; PG8_SCHED;
            PG8_STAGE(PG8_SB(1, 1), b3 + hstep, voffB);
            PG8_WAIT_V(6); PG8_BAR; PG8_MMA(1, 1, At, B1); PG8_BAR;
            }
        }
        if constexpr (ALIGN_EPI) { if (wr == 0) PG8_BAR; }
        if constexpr (!Epi::AFTER_DRAIN) { E(acc, cur, wr, wc, fr, fq); S.done(cur); }
        if (!has_next) break;
#pragma unroll
        for (int a = 0; a < 2; ++a)
#pragma unroll
            for (int b = 0; b < 2; ++b)
#pragma unroll
                for (int m = 0; m < 4; ++m)
#pragma unroll
                    for (int n = 0; n < 2; ++n) acc[a][b][m][n] = (f32x4){0.f, 0.f, 0.f, 0.f};
        cur = nxt; cA = nA; cB = nB; ++ui;
        if constexpr (ALIGN_EPI) { if (wr == 1) PG8_BAR; }
    }
    PG8_WAIT_V(0);
    if constexpr (!ALIGN_EPI) { if (wr == 0) PG8_BAR; }
    PG8_BAR;
    if constexpr (Epi::AFTER_DRAIN) { E.fused(acc, cur, wr, wc, fr, fq, lds, wid, lane); S.done(cur); }
#undef PG8_SA
#undef PG8_SB
#undef PG8_STAGE
#undef PG8_LDA
#undef PG8_LDB
#undef PG8_MMA
#undef PG8_WAIT_V
#undef PG8_WAIT_L
#undef PG8_BAR
#undef PG8_SCHED
}
}

#ifndef ONE_LAUNCH
#define ONE_LAUNCH 1
#endif
using pg8::bf16_t; using pg8::bf16x8; using pg8::f32x4; using pg8::u32x4; using pg8::Unit; using pg8::cvt_pk_bf16;
typedef unsigned u32x2 __attribute__((ext_vector_type(2)));
typedef unsigned short u16x4 __attribute__((ext_vector_type(4)));

constexpr int T = 16384, D = 1024, FF = 2816, NCAT = 6656, HALFCAT = 3328, QW = 3072, KVW = 6144;
constexpr float RMS_EPS = 1e-6f;
constexpr int LDS_BYTES = 147456;
constexpr int NSTEPS = 38;

constexpr size_t WS_BAR = 0;
constexpr size_t WS_WIN = 1u << 20;
constexpr size_t SZ_WIN = (size_t)5632 * 1024 * 2;
constexpr size_t WS_WOUT = WS_WIN + 8 * SZ_WIN;
constexpr size_t SZ_WOUT = (size_t)1024 * 2816 * 2;
constexpr size_t WS_WCAT = WS_WOUT + 8 * SZ_WOUT;
constexpr size_t SZ_WCAT = (size_t)NCAT * 1024 * 2;
constexpr size_t WS_WOR = WS_WCAT + 2 * SZ_WCAT;
constexpr size_t SZ_SQ = (size_t)1024 * 1024 * 2;
constexpr size_t WS_WUP = WS_WOR + 2 * SZ_SQ;
constexpr size_t SZ_UP = (size_t)1024 * 64 * 2;
constexpr size_t WS_WKV = WS_WUP + 8 * SZ_UP;
constexpr size_t WS_WQ = WS_WKV + (size_t)KVW * 1024 * 2;
constexpr size_t SZ_WQ = (size_t)QW * 1024 * 2;
constexpr size_t WS_WOA = WS_WQ + 2 * SZ_WQ;
constexpr size_t WS_XB = WS_WOA + 2 * SZ_SQ;
constexpr size_t SZ_TD2 = (size_t)T * 1024 * 2;
constexpr size_t WS_BIG = WS_XB + SZ_TD2;
constexpr size_t SZ_BIG = (size_t)T * NCAT * 2;
constexpr size_t WS_MIX = WS_BIG + SZ_BIG;
constexpr size_t WS_SS = WS_MIX + 8 * SZ_TD2;
constexpr size_t SZ_SS = (size_t)T * 16 * 4;
constexpr size_t WS_END = WS_SS + 13 * SZ_SS;
constexpr size_t BIG_Y = 0, BIG_YG = (size_t)T * 1024 * 4;
constexpr size_t BIG_Q = 0, BIG_OG = (size_t)T * QW * 2, BIG_LSE = BIG_OG + 3 * SZ_TD2;
static_assert(BIG_LSE + (size_t)3 * T * 16 * 4 <= SZ_BIG, "big");

struct Args { const float* in[30]; float* out; unsigned char* ws; int ph_lo, ph_hi; };

__device__ __forceinline__ float bf2f(unsigned short v) { return __uint_as_float((unsigned)v << 16); }
__device__ __forceinline__ float bflo(unsigned v) { return __uint_as_float(v << 16); }
__device__ __forceinline__ float bfhi(unsigned v) { return __uint_as_float(v & 0xffff0000u); }
__device__ __forceinline__ float row_rs(const float* ssp, int row) { const f32x4* q = (const f32x4*)(ssp + (size_t)row * 16); const f32x4 a = q[0], b = q[1], c = q[2], d = q[3];
    const float s = ((a[0] + a[1]) + (a[2] + a[3])) + ((b[0] + b[1]) + (b[2] + b[3])) + (((c[0] + c[1]) + (c[2] + c[3])) + ((d[0] + d[1]) + (d[2] + d[3]))); return rsqrtf(s * (1.f / 1024.f) + RMS_EPS); }
__device__ __forceinline__ float sigm(float x) { return __builtin_amdgcn_rcpf(1.f + __expf(-x)); }
__device__ __forceinline__ float tanh_fast(float x) { const float e = __expf(2.f * x); return 1.f - 2.f * __builtin_amdgcn_rcpf(e + 1.f); }
#define LAS __attribute__((address_space(3)))
#define XB_TMO      128
#define XB_XCNT(j)  (256  + 64 * (j))
#define XB_XSUB(j)  (1280 + 64 * (j))
#define XB_XGEN(j)  (2304 + 64 * (j))
#define XB_TOP      3328
#define XB_TOPGEN   3392
#define XCD_BAR_WORDS 3456
#define XB_SPIN_CAP (1u << 18)

__device__ __forceinline__ unsigned xb_ld(unsigned* p)              { return __hip_atomic_load(p, __ATOMIC_RELAXED, __HIP_MEMORY_SCOPE_AGENT); }
__device__ __forceinline__ unsigned xb_add(unsigned* p, unsigned v) { return __hip_atomic_fetch_add(p, v, __ATOMIC_RELAXED, __HIP_MEMORY_SCOPE_AGENT); }
__device__ __forceinline__ unsigned xb_xcc_id() { return (unsigned)__builtin_amdgcn_s_getreg((3 << 11) | 20) & 0xFu; }
#define XB_SPIN(cond, bar) do { unsigned _sp = 0; while (cond) { __builtin_amdgcn_s_sleep(1); \
    if ((++_sp & 255u) == 0u) { if (xb_ld(&(bar)[XB_TMO])) break; if (_sp > XB_SPIN_CAP) { atomicAdd(&(bar)[XB_TMO], 1u); break; } } } } while (0)

struct XcdBarrier {
    unsigned* bar; unsigned x;
    volatile LAS unsigned* st;
};

__device__ __forceinline__ XcdBarrier xcd_barrier_post(unsigned* bar, volatile LAS unsigned* st) {
    XcdBarrier b; b.bar = bar; b.x = xb_xcc_id(); b.st = st;
    if (threadIdx.x == 0) (void)xb_add(&bar[XB_XCNT(b.x)], 1u);
    return b;
}
__device__ __forceinline__ void xcd_barrier_complete(unsigned* bar, unsigned x, unsigned& nloc, unsigned& nx) {
    const unsigned G = gridDim.x * gridDim.y * gridDim.z;
    unsigned sum, cnt, mine, sp = 0u;
    for (;;) {
        sum = 0u; cnt = 0u; mine = 0u;
#pragma unroll
        for (unsigned j = 0; j < 16; ++j) { const unsigned c = xb_ld(&bar[XB_XCNT(j)]); sum += c; cnt += (c > 0u) ? 1u : 0u; mine = (j == x) ? c : mine; }
        if (sum == G) break;
        __builtin_amdgcn_s_sleep(1);
        if ((++sp & 255u) == 0u) { if (xb_ld(&bar[XB_TMO])) break; if (sp > XB_SPIN_CAP) { atomicAdd(&bar[XB_TMO], 1u); break; } }
    }
    nloc = mine > 0u ? mine : 1u; nx = cnt > 0u ? cnt : 1u;
}

__device__ __forceinline__ void xcd_barrier(const XcdBarrier& b) {
    asm volatile("s_waitcnt vmcnt(0)" ::: "memory");
    __syncthreads();
    if (threadIdx.x == 0) {
        unsigned* bar = b.bar;
        __builtin_amdgcn_s_waitcnt(0);
        unsigned nloc = b.st[0], nx = b.st[1];
        if (nloc == 0u) { xcd_barrier_complete(bar, b.x, nloc, nx); b.st[0] = nloc; b.st[1] = nx; }
        const unsigned old = xb_add(&bar[XB_XSUB(b.x)], 1u);
        const unsigned gen = old / nloc;
        if (old + 1u == (gen + 1u) * nloc) {
            __builtin_amdgcn_fence(__ATOMIC_RELEASE, "agent");
            asm volatile("s_waitcnt vmcnt(0)" ::: "memory");
            const unsigned og = xb_add(&bar[XB_TOP], 1u);
            const unsigned tg = og / nx;
            if (og + 1u == (tg + 1u) * nx) xb_add(&bar[XB_TOPGEN], 1u);
            else XB_SPIN(xb_ld(&bar[XB_TOPGEN]) == tg, bar);
            __builtin_amdgcn_fence(__ATOMIC_ACQUIRE, "agent");
            xb_add(&bar[XB_XGEN(b.x)], 1u);
            asm volatile("s_waitcnt vmcnt(0)" ::: "memory");
        } else {
            XB_SPIN(xb_ld(&bar[XB_XGEN(b.x)]) == gen, bar);
            __builtin_amdgcn_fence(__ATOMIC_ACQUIRE, "agent");
            asm volatile("s_waitcnt vmcnt(0)" ::: "memory");
        }
    }
    __syncthreads();
}
struct EpiPlain {
    static constexpr bool PERM = true, AFTER_DRAIN = false;
    bf16_t* O; int ldc;
    __device__ __forceinline__ void operator()(const f32x4 (&acc)[2][2][4][2], const Unit& u, int wr, int wc, int fr, int fq) const {
        const int row0 = u.pm * 256 + wr * 64 + fr, col0 = u.pn * 256 + wc * 32 + 8 * fq;
#pragma unroll
        for (int ai = 0; ai < 2; ++ai)
#pragma unroll
            for (int m = 0; m < 4; ++m) { bf16_t* rowp = O + (size_t)(row0 + ai * 128 + m * 16) * ldc + col0;
#pragma unroll
                for (int bj = 0; bj < 2; ++bj) { const f32x4 v0 = acc[ai][bj][m][0], v1 = acc[ai][bj][m][1]; u32x4 w;
                    w.x = cvt_pk_bf16(v0[0], v0[1]); w.y = cvt_pk_bf16(v0[2], v0[3]); w.z = cvt_pk_bf16(v1[0], v1[1]); w.w = cvt_pk_bf16(v1[2], v1[3]);
                    *(u32x4*)(rowp + bj * 128) = w; } }
    }
};
struct EpiSwiglu {
    static constexpr bool PERM = true, AFTER_DRAIN = false;
    bf16_t* O; const float* ss; const PG8_LAS float* rtab;
    __device__ __forceinline__ void operator()(const f32x4 (&acc)[2][2][4][2], const Unit& u, int wr, int wc, int fr, int fq) const {
        const int row0 = u.pm * 256 + wr * 64 + fr, col0 = u.pn * 128 + wc * 32 + 8 * fq; const PG8_LAS float* rt = rtab + u.ord * 256 + wr * 64 + fr;
#pragma unroll
        for (int ai = 0; ai < 2; ++ai)
#pragma unroll
            for (int m = 0; m < 4; ++m) { const int row = row0 + ai * 128 + m * 16; const float rs = rt[ai * 128 + m * 16];
                float o[8];
#pragma unroll
                for (int n = 0; n < 2; ++n)
#pragma unroll
                    for (int e = 0; e < 4; ++e) { const float g = acc[ai][0][m][n][e] * rs, up = acc[ai][1][m][n][e] * rs; o[n * 4 + e] = g * sigm(g) * up; }
                u32x4 w; w.x = cvt_pk_bf16(o[0], o[1]); w.y = cvt_pk_bf16(o[2], o[3]); w.z = cvt_pk_bf16(o[4], o[5]); w.w = cvt_pk_bf16(o[6], o[7]);
                *(u32x4*)(O + (size_t)row * FF + col0) = w; }
    }
};
struct EpiResid {
    static constexpr bool PERM = true, AFTER_DRAIN = false;
    const float* xold; float* xnew; bf16_t* xb; float* ssn; float alpha;
    __device__ __forceinline__ void operator()(const f32x4 (&acc)[2][2][4][2], const Unit& u, int wr, int wc, int fr, int fq) const {
        const int row0 = u.pm * 256 + wr * 64 + fr, col0 = u.pn * 256 + wc * 32 + 8 * fq;
#pragma unroll
        for (int ai = 0; ai < 2; ++ai)
#pragma unroll
          for (int mh = 0; mh < 2; ++mh) {
            f32x4 xo[2][2][2];
#pragma unroll
            for (int m2 = 0; m2 < 2; ++m2)
#pragma unroll
                for (int bj = 0; bj < 2; ++bj) { const size_t off = (size_t)(row0 + ai * 128 + (mh * 2 + m2) * 16) * D + col0 + bj * 128; xo[m2][bj][0] = *(const f32x4*)(xold + off); xo[m2][bj][1] = *(const f32x4*)(xold + off + 4); }
#pragma unroll
            for (int m2 = 0; m2 < 2; ++m2) { const int m = mh * 2 + m2; const int row = row0 + ai * 128 + m * 16; float s = 0.f;
#pragma unroll
                for (int bj = 0; bj < 2; ++bj) { const size_t off = (size_t)row * D + col0 + bj * 128;
                    const f32x4 xn0 = xo[m2][bj][0] + acc[ai][bj][m][0] * alpha, xn1 = xo[m2][bj][1] + acc[ai][bj][m][1] * alpha;
                    *(f32x4*)(xnew + off) = xn0; *(f32x4*)(xnew + off + 4) = xn1;
                    s += ((xn0[0] * xn0[0] + xn0[1] * xn0[1]) + (xn0[2] * xn0[2] + xn0[3] * xn0[3])) + ((xn1[0] * xn1[0] + xn1[1] * xn1[1]) + (xn1[2] * xn1[2] + xn1[3] * xn1[3]));
                    u32x4 w; w.x = cvt_pk_bf16(xn0[0], xn0[1]); w.y = cvt_pk_bf16(xn0[2], xn0[3]); w.z = cvt_pk_bf16(xn1[0], xn1[1]); w.w = cvt_pk_bf16(xn1[2], xn1[3]); *(u32x4*)(xb + off) = w; }
                s += __shfl_xor(s, 16); s += __shfl_xor(s, 32);
                if (fq == 0) ssn[(size_t)row * 16 + u.pn * 4 + wc] = s; } }
    }
};
struct EpiHeadNorm {
    static constexpr bool PERM = true, AFTER_DRAIN = false;
    bf16_t* O; int ldc; const float* ss; const float* gain; int nnorm; float scale; const PG8_LAS float* rtab;
    __device__ __forceinline__ void operator()(const f32x4 (&acc)[2][2][4][2], const Unit& u, int wr, int wc, int fr, int fq) const {
        const int row0 = u.pm * 256 + wr * 64 + fr; const int head = u.pn * 4 + wc; const bool normed = head < nnorm; const int g = (head >> 4) % 3;
        float gn[2][8];
#pragma unroll
        for (int bj = 0; bj < 2; ++bj)
#pragma unroll
            for (int j = 0; j < 8; ++j) gn[bj][j] = normed ? gain[g * 64 + bj * 32 + 8 * fq + j] * scale : 1.f;
#pragma unroll
        for (int ai = 0; ai < 2; ++ai)
#pragma unroll
            for (int m = 0; m < 4; ++m) { const int row = row0 + ai * 128 + m * 16; const float rs = rtab[u.ord * 256 + wr * 64 + fr + ai * 128 + m * 16];
                float v[2][8]; float s = 0.f;
#pragma unroll
                for (int bj = 0; bj < 2; ++bj)
#pragma unroll
                    for (int n = 0; n < 2; ++n)
#pragma unroll
                        for (int e = 0; e < 4; ++e) { const float x = acc[ai][bj][m][n][e] * rs; v[bj][n * 4 + e] = x; s += x * x; }
                s += __shfl_xor(s, 16); s += __shfl_xor(s, 32);
                const float inv = normed ? rsqrtf(s * (1.f / 64.f) + RMS_EPS) : 1.f;
#pragma unroll
                for (int bj = 0; bj < 2; ++bj) { float o[8];
#pragma unroll
                    for (int j = 0; j < 8; ++j) o[j] = v[bj][j] * inv * gn[bj][j];
                    u32x4 w; w.x = cvt_pk_bf16(o[0], o[1]); w.y = cvt_pk_bf16(o[2], o[3]); w.z = cvt_pk_bf16(o[4], o[5]); w.w = cvt_pk_bf16(o[6], o[7]);
                    const int hh = head % 48, pg_ = hh >> 4, sh_ = 2 * pg_; const int pos = (row & ((1 << sh_) - 1)) * (T >> sh_) + (row >> sh_);
                    *(u32x4*)(O + (head >= 48 ? (size_t)48 * T * 64 : (size_t)0) + ((size_t)hh * T + pos) * 64 + bj * 32 + 8 * fq) = w; } }
    }
};
struct MatDesc { const float* W; int K, N; bf16_t* dst; int dstK, row_off, maptype; const float* s1; const float* s2; int s2mode; };
__device__ __forceinline__ int map_row(int maptype, int n) {
    if (maptype == 1) { const int u = n % FF, isup = n / FF; return (u >> 7) * 256 + isup * 128 + (u & 127); }
    if (maptype == 2) { const int tile = n >> 8, w = n & 255, head = w >> 6, d = w & 63; return tile * 256 + (d >> 5) * 128 + head * 32 + (d & 31); }
    return n;
}
struct ConvRegs { f32x4 v[2]; float sc[2]; };
__device__ __forceinline__ void conv_load(const MatDesc& md, int tile, ConvRegs& R) {
    const int tid = pg8::opq_tid(); const int ntn = (md.N + 63) >> 6; const int kt = tile / ntn, nt = tile - kt * ntn; const int k0 = kt * 64, n0 = nt * 64;
#pragma unroll
    for (int p = 0; p < 2; ++p) { const int kk = p * 32 + (tid >> 4), nn = (tid & 15) * 4, k = k0 + kk;
        f32x4 v = {0.f, 0.f, 0.f, 0.f}; float sc = 1.f;
        if (k < md.K) { if (n0 + nn < md.N) v = *(const f32x4*)(md.W + (size_t)k * md.N + n0 + nn);
            if (md.s1) sc = md.s1[k]; if (md.s2mode == 1) sc *= md.s2[k]; else if (md.s2mode == 2) sc *= (1.f - md.s2[k]); }
        R.v[p] = v; R.sc[p] = sc; }
}
__device__ __forceinline__ void conv_store(const MatDesc& md, int tile, const ConvRegs& R, float* tl) {
    const int tid = pg8::opq_tid(); const int ntn = (md.N + 63) >> 6; const int kt = tile / ntn, nt = tile - kt * ntn; const int k0 = kt * 64, n0 = nt * 64;
#pragma unroll
    for (int p = 0; p < 2; ++p) { const int kk = p * 32 + (tid >> 4), nn = (tid & 15) * 4; const f32x4 v = R.v[p]; const float sc = R.sc[p];
        tl[kk * 65 + nn + 0] = v[0] * sc; tl[kk * 65 + nn + 1] = v[1] * sc; tl[kk * 65 + nn + 2] = v[2] * sc; tl[kk * 65 + nn + 3] = v[3] * sc; }
    asm volatile("s_waitcnt lgkmcnt(0)" ::: "memory"); __builtin_amdgcn_s_barrier(); asm volatile("" ::: "memory");
    { const int n = tid >> 3, kc = tid & 7;
      if (n0 + n < md.N && k0 + kc * 8 < md.dstK) { float o[8];
#pragma unroll
          for (int j = 0; j < 8; ++j) o[j] = tl[(kc * 8 + j) * 65 + n];
          u32x4 w; w.x = cvt_pk_bf16(o[0], o[1]); w.y = cvt_pk_bf16(o[2], o[3]); w.z = cvt_pk_bf16(o[4], o[5]); w.w = cvt_pk_bf16(o[6], o[7]);
          const int drow = md.row_off + map_row(md.maptype, n0 + n);
          *(u32x4*)(md.dst + (size_t)drow * md.dstK + k0 + kc * 8) = w; } }
    asm volatile("s_waitcnt lgkmcnt(0)" ::: "memory"); __builtin_amdgcn_s_barrier(); asm volatile("" ::: "memory");
}
__device__ __forceinline__ bool get_mat(const Args& a, int mi, MatDesc& md) {
    unsigned char* ws = pg8::opq_ptr(a.ws); md.s1 = nullptr; md.s2 = nullptr; md.s2mode = 0; md.row_off = 0; md.maptype = 0;
    if (mi < 8) { md.W = a.in[2] + (size_t)mi * 1024 * 5632; md.K = 1024; md.N = 5632; md.dst = (bf16_t*)(ws + WS_WIN + mi * SZ_WIN); md.dstK = 1024; md.maptype = 1; md.s1 = a.in[1] + mi * 1024; return true; }
    mi -= 8;
    if (mi < 8) { md.W = a.in[3] + (size_t)mi * 2816 * 1024; md.K = 2816; md.N = 1024; md.dst = (bf16_t*)(ws + WS_WOUT + mi * SZ_WOUT); md.dstK = 2816; return true; }
    mi -= 8;
    if (mi < 38) { const int l = mi / 19, r = mi % 19;
        if (r < 14) { const int part = r / 7, s = r % 7; md.K = 1024; md.dstK = 1024; md.dst = (bf16_t*)(ws + WS_WCAT + l * SZ_WCAT); md.s1 = a.in[4] + l * 1024; md.s2mode = part ? 1 : 2;
            const float* mu = a.in[5] + (size_t)l * 6 * 1024; int off;
            if (s == 0) { md.W = a.in[6] + (size_t)(l * 3 + 0) * 1024 * 1024; md.N = 1024; md.s2 = mu + 0 * 1024; off = 0; }
            else if (s == 1) { md.W = a.in[6] + (size_t)(l * 3 + 1) * 1024 * 1024; md.N = 1024; md.s2 = mu + 2 * 1024; off = 1024; }
            else if (s == 2) { md.W = a.in[6] + (size_t)(l * 3 + 2) * 1024 * 1024; md.N = 1024; md.s2 = mu + 3 * 1024; off = 2048; }
            else if (s == 3) { md.W = a.in[8] + (size_t)l * 1024 * 64; md.N = 64; md.s2 = mu + 1 * 1024; off = 3072; }
            else if (s == 4) { md.W = a.in[11] + (size_t)l * 1024 * 64; md.N = 64; md.s2 = mu + 4 * 1024; off = 3136; }
            else if (s == 5) { if (l == 0) return false; md.W = a.in[14]; md.N = 32; md.s2 = mu + 3 * 1024; off = 3200; }
            else { md.W = a.in[16] + (size_t)l * 1024 * 64; md.N = 64; md.s2 = mu + 5 * 1024; off = 3232; }
            md.row_off = off + part * HALFCAT; return true; }
        if (r == 14) { md.W = a.in[23] + (size_t)l * 1024 * 1024; md.K = 1024; md.N = 1024; md.dst = (bf16_t*)(ws + WS_WOR + l * SZ_SQ); md.dstK = 1024; return true; }
        const int ui = r - 15; md.N = 1024; md.dstK = 64; md.K = 64; md.dst = (bf16_t*)(ws + WS_WUP + (size_t)(l * 4 + ui) * SZ_UP);
        if (ui == 0) md.W = a.in[9] + (size_t)l * 64 * 1024;
        else if (ui == 1) md.W = a.in[12] + (size_t)l * 64 * 1024;
        else if (ui == 2) { if (l == 0) return false; md.W = a.in[15]; md.K = 32; }
        else md.W = a.in[17] + (size_t)l * 64 * 1024;
        return true; }
    mi -= 38;
    if (mi == 0) { md.W = a.in[25]; md.K = 1024; md.N = KVW; md.dst = (bf16_t*)(ws + WS_WKV); md.dstK = 1024; md.maptype = 2; md.s1 = a.in[24]; return true; }
    mi -= 1;
    if (mi < 2) { md.W = a.in[27] + (size_t)mi * 1024 * QW; md.K = 1024; md.N = QW; md.dst = (bf16_t*)(ws + WS_WQ + mi * SZ_WQ); md.dstK = 1024; md.maptype = 2; md.s1 = a.in[4] + (2 + mi) * 1024; return true; }
    mi -= 2;
    md.W = a.in[29] + (size_t)mi * 1024 * 1024; md.K = 1024; md.N = 1024; md.dst = (bf16_t*)(ws + WS_WOA + mi * SZ_SQ); md.dstK = 1024; return true;
}
constexpr int NMAT = 8 + 8 + 38 + 1 + 2 + 2;
__device__ __forceinline__ void zero_rows(bf16_t* base, int row0, int nrows) {
    const int gt = pg8::opq_bid() * 512 + pg8::opq_tid(), NT = gridDim.x * 512;
    for (int i = gt; i < nrows * 128; i += NT) *(u32x4*)(base + (size_t)row0 * 1024 + (size_t)i * 8) = (u32x4){0u, 0u, 0u, 0u};
}
__device__ __forceinline__ int conv_sel(int mi) {
    if (mi < 16) { const int idx = mi & 7; return idx == 0 ? 0 : (idx < 4 ? 1 : 2); }
    if (mi < 54) return (mi - 16) / 19;
    return 2;
}
__device__ __forceinline__ void p0_convert(const Args& a, float* tl, int sel, int vbid, int vG) {
    for (int mi = 0; mi < NMAT; ++mi) { if (conv_sel(mi) != sel) continue; MatDesc md; if (!get_mat(a, mi, md)) continue;
        const int ntiles = ((md.K + 63) >> 6) * ((md.N + 63) >> 6);
        const int G = vG; int tile = (vbid + mi * 37) % G; ConvRegs R[4];
#pragma unroll
        for (int k = 0; k < 4; ++k) if (tile + k * G < ntiles) conv_load(md, tile + k * G, R[k]);
        for (; tile < ntiles; tile += 4 * G) {
#pragma unroll
            for (int k = 0; k < 4; ++k) { const int tk = tile + k * G; if (tk < ntiles) { conv_store(md, tk, R[k], tl); const int tn = tk + 4 * G; if (tn < ntiles) conv_load(md, tn, R[k]); } } } }
}
__device__ __forceinline__ void p0_phase(const Args& a, float* tl) {
    unsigned char* ws = pg8::opq_ptr(a.ws);
    p0_convert(a, tl, 0, pg8::opq_bid(), gridDim.x);
    if (gridDim.x <= 64) { p0_convert(a, tl, 1, pg8::opq_bid(), gridDim.x); p0_convert(a, tl, 2, pg8::opq_bid(), gridDim.x); }
    for (int l = 0; l < 2; ++l) { bf16_t* wc = (bf16_t*)(ws + WS_WCAT + l * SZ_WCAT);
        zero_rows(wc, 3296, 32); zero_rows(wc, HALFCAT + 3296, 32);
        if (l == 0) { zero_rows(wc, 3200, 32); zero_rows(wc, HALFCAT + 3200, 32); } }
    { const int gw = pg8::opq_bid() * 8 + (pg8::opq_tid() >> 6), NGW = gridDim.x * 8, lane = pg8::opq_tid() & 63;
      const float* x = a.in[0]; bf16_t* xb = (bf16_t*)(ws + WS_XB); float* ss = (float*)(ws + WS_SS);
      for (int m = gw; m < T; m += NGW) { float s = 0.f;
#pragma unroll
          for (int j = 0; j < 4; ++j) { const f32x4 v = *(const f32x4*)(x + (size_t)m * D + j * 256 + lane * 4); s += (v[0] * v[0] + v[1] * v[1]) + (v[2] * v[2] + v[3] * v[3]);
              u32x2 w; w.x = cvt_pk_bf16(v[0], v[1]); w.y = cvt_pk_bf16(v[2], v[3]); *(u32x2*)(xb + (size_t)m * D + j * 256 + lane * 4) = w; }
#pragma unroll
          for (int o = 1; o < 64; o <<= 1) s += __shfl_xor(s, o);
          if (lane < 16) ss[(size_t)m * 16 + lane] = lane == 0 ? s : 0.f; }
    }
}
#define MFMA16(a, b, c) __builtin_amdgcn_mfma_f32_16x16x32_bf16((a), (b), (c), 0, 0, 0)
__device__ __forceinline__ void ld8(const bf16_t* p, float (&o)[8]) { const u32x4 w = *(const u32x4*)p; o[0] = bflo(w.x); o[1] = bfhi(w.x); o[2] = bflo(w.y); o[3] = bfhi(w.y); o[4] = bflo(w.z); o[5] = bfhi(w.z); o[6] = bflo(w.w); o[7] = bfhi(w.w); }
__device__ __forceinline__ void ld4(const bf16_t* p, float (&o)[4]) { const u32x2 w = *(const u32x2*)p; o[0] = bflo(w.x); o[1] = bfhi(w.x); o[2] = bflo(w.y); o[3] = bfhi(w.y); }
__device__ __forceinline__ void up8(const u32x4 w, float (&o)[8]) { o[0] = bflo(w.x); o[1] = bfhi(w.x); o[2] = bflo(w.y); o[3] = bfhi(w.y); o[4] = bflo(w.z); o[5] = bfhi(w.z); o[6] = bflo(w.w); o[7] = bfhi(w.w); }
__device__ __forceinline__ void up4(const u32x2 w, float (&o)[4]) { o[0] = bflo(w.x); o[1] = bfhi(w.x); o[2] = bflo(w.y); o[3] = bfhi(w.y); }
__device__ __forceinline__ bf16x8 pack8(const float (&o)[8]) { u32x4 w; w.x = cvt_pk_bf16(o[0], o[1]); w.y = cvt_pk_bf16(o[2], o[3]); w.z = cvt_pk_bf16(o[4], o[5]); w.w = cvt_pk_bf16(o[6], o[7]); return __builtin_bit_cast(bf16x8, w); }
__device__ __forceinline__ void st4(bf16_t* p, float a, float b, float c, float d) { u32x2 w; w.x = cvt_pk_bf16(a, b); w.y = cvt_pk_bf16(c, d); *(u32x2*)p = w; }

__device__ __forceinline__ void f1_phase(const Args& a, int l, unsigned char* lds) {
    unsigned char* ws = pg8::opq_ptr(a.ws); const int lane = pg8::opq_tid() & 63, wave = pg8::opq_tid() >> 6; const int gw = pg8::opq_bid() * 8 + wave, NGW = gridDim.x * 8;
    const int tok = lane & 15, q = lane >> 4;
    const bf16_t* P = (const bf16_t*)(ws + WS_BIG); const float* ss = (const float*)(ws + WS_SS) + (size_t)(3 * l + 1) * T * 16;
    const bf16_t* WUP = (const bf16_t*)(ws + WS_WUP + (size_t)l * 4 * SZ_UP);
    bf16_t* oR = (bf16_t*)(ws + WS_MIX); bf16_t* oLD = oR + (size_t)T * D; bf16_t* oK = oLD + (size_t)T * D; bf16_t* oA = oK + (size_t)T * D; bf16_t* oB = oA + (size_t)T * D;
    bf16_t* oV0 = oB + (size_t)T * D; bf16_t* oV1 = oV0 + (size_t)T * D; bf16_t* oG = oV1 + (size_t)T * D;
    bf16_t* oV = l ? oV1 : oV0;
    const float* w0 = a.in[7] + l * D; const float* a0 = a.in[10] + l * D; const float* v0 = a.in[13]; const float* kkp = a.in[18] + l * D; const float* kap = a.in[19] + l * D;
    const int bidf = pg8::opq_bid(); const int h = bidf & 15, grp = bidf >> 4, ngrp = gridDim.x >> 4; (void)gw; (void)NGW;
    bf16_t* wl = (bf16_t*)lds; float* pl = (float*)(lds + 4 * 64 * 72 * 2);
    { const int tidf = pg8::opq_tid();
      for (int i = tidf; i < 4 * 64 * 8; i += 512) { const int m = i >> 9, r = (i >> 3) & 63, c8 = (i & 7) * 8;
          u32x4 v = {0u, 0u, 0u, 0u}; if (m != 2 || l) v = *(const u32x4*)(WUP + (size_t)m * 1024 * 64 + (size_t)(h * 64 + r) * 64 + c8);
          *(u32x4*)(wl + (m * 64 + r) * 72 + c8) = v; }
      if (tidf < 320) { const int m = tidf >> 6, c = tidf & 63; float v = 0.f;
          if (m == 0) v = w0[h * 64 + c]; else if (m == 1) v = a0[h * 64 + c]; else if (m == 2) { if (l) v = v0[h * 64 + c]; } else if (m == 3) v = kkp[h * 64 + c]; else v = kap[h * 64 + c];
          pl[m * 64 + c] = v; } }
    __syncthreads();
    bf16_t* stg = (bf16_t*)(lds + 38400 + wave * 12288);
    for (int tt = grp * 8 + wave; tt < T / 16 && grp < ngrp; tt += ngrp * 8) {
        const int t = tt * 16 + tok;
        const float rs_c = row_rs(ss, t); const float rs_p = t > 0 ? row_rs(ss, t > 0 ? t - 1 : 0) : 0.f;
        const bf16_t* Pc = P + (size_t)t * NCAT; const bf16_t* Pp = P + (size_t)(t > 0 ? t - 1 : 0) * NCAT + HALFCAT;
        u32x4 Lw[2][2], La[2][2], Lg[2][2], Lv[2]; u32x2 Lr[4][2], Lk[4][2], Lvv[4][2], Lvf[4];
#pragma unroll
        for (int ks = 0; ks < 2; ++ks) { const int ko = ks * 32 + q * 8;
            Lw[ks][0] = *(const u32x4*)(Pc + 3072 + ko); Lw[ks][1] = *(const u32x4*)(Pp + 3072 + ko); La[ks][0] = *(const u32x4*)(Pc + 3136 + ko); La[ks][1] = *(const u32x4*)(Pp + 3136 + ko);
            Lg[ks][0] = *(const u32x4*)(Pc + 3232 + ko); Lg[ks][1] = *(const u32x4*)(Pp + 3232 + ko); }
        Lv[0] = *(const u32x4*)(Pc + 3200 + q * 8); Lv[1] = *(const u32x4*)(Pp + 3200 + q * 8);
        { const int srow = lane >> 3, ch8 = (lane & 7) * 8; const int t0 = tt * 16; u32x4 sv[6][2];
#pragma unroll
          for (int a6 = 0; a6 < 6; ++a6)
#pragma unroll
              for (int hf = 0; hf < 2; ++hf) { int tr = t0 + 8 * hf + srow - (a6 & 1); tr = tr < 0 ? 0 : tr;
                  sv[a6][hf] = *(const u32x4*)(P + (size_t)tr * NCAT + (a6 & 1) * HALFCAT + (a6 >> 1) * 1024 + h * 64 + ch8); }
#pragma unroll
          for (int a6 = 0; a6 < 6; ++a6)
#pragma unroll
              for (int hf = 0; hf < 2; ++hf) *(u32x4*)(stg + (a6 * 16 + 8 * hf + srow) * 64 + ch8) = sv[a6][hf];
          asm volatile("s_waitcnt lgkmcnt(0)" ::: "memory"); }
#pragma unroll
        for (int nt = 0; nt < 4; ++nt) { const int c0 = h * 64 + nt * 16 + 4 * q; const int cl4 = nt * 16 + 4 * q;
            Lr[nt][0] = *(const u32x2*)(stg + (0 * 16 + tok) * 64 + cl4); Lr[nt][1] = *(const u32x2*)(stg + (1 * 16 + tok) * 64 + cl4);
            Lk[nt][0] = *(const u32x2*)(stg + (2 * 16 + tok) * 64 + cl4); Lk[nt][1] = *(const u32x2*)(stg + (3 * 16 + tok) * 64 + cl4);
            Lvv[nt][0] = *(const u32x2*)(stg + (4 * 16 + tok) * 64 + cl4); Lvv[nt][1] = *(const u32x2*)(stg + (5 * 16 + tok) * 64 + cl4);
            Lvf[nt] = (u32x2){0u, 0u}; if (l) Lvf[nt] = *(const u32x2*)(oV0 + (size_t)t * D + c0); }
        asm volatile("s_waitcnt lgkmcnt(0)" ::: "memory");
        bf16x8 actW[2], actA[2], actG[2], actV;
#pragma unroll
        for (int ks = 0; ks < 2; ++ks) { float c[8], p[8], x[8];
            up8(Lw[ks][0], c); up8(Lw[ks][1], p);
#pragma unroll
            for (int j = 0; j < 8; ++j) x[j] = tanh_fast(rs_c * c[j] + rs_p * p[j]);
            actW[ks] = pack8(x);
            up8(La[ks][0], c); up8(La[ks][1], p);
#pragma unroll
            for (int j = 0; j < 8; ++j) x[j] = rs_c * c[j] + rs_p * p[j];
            actA[ks] = pack8(x);
            up8(Lg[ks][0], c); up8(Lg[ks][1], p);
#pragma unroll
            for (int j = 0; j < 8; ++j) x[j] = sigm(rs_c * c[j] + rs_p * p[j]);
            actG[ks] = pack8(x); }
        { float c[8], p[8], x[8]; up8(Lv[0], c); up8(Lv[1], p);
#pragma unroll
          for (int j = 0; j < 8; ++j) x[j] = rs_c * c[j] + rs_p * p[j];
          actV = pack8(x); }
        f32x4 Dw[4], Da[4], Dv[4], Dg[4];
#pragma unroll
        for (int nt = 0; nt < 4; ++nt) { const f32x4 z = {0.f, 0.f, 0.f, 0.f}; Dw[nt] = z; Da[nt] = z; Dv[nt] = z; Dg[nt] = z;
            const int wo = (nt * 16 + tok) * 72 + q * 8;
#pragma unroll
            for (int ks = 0; ks < 2; ++ks) {
                Dw[nt] = MFMA16(*(const bf16x8*)(wl + wo + ks * 32), actW[ks], Dw[nt]);
                Da[nt] = MFMA16(*(const bf16x8*)(wl + 64 * 72 + wo + ks * 32), actA[ks], Da[nt]);
                Dg[nt] = MFMA16(*(const bf16x8*)(wl + 3 * 64 * 72 + wo + ks * 32), actG[ks], Dg[nt]); }
            if (l) Dv[nt] = MFMA16(*(const bf16x8*)(wl + 2 * 64 * 72 + wo), actV, Dv[nt]);
            __builtin_amdgcn_sched_barrier(0); }
        float kkv[4][4], asg[4][4]; float ssq = 0.f;
#pragma unroll
        for (int nt = 0; nt < 4; ++nt) { const int c0 = h * 64 + nt * 16 + 4 * q; const size_t off = (size_t)t * D + c0;
            float rc[4], rp[4], kc[4], kp[4], vc[4], vp[4];
            up4(Lr[nt][0], rc); up4(Lr[nt][1], rp); up4(Lk[nt][0], kc); up4(Lk[nt][1], kp); up4(Lvv[nt][0], vc); up4(Lvv[nt][1], vp);
            const int cl = nt * 16 + 4 * q; const f32x4 w0v = *(const f32x4*)(pl + cl), a0v = *(const f32x4*)(pl + 64 + cl), kkw = *(const f32x4*)(pl + 192 + cl), kaw = *(const f32x4*)(pl + 256 + cl);
            float vf[4] = {0.f, 0.f, 0.f, 0.f}; f32x4 v0v = {0.f, 0.f, 0.f, 0.f};
            if (l) { up4(Lvf[nt], vf); v0v = *(const f32x4*)(pl + 128 + cl); }
            float ro[4], ldo[4], ko[4], vo[4], go[4];
#pragma unroll
            for (int e = 0; e < 4; ++e) {
                const float rr = rs_c * rc[e] + rs_p * rp[e], kx = rs_c * kc[e] + rs_p * kp[e]; float vx = rs_c * vc[e] + rs_p * vp[e];
                const float wl = w0v[e] + Dw[nt][e]; const float xx = -wl; const float sp = fmaxf(xx, 0.f) + __logf(1.f + __expf(-fabsf(xx)));
                ldo[e] = -__expf(-sp - 0.5f);
                const float as = sigm(a0v[e] + Da[nt][e]);
                if (l) vx = vx + (vf[e] - vx) * sigm(v0v[e] + Dv[nt][e]);
                const float kk = kx * kkw[e]; ssq += kk * kk; kkv[nt][e] = kk; asg[nt][e] = as;
                ro[e] = rr; ko[e] = kx * (1.f + (as - 1.f) * kaw[e]); vo[e] = vx; go[e] = Dg[nt][e]; }
            { const int so = tok * 64 + nt * 16 + 4 * q; (void)off;
              st4(stg + 0 * 1024 + so, ro[0], ro[1], ro[2], ro[3]); st4(stg + 1 * 1024 + so, ldo[0], ldo[1], ldo[2], ldo[3]); st4(stg + 2 * 1024 + so, ko[0], ko[1], ko[2], ko[3]);
              st4(stg + 3 * 1024 + so, vo[0], vo[1], vo[2], vo[3]); st4(stg + 4 * 1024 + so, go[0], go[1], go[2], go[3]); } }
        asm volatile("s_waitcnt lgkmcnt(0)" ::: "memory");
        { const int srow = lane >> 3, ch8 = (lane & 7) * 8;
#define F1_OUT(ptr, sl) do { _Pragma("unroll") for (int hf = 0; hf < 2; ++hf) *(u32x4*)((ptr) + (size_t)(tt * 16 + 8 * hf + srow) * D + h * 64 + ch8) = *(const u32x4*)(stg + (sl) * 1024 + (8 * hf + srow) * 64 + ch8); } while (0)
          F1_OUT(oR, 0); F1_OUT(oLD, 1); F1_OUT(oK, 2); F1_OUT(oV, 3); F1_OUT(oG, 4); }
        asm volatile("s_waitcnt lgkmcnt(0)" ::: "memory");
        ssq += __shfl_xor(ssq, 16); ssq += __shfl_xor(ssq, 32);
        const float inv = 1.f / fmaxf(sqrtf(ssq), 1e-12f);
#pragma unroll
        for (int nt = 0; nt < 4; ++nt) { const size_t off = (size_t)t * D + h * 64 + nt * 16 + 4 * q;
            float av[4], bv[4];
#pragma unroll
            for (int e = 0; e < 4; ++e) { const float kn = kkv[nt][e] * inv; av[e] = -kn; bv[e] = kn * asg[nt][e]; }
            { const int so = tok * 64 + nt * 16 + 4 * q; (void)off; st4(stg + so, av[0], av[1], av[2], av[3]); st4(stg + 1024 + so, bv[0], bv[1], bv[2], bv[3]); } }
        asm volatile("s_waitcnt lgkmcnt(0)" ::: "memory");
        { const int srow = lane >> 3, ch8 = (lane & 7) * 8; F1_OUT(oA, 0); F1_OUT(oB, 1); }
        asm volatile("s_waitcnt lgkmcnt(0)" ::: "memory");
    }
}

__device__ __forceinline__ void rseq_phase(const Args& a, int l, float* lds) {
    if (pg8::opq_bid() >= 16) return;
    unsigned char* ws = pg8::opq_ptr(a.ws); const int tid = pg8::opq_tid(), h = pg8::opq_bid();
    const bf16_t* base = (const bf16_t*)(ws + WS_MIX);
    float* Y = (float*)(ws + WS_BIG + BIG_Y);
    const int row = tid >> 2, cgp = tid & 3;
    float s[16];
#pragma unroll
    for (int j = 0; j < 16; ++j) s[j] = 0.f;
    for (int c0 = 0; c0 < T; c0 += 16) {
        __syncthreads();
#pragma unroll
        for (int i = 0; i < 12; ++i) { const int idx = tid + i * 512; const int arr = idx >> 10, rem = idx & 1023, st = rem >> 6, j = rem & 63;
            const int ga = arr == 5 ? (5 + l) : arr;
            float v = bf2f(base[(size_t)ga * T * D + (size_t)(c0 + st) * D + h * 64 + j]); if (arr == 1) v = __expf(v);
            lds[idx] = v; }
        __syncthreads();
        if (tid < 256) {
#pragma unroll 4
            for (int st = 0; st < 16; ++st) {
                const float* pR = lds + 0 * 1024 + st * 64 + cgp * 16; const float* pD = lds + 1 * 1024 + st * 64 + cgp * 16; const float* pK = lds + 2 * 1024 + st * 64 + cgp * 16;
                const float* pA = lds + 3 * 1024 + st * 64 + cgp * 16; const float* pB = lds + 4 * 1024 + st * 64 + cgp * 16;
                const float vv = lds[5 * 1024 + st * 64 + row];
                float sa = 0.f;
#pragma unroll
                for (int j = 0; j < 16; ++j) sa += s[j] * pA[j];
                sa += __shfl_xor(sa, 1); sa += __shfl_xor(sa, 2);
                float y = 0.f;
#pragma unroll
                for (int j = 0; j < 16; ++j) { s[j] = s[j] * pD[j] + sa * pB[j] + vv * pK[j]; y += s[j] * pR[j]; }
                y += __shfl_xor(y, 1); y += __shfl_xor(y, 2);
                if (cgp == 0) Y[(size_t)(c0 + st) * D + h * 64 + row] = y;
            }
        }
    }
}

__device__ __forceinline__ void f2_phase(const Args& a, int l) {
    unsigned char* ws = pg8::opq_ptr(a.ws); const int lane = pg8::opq_tid() & 63; const int gw = pg8::opq_bid() * 8 + (pg8::opq_tid() >> 6), NGW = gridDim.x * 8;
    const bf16_t* base = (const bf16_t*)(ws + WS_MIX); const float* Y = (const float*)(ws + WS_BIG + BIG_Y); bf16_t* YG = (bf16_t*)(ws + WS_BIG + BIG_YG);
    const bf16_t* pR = base; const bf16_t* pK = base + (size_t)2 * T * D; const bf16_t* pV = base + (size_t)(5 + l) * T * D; const bf16_t* pG = base + (size_t)7 * T * D;
    const float* lnw = a.in[21] + l * D; const float* lnb = a.in[22] + l * D; const float* rk = a.in[20] + l * D;
    const int c0 = lane * 16;
    for (int t = gw; t < T; t += NGW) { const size_t off = (size_t)t * D + c0;
        float y[16], r[16], k[16], v[16], g[16];
#pragma unroll
        for (int j = 0; j < 4; ++j) { const f32x4 yy = *(const f32x4*)(Y + off + j * 4); y[j * 4] = yy[0]; y[j * 4 + 1] = yy[1]; y[j * 4 + 2] = yy[2]; y[j * 4 + 3] = yy[3]; }
        { float tmp[8]; ld8(pR + off, tmp);
#pragma unroll
          for (int j = 0; j < 8; ++j) r[j] = tmp[j];
          ld8(pR + off + 8, tmp);
#pragma unroll
          for (int j = 0; j < 8; ++j) r[8 + j] = tmp[j];
          ld8(pK + off, tmp);
#pragma unroll
          for (int j = 0; j < 8; ++j) k[j] = tmp[j];
          ld8(pK + off + 8, tmp);
#pragma unroll
          for (int j = 0; j < 8; ++j) k[8 + j] = tmp[j];
          ld8(pV + off, tmp);
#pragma unroll
          for (int j = 0; j < 8; ++j) v[j] = tmp[j];
          ld8(pV + off + 8, tmp);
#pragma unroll
          for (int j = 0; j < 8; ++j) v[8 + j] = tmp[j];
          ld8(pG + off, tmp);
#pragma unroll
          for (int j = 0; j < 8; ++j) g[j] = tmp[j];
          ld8(pG + off + 8, tmp);
#pragma unroll
          for (int j = 0; j < 8; ++j) g[8 + j] = tmp[j]; }
        float sm = 0.f, bs = 0.f;
#pragma unroll
        for (int j = 0; j < 16; ++j) { sm += y[j]; bs += r[j] * k[j] * rk[c0 + j]; }
        sm += __shfl_xor(sm, 1); sm += __shfl_xor(sm, 2); bs += __shfl_xor(bs, 1); bs += __shfl_xor(bs, 2);
        const float mean = sm * (1.f / 64.f); float vr = 0.f;
#pragma unroll
        for (int j = 0; j < 16; ++j) { const float d = y[j] - mean; vr += d * d; }
        vr += __shfl_xor(vr, 1); vr += __shfl_xor(vr, 2);
        const float rstd = rsqrtf(vr * (1.f / 64.f) + 64e-5f);
        float o[16];
#pragma unroll
        for (int j = 0; j < 16; ++j) o[j] = ((y[j] - mean) * rstd * lnw[c0 + j] + lnb[c0 + j] + bs * v[j]) * g[j];
        u32x4 w0, w1; w0.x = cvt_pk_bf16(o[0], o[1]); w0.y = cvt_pk_bf16(o[2], o[3]); w0.z = cvt_pk_bf16(o[4], o[5]); w0.w = cvt_pk_bf16(o[6], o[7]);
        w1.x = cvt_pk_bf16(o[8], o[9]); w1.y = cvt_pk_bf16(o[10], o[11]); w1.z = cvt_pk_bf16(o[12], o[13]); w1.w = cvt_pk_bf16(o[14], o[15]);
        *(u32x4*)(YG + off) = w0; *(u32x4*)(YG + off + 8) = w1; }
}
constexpr size_t BIG_RH = 0, BIG_Y0 = (size_t)4096 * 8192, BIG_MM = BIG_Y0 + (size_t)4096 * 16384, BIG_NT = BIG_MM + (size_t)4096 * 8192;
static_assert(BIG_NT + (size_t)4096 * 16384 <= SZ_BIG, "big2");
__device__ __forceinline__ f32x4 ldbf4(const bf16_t* p) { const u32x2 w = *(const u32x2*)p; return (f32x4){bflo(w.x), bfhi(w.x), bflo(w.y), bfhi(w.y)}; }
__device__ __forceinline__ int nat_frag(int rtile, int ks, int lane) { return ((rtile * 2 + ks) * 64 + lane) * 8; }
__device__ __forceinline__ int nat_st4(int rtile, int lq, int c0) { return ((rtile * 2 + (c0 >> 5)) * 64 + ((c0 >> 3) & 3) * 16 + lq) * 8 + (c0 & 7); }
constexpr int R4_RHS = 0, R4_AAB = 34816, R4_PL = 51200, R4_SEG = 51456, R4_BF = 53504, R4_ASZ = 9216, R4_LD = 72, XLD = 68;
__device__ __forceinline__ bf16x8 ldsfrag(const bf16_t* arr, int row, int koff) { return *(const bf16x8*)(arr + row * R4_LD + koff); }
__device__ __forceinline__ void r4_phase(const Args& a, int l, unsigned char* lds) {
    unsigned char* ws = pg8::opq_ptr(a.ws); const int tid = pg8::opq_tid(), lane = tid & 63, w = tid >> 6, lq = lane & 15, q = lane >> 4;
    const bf16_t* base = (const bf16_t*)(ws + WS_MIX);
    float* RHS = (float*)(lds + R4_RHS); float* AAB = (float*)(lds + R4_AAB); float* PL = (float*)(lds + R4_PL); float* SEG = (float*)(lds + R4_SEG);
    bf16_t* Arow = (bf16_t*)(lds + R4_BF); bf16_t* Brow = Arow + R4_ASZ / 2; bf16_t* Krow = Brow + R4_ASZ / 2; bf16_t* Rrow = Krow + R4_ASZ / 2;
    bf16_t* BT = Rrow + R4_ASZ / 2; bf16_t* KT = BT + R4_ASZ / 2; bf16_t* VT = KT + R4_ASZ / 2; bf16_t* AAK = VT + R4_ASZ / 2; bf16_t* ARB = AAK + R4_ASZ / 2; bf16_t* ARK = ARB + R4_ASZ / 2;
    bf16_t* AhT = Arow; bf16_t* W1T = Krow;
    const int bid = pg8::opq_bid();
    u32x4 pre[6]; bf16_t* raw = (bf16_t*)lds;
#define R4_PREFETCH(uu) do { const int h_ = (uu) & 15, c_ = (uu) >> 4; _Pragma("unroll") for (int k_ = 0; k_ < 6; ++k_) { const int idx_ = tid + 512 * k_; const int arr_ = idx_ >> 9, t_ = (idx_ >> 3) & 63, j8_ = (idx_ & 7) * 8; \
        pre[k_] = *(const u32x4*)(base + (size_t)(arr_ == 5 ? 5 + l : arr_) * T * D + (size_t)(c_ * 64 + t_) * D + h_ * 64 + j8_); } } while (0)
    for (int u = bid; u < 4096; u += gridDim.x) {
        const int h = u & 15, c = u >> 4;
        R4_PREFETCH(u);
        __syncthreads();
#pragma unroll
        for (int k_ = 0; k_ < 6; ++k_) { const int idx_ = tid + 512 * k_; *(u32x4*)(raw + (size_t)idx_ * 8) = pre[k_]; }
        __syncthreads();
#ifndef NO_S1
        { const int j = lane, seg = w; const size_t g0 = (size_t)(c * 64 + seg * 8) * D + h * 64 + j;
          float r[8], ld[8], k[8], v[8], aa[8], bb[8];
#pragma unroll
          for (int i = 0; i < 8; ++i) { const int o = (seg * 8 + i) * 64 + j; r[i] = bf2f(raw[o]); ld[i] = bf2f(raw[4096 + o]); k[i] = bf2f(raw[2 * 4096 + o]);
              aa[i] = bf2f(raw[3 * 4096 + o]); bb[i] = bf2f(raw[4 * 4096 + o]); v[i] = bf2f(raw[5 * 4096 + o]); }
          (void)g0;
          float cum[8]; float run = 0.f;
#pragma unroll
          for (int i = 0; i < 8; ++i) { run += ld[i]; cum[i] = run; }
          SEG[seg * 64 + j] = run;
          __syncthreads();
          float off = 0.f;
#pragma unroll
          for (int s = 0; s < 8; ++s) off += (s < seg) ? SEG[s * 64 + j] : 0.f;
          float at[8], rt[8], bt[8], kt[8];
#pragma unroll
          for (int i = 0; i < 8; ++i) { const float cm = cum[i] + off; const float ep = __expf(cm), em = __expf(-cm), epp = __expf(cm - ld[i]);
              at[i] = aa[i] * epp; rt[i] = r[i] * ep; bt[i] = bb[i] * em; kt[i] = k[i] * em;
              const int t = seg * 8 + i;
              Arow[t * R4_LD + j] = (bf16_t)(cvt_pk_bf16(at[i], 0.f) & 0xffffu); Brow[t * R4_LD + j] = (bf16_t)(cvt_pk_bf16(bt[i], 0.f) & 0xffffu);
              Krow[t * R4_LD + j] = (bf16_t)(cvt_pk_bf16(kt[i], 0.f) & 0xffffu); Rrow[t * R4_LD + j] = (bf16_t)(cvt_pk_bf16(rt[i], 0.f) & 0xffffu);
              if (i == 7 && seg == 7) PL[j] = ep; }
          *(f32x4*)(RHS + j * XLD + seg * 8) = (f32x4){at[0], at[1], at[2], at[3]}; *(f32x4*)(RHS + j * XLD + seg * 8 + 4) = (f32x4){at[4], at[5], at[6], at[7]};
          *(bf16x8*)(BT + j * R4_LD + seg * 8) = pack8(bt); *(bf16x8*)(KT + j * R4_LD + seg * 8) = pack8(kt); *(bf16x8*)(VT + j * R4_LD + seg * 8) = pack8(v); }
#endif
        __syncthreads();
        { const int tt = w >> 1; const int t = 16 * tt + lq;
          bf16x8 fa[2], fr[2];
#pragma unroll
          for (int ks = 0; ks < 2; ++ks) { fa[ks] = ldsfrag(Arow, t, ks * 32 + 8 * q); fr[ks] = ldsfrag(Rrow, t, ks * 32 + 8 * q); }
#pragma unroll
          for (int k2 = 0; k2 < 2; ++k2) { const int st = 2 * (w & 1) + k2; const int s0 = 16 * st + 4 * q;
              f32x4 dab = {0.f, 0.f, 0.f, 0.f}, dak = dab, drb = dab, drk = dab;
              if (st <= tt) {
#pragma unroll
                  for (int ks = 0; ks < 2; ++ks) { const bf16x8 fb = ldsfrag(Brow, 16 * st + lq, ks * 32 + 8 * q), fk = ldsfrag(Krow, 16 * st + lq, ks * 32 + 8 * q);
                      dab = MFMA16(fb, fa[ks], dab); dak = MFMA16(fk, fa[ks], dak); drb = MFMA16(fb, fr[ks], drb); drk = MFMA16(fk, fr[ks], drk); } }
#pragma unroll
              for (int e = 0; e < 4; ++e) { const int s = s0 + e; if (!(s < t)) { dab[e] = 0.f; dak[e] = 0.f; } if (!(s <= t)) { drb[e] = 0.f; drk[e] = 0.f; } }
              *(f32x4*)(AAB + t * 64 + s0) = dab;
              st4(AAK + t * R4_LD + s0, dak[0], dak[1], dak[2], dak[3]); st4(ARB + t * R4_LD + s0, drb[0], drb[1], drb[2], drb[3]); st4(ARK + t * R4_LD + s0, drk[0], drk[1], drk[2], drk[3]); } }
        __syncthreads();
        { bf16_t* AOFF = Brow; const int t = tid >> 3, s8 = (tid & 7) * 8; const f32x4 a0 = *(const f32x4*)(AAB + t * 64 + s8), a1 = *(const f32x4*)(AAB + t * 64 + s8 + 4);
          const bool keep = (s8 >> 4) < (t >> 4); const float o[8] = {keep ? a0[0] : 0.f, keep ? a0[1] : 0.f, keep ? a0[2] : 0.f, keep ? a0[3] : 0.f, keep ? a1[0] : 0.f, keep ? a1[1] : 0.f, keep ? a1[2] : 0.f, keep ? a1[3] : 0.f};
          *(bf16x8*)(AOFF + t * R4_LD + s8) = pack8(o); }
        { const int tt = w >> 1; const int t = 16 * tt + lq;
          bf16x8 fb[2];
#pragma unroll
          for (int ks = 0; ks < 2; ++ks) fb[ks] = ldsfrag(AAK, t, ks * 32 + 8 * q);
#pragma unroll
          for (int k2 = 0; k2 < 2; ++k2) { const int it = 2 * (w & 1) + k2; f32x4 d = {0.f, 0.f, 0.f, 0.f};
#pragma unroll
              for (int ks = 0; ks < 2; ++ks) d = MFMA16(ldsfrag(VT, 16 * it + lq, ks * 32 + 8 * q), fb[ks], d);
#pragma unroll
              for (int e = 0; e < 4; ++e) RHS[(64 + 16 * it + 4 * q + e) * XLD + t] = d[e]; } }
        __syncthreads();
        { bf16_t* AOFF = Brow;
#pragma unroll
          for (int b = 0; b < 4; ++b) {
              if (b > 0) { const bf16_t* xt = (w < 4 ? AhT : W1T); const int crow = 16 * (w & 3) + lq; f32x4 d = {0.f, 0.f, 0.f, 0.f};
#pragma unroll
                  for (int ks = 0; ks < (b + 1) / 2; ++ks) d = MFMA16(ldsfrag(xt, crow, ks * 32 + 8 * q), ldsfrag(AOFF, 16 * b + lq, ks * 32 + 8 * q), d);
                  const int t = 16 * b + lq; const int c0 = 16 * w + 4 * q;
#pragma unroll
                  for (int e = 0; e < 4; ++e) RHS[(c0 + e) * XLD + t] += d[e];
                  __syncthreads(); }
              if (tid < 128) { float* xr = RHS + tid * XLD + 16 * b; float x[16];
#pragma unroll
                  for (int k = 0; k < 4; ++k) { const f32x4 v = *(const f32x4*)(xr + 4 * k); x[4 * k] = v[0]; x[4 * k + 1] = v[1]; x[4 * k + 2] = v[2]; x[4 * k + 3] = v[3]; }
#pragma unroll
                  for (int t = 1; t < 16; ++t) { const float* ar = AAB + (16 * b + t) * 64 + 16 * b; float acc = x[t];
#pragma unroll
                      for (int k = 0; k < (t + 3) / 4; ++k) { const f32x4 av = *(const f32x4*)(ar + 4 * k);
#pragma unroll
                          for (int e = 0; e < 4; ++e) if (4 * k + e < t) acc += av[e] * x[4 * k + e]; }
                      x[t] = acc; }
#pragma unroll
                  for (int k = 0; k < 4; ++k) *(f32x4*)(xr + 4 * k) = (f32x4){x[4 * k], x[4 * k + 1], x[4 * k + 2], x[4 * k + 3]};
                  bf16_t* dst = (tid < 64 ? AhT : W1T) + (tid & 63) * R4_LD + 16 * b;
                  { const float o0[8] = {x[0], x[1], x[2], x[3], x[4], x[5], x[6], x[7]}; const float o1[8] = {x[8], x[9], x[10], x[11], x[12], x[13], x[14], x[15]};
                    *(bf16x8*)dst = pack8(o0); *(bf16x8*)(dst + 8) = pack8(o1); } }
              if (b < 3) __syncthreads();
          } }
        __syncthreads();
#ifndef NO_S5
        { const int rt_ = w >> 1; const int row = 16 * rt_ + lq;
          unsigned char* bigb = ws + WS_BIG;
          bf16_t* gRH = (bf16_t*)(bigb + BIG_RH) + (size_t)u * 4096; float* gY0 = (float*)((bf16_t*)(bigb + BIG_Y0) + (size_t)u * 4096);
          bf16_t* gMM = (bf16_t*)(bigb + BIG_MM) + (size_t)(h * 256 + c) * 4096; float* gNT = (float*)((bf16_t*)(bigb + BIG_NT) + (size_t)(h * 256 + c) * 4096);
          bf16x8 f_arb[2], f_ark[2], f_bt[2], f_w1[2], f_vt[2];
#pragma unroll
          for (int ks = 0; ks < 2; ++ks) { const int ko = ks * 32 + 8 * q; f_arb[ks] = ldsfrag(ARB, row, ko); f_ark[ks] = ldsfrag(ARK, row, ko); f_bt[ks] = ldsfrag(BT, row, ko); f_w1[ks] = ldsfrag(W1T, row, ko); f_vt[ks] = ldsfrag(VT, row, ko); }
          const float plrow = PL[row];
#pragma unroll
          for (int k2 = 0; k2 < 2; ++k2) { const int ct = 2 * (w & 1) + k2; const int c0 = 16 * ct + 4 * q;
              f32x4 drh = {0.f, 0.f, 0.f, 0.f}, dy0 = drh, dmm = drh, dnt = drh;
#pragma unroll
              for (int ks = 0; ks < 2; ++ks) { const int ko = ks * 32 + 8 * q;
                  const bf16x8 c_ah = ldsfrag(AhT, 16 * ct + lq, ko), c_w1 = ldsfrag(W1T, 16 * ct + lq, ko), c_vt = ldsfrag(VT, 16 * ct + lq, ko), c_bt = ldsfrag(BT, 16 * ct + lq, ko), c_kt = ldsfrag(KT, 16 * ct + lq, ko);
                  drh = MFMA16(c_ah, f_arb[ks], drh);
                  dy0 = MFMA16(c_w1, f_arb[ks], dy0); dy0 = MFMA16(c_vt, f_ark[ks], dy0);
                  dmm = MFMA16(c_ah, f_bt[ks], dmm);
                  dnt = MFMA16(c_bt, f_w1[ks], dnt); dnt = MFMA16(c_kt, f_vt[ks], dnt); }
              float rr[4]; ld4(Rrow + row * R4_LD + c0, rr);
              st4(gRH + nat_st4(rt_, lq, c0), drh[0] + rr[0], drh[1] + rr[1], drh[2] + rr[2], drh[3] + rr[3]);
              st4((bf16_t*)gY0 + ((rt_ * 4 + ct) * 64 + lane) * 4, dy0[0], dy0[1], dy0[2], dy0[3]);
#pragma unroll
              for (int e = 0; e < 4; ++e) { dmm[e] = plrow * (dmm[e] + ((c0 + e) == row ? 1.f : 0.f)); dnt[e] *= PL[c0 + e]; }
              st4(gMM + nat_st4(rt_, lq, c0), dmm[0], dmm[1], dmm[2], dmm[3]);
              st4((bf16_t*)gNT + ((rt_ * 4 + ct) * 64 + lane) * 4, dnt[0], dnt[1], dnt[2], dnt[3]); } }
#endif
    }
}
__device__ __forceinline__ void r5_phase(const Args& a, unsigned char* lds) {
    const int bid = pg8::opq_bid(); if (bid >= 64) return;
    unsigned char* ws = pg8::opq_ptr(a.ws); const int tid = pg8::opq_tid(), lane = tid & 63, w = tid >> 6, lq = lane & 15, q = lane >> 4; const int h = bid & 15, iq = bid >> 4;
    const bf16_t* gMM = (const bf16_t*)(ws + WS_BIG + BIG_MM); const float* gNT = (const float*)(ws + WS_BIG + BIG_NT);
    bf16_t* SC = (bf16_t*)(ws + WS_MIX + (size_t)1 * SZ_TD2);
    bf16_t* Sb = (bf16_t*)lds;
    for (int i = tid; i < 2 * 16 * R4_LD / 2; i += 512) ((unsigned*)Sb)[i] = 0u;
    for (int i = tid; i < 512; i += 512) ((unsigned*)(SC + (size_t)h * 4096 + iq * 1024))[i] = 0u;
    __syncthreads();
    if (w >= 4) {
        for (int c = 0; c < 256; ++c) { asm volatile("s_waitcnt lgkmcnt(0)" ::: "memory"); __builtin_amdgcn_s_barrier(); asm volatile("" ::: "memory"); }
        return; }
    const int jt = w; const int irow = 16 * iq + lq;
    bf16x8 Mr[8][2]; f32x4 Nr[8];
#pragma unroll
    for (int k = 0; k < 8; ++k) { const size_t ub = (size_t)(h * 256 + k) * 4096;
#pragma unroll
        for (int ks = 0; ks < 2; ++ks) Mr[k][ks] = *(const bf16x8*)(gMM + ub + nat_frag(jt, ks, lane));
        Nr[k] = ldbf4((const bf16_t*)gNT + ub + ((iq * 4 + jt) * 64 + lane) * 4); }
    for (int c0 = 0; c0 < 256; c0 += 8) {
#pragma unroll
        for (int k = 0; k < 8; ++k) { const int c = c0 + k;
            const bf16_t* Sc_ = Sb + (k & 1) * 16 * R4_LD; bf16_t* Sn_ = Sb + ((k & 1) ^ 1) * 16 * R4_LD;
            bf16_t* scn = SC + (size_t)((c + 1) * 16 + h) * 4096;
            f32x4 d = Nr[k];
#pragma unroll
            for (int ks = 0; ks < 2; ++ks) d = MFMA16(Mr[k][ks], ldsfrag(Sc_, lq, ks * 32 + 8 * q), d);
            st4(Sn_ + lq * R4_LD + 16 * jt + 4 * q, d[0], d[1], d[2], d[3]);
            if (c < 255) st4(scn + nat_st4(iq, lq, 16 * jt + 4 * q), d[0], d[1], d[2], d[3]);
            { const int cn = (c + 8 < 256) ? c + 8 : 255; const size_t ub = (size_t)(h * 256 + cn) * 4096;
#pragma unroll
              for (int ks = 0; ks < 2; ++ks) Mr[k][ks] = *(const bf16x8*)(gMM + ub + nat_frag(jt, ks, lane));
              Nr[k] = ldbf4((const bf16_t*)gNT + ub + ((iq * 4 + jt) * 64 + lane) * 4); }
            asm volatile("s_waitcnt lgkmcnt(0)" ::: "memory"); __builtin_amdgcn_s_barrier(); asm volatile("" ::: "memory");
        }
    }
}
__device__ __forceinline__ void r6_phase(const Args& a, int l) {
    unsigned char* ws = pg8::opq_ptr(a.ws); const int tid = pg8::opq_tid(), lane = tid & 63, lq = lane & 15, q = lane >> 4; const int gw = pg8::opq_bid() * 8 + (tid >> 6), NGW = gridDim.x * 8;
    const bf16_t* gRH = (const bf16_t*)(ws + WS_BIG + BIG_RH); const float* gY0 = (const float*)(ws + WS_BIG + BIG_Y0); const bf16_t* SC = (const bf16_t*)(ws + WS_MIX + (size_t)1 * SZ_TD2);
    const bf16_t* base = (const bf16_t*)(ws + WS_MIX); const bf16_t* pR = base; const bf16_t* pK = base + (size_t)2 * T * D; const bf16_t* pV = base + (size_t)(5 + l) * T * D; const bf16_t* pG = base + (size_t)7 * T * D;
    bf16_t* YG = (bf16_t*)(ws + WS_MIX + (size_t)3 * SZ_TD2);
    const float* lnw = a.in[21] + l * D; const float* lnb = a.in[22] + l * D; const float* rk = a.in[20] + l * D;
    for (int item = gw; item < 16384; item += NGW) { const int tt = item & 3, u = item >> 2; const int h = u & 15, c = u >> 4; const int t = c * 64 + tt * 16 + lq;
        const size_t ub = (size_t)u * 4096;
        bf16x8 fr[2];
#pragma unroll
        for (int ks = 0; ks < 2; ++ks) fr[ks] = *(const bf16x8*)(gRH + ub + nat_frag(tt, ks, lane));
        f32x4 y[4]; bf16x8 fs[4][2]; u32x2 Lr[4], Lk[4], Lv[4], Lg[4];
#pragma unroll
        for (int it = 0; it < 4; ++it) { y[it] = ldbf4((const bf16_t*)gY0 + ub + ((tt * 4 + it) * 64 + lane) * 4);
#pragma unroll
            for (int ks = 0; ks < 2; ++ks) fs[it][ks] = *(const bf16x8*)(SC + ub + nat_frag(it, ks, lane));
            const size_t off = (size_t)t * D + h * 64 + 16 * it + 4 * q; Lr[it] = *(const u32x2*)(pR + off); Lk[it] = *(const u32x2*)(pK + off); Lv[it] = *(const u32x2*)(pV + off); Lg[it] = *(const u32x2*)(pG + off); }
#pragma unroll
        for (int it = 0; it < 4; ++it)
#pragma unroll
            for (int ks = 0; ks < 2; ++ks) y[it] = MFMA16(fs[it][ks], fr[ks], y[it]);
        float sm = 0.f, bs = 0.f; float vv[4][4], gg[4][4];
#pragma unroll
        for (int it = 0; it < 4; ++it) { const int c0 = h * 64 + 16 * it + 4 * q; float r4[4], k4[4];
            up4(Lr[it], r4); up4(Lk[it], k4); up4(Lv[it], vv[it]); up4(Lg[it], gg[it]); const f32x4 rkv = *(const f32x4*)(rk + c0);
#pragma unroll
            for (int e = 0; e < 4; ++e) { sm += y[it][e]; bs += r4[e] * k4[e] * rkv[e]; } }
        sm += __shfl_xor(sm, 16); sm += __shfl_xor(sm, 32); bs += __shfl_xor(bs, 16); bs += __shfl_xor(bs, 32);
        const float mean = sm * (1.f / 64.f); float vr = 0.f;
#pragma unroll
        for (int it = 0; it < 4; ++it)
#pragma unroll
            for (int e = 0; e < 4; ++e) { const float dd = y[it][e] - mean; vr += dd * dd; }
        vr += __shfl_xor(vr, 16); vr += __shfl_xor(vr, 32);
        const float rstd = rsqrtf(vr * (1.f / 64.f) + 64e-5f);
#pragma unroll
        for (int it = 0; it < 4; ++it) { const int c0 = h * 64 + 16 * it + 4 * q; const f32x4 lw = *(const f32x4*)(lnw + c0), lb = *(const f32x4*)(lnb + c0); float o[4];
#pragma unroll
            for (int e = 0; e < 4; ++e) o[e] = ((y[it][e] - mean) * rstd * lw[e] + lb[e] + bs * vv[it][e]) * gg[it][e];
            st4(YG + (size_t)t * D + c0, o[0], o[1], o[2], o[3]); }
    }
}
constexpr int VT_LD = 136;
__device__ __forceinline__ int vt_addr(int dim, int kp) { return dim * VT_LD + (dim >> 4) * 8 + kp; }
constexpr int KL_LD = 72;
struct AttRegs { u32x4 k[4], v0a, v0b, v1a, v1b; bf16x8 q[2]; };
__device__ __forceinline__ void att_decode(int u, int& g, int& h, int& d, int& rsd, int& n) { g = u >> 11; const int rem = u & 2047; h = rem >> 7; const int rr = rem & 127; const int sh = 2 * g; d = 1 << sh; rsd = rr & (d - 1); n = rr >> sh; }
__device__ __forceinline__ void att_load(const bf16_t* Q, const bf16_t* KV, int u, int tid, AttRegs& R) {
    int g, h, d, rsd, n; att_decode(u, g, h, d, rsd, n); const int hc = g * 1024 + h * 64; const int lane = tid & 63, w = tid >> 6, lq = lane & 15, qp = lane >> 4;
    const int sh = 2 * g; const size_t plane = ((size_t)(g * 16 + h) * T + (size_t)rsd * (T >> sh)) * 64; (void)hc;
    { const int key = tid >> 1, half = tid & 1; int mk = 128 * (n - 1) + key; mk = mk < 0 ? 0 : mk; const bf16_t* p = KV + plane + (size_t)mk * 64 + half * 32;
#pragma unroll
      for (int i = 0; i < 4; ++i) R.k[i] = *(const u32x4*)(p + 8 * i); }
    { const int kp = tid >> 2, dg = tid & 3; const u32x4 z = {0u, 0u, 0u, 0u}; R.v0a = z; R.v0b = z; R.v1a = z; R.v1b = z; const int m0 = 128 * (n - 1) + 2 * kp;
      if (m0 >= 0) { const bf16_t* p0 = KV + (size_t)48 * T * 64 + plane + (size_t)m0 * 64 + dg * 16; const bf16_t* p1 = p0 + 64;
          R.v0a = *(const u32x4*)p0; R.v0b = *(const u32x4*)(p0 + 8); R.v1a = *(const u32x4*)p1; R.v1b = *(const u32x4*)(p1 + 8); } }
    { const int qi = 16 * w + lq; const int tq = (128 * n + qi) * d + rsd;
#pragma unroll
      for (int ks = 0; ks < 2; ++ks) R.q[ks] = *(const bf16x8*)(Q + plane + (size_t)(128 * n + qi) * 64 + ks * 32 + qp * 8); (void)tq; }
}
__device__ __forceinline__ void attn_phase(const Args& a, unsigned* vt) {
    unsigned char* ws = pg8::opq_ptr(a.ws); const int tid = pg8::opq_tid(), lane = tid & 63, w = tid >> 6, lq = lane & 15, qp = lane >> 4;
    const bf16_t* Q = (const bf16_t*)(ws + WS_BIG + BIG_Q); const bf16_t* KV = (const bf16_t*)(ws + WS_MIX);
    bf16_t* OG = (bf16_t*)(ws + WS_BIG + BIG_OG); float* LSE = (float*)(ws + WS_BIG + BIG_LSE);
    bf16_t* kl = (bf16_t*)(vt + 9216);
    const int G = gridDim.x; int u = pg8::opq_bid();
    AttRegs R, R2; if (u < 6144) { att_load(Q, KV, u, tid, R); att_load(Q, KV, (u + G < 6144) ? u + G : u, tid, R2); }
    for (; u < 6144; u += G) {
        int g, h, d, rsd, n; att_decode(u, g, h, d, rsd, n);
        asm volatile("s_waitcnt lgkmcnt(0)" ::: "memory"); __builtin_amdgcn_s_barrier(); asm volatile("" ::: "memory");
        { const int key = tid >> 1, half = tid & 1;
#pragma unroll
          for (int i = 0; i < 4; ++i) *(u32x4*)(kl + key * KL_LD + half * 32 + 8 * i) = R.k[i]; }
        { const int kp = tid >> 2, dg = tid & 3;
          const unsigned e0[8] = {R.v0a.x, R.v0a.y, R.v0a.z, R.v0a.w, R.v0b.x, R.v0b.y, R.v0b.z, R.v0b.w}; const unsigned e1[8] = {R.v1a.x, R.v1a.y, R.v1a.z, R.v1a.w, R.v1b.x, R.v1b.y, R.v1b.z, R.v1b.w};
#pragma unroll
          for (int j = 0; j < 8; ++j) { const int dim = dg * 16 + 2 * j;
              vt[vt_addr(dim, kp)] = (e0[j] & 0xffffu) | (e1[j] << 16);
              vt[vt_addr(dim + 1, kp)] = (e0[j] >> 16) | (e1[j] & 0xffff0000u); } }
        bf16x8 bq[2]; bq[0] = R.q[0]; bq[1] = R.q[1];
        asm volatile("s_waitcnt lgkmcnt(0)" ::: "memory"); __builtin_amdgcn_s_barrier(); asm volatile("" ::: "memory");
        R = R2; { const int un = (u + 2 * G < 6144) ? u + 2 * G : u; att_load(Q, KV, un, tid, R2); }
        const int qi = 16 * w + lq; const int tq = (128 * n + qi) * d + rsd;
        const int kt0 = 2 * (w >> 1);
        f32x4 sc[10];
#pragma unroll
        for (int kl_ = 0; kl_ < 10; ++kl_) { const int krow = 16 * (kt0 + kl_) + lq; f32x4 acc = {0.f, 0.f, 0.f, 0.f};
            acc = MFMA16(*(const bf16x8*)(kl + krow * KL_LD + qp * 8), bq[0], acc); acc = MFMA16(*(const bf16x8*)(kl + krow * KL_LD + 32 + qp * 8), bq[1], acc); sc[kl_] = acc; }
        float mx = -3.0e38f;
#pragma unroll
        for (int kl_ = 0; kl_ < 10; ++kl_)
#pragma unroll
            for (int e = 0; e < 4; ++e) { const int kj = 16 * (kt0 + kl_) + 4 * qp + e; const bool valid = (kj >= qi) && (kj <= qi + 128) && (n > 0 || kj >= 128);
                const float sv = valid ? sc[kl_][e] : -1e30f; sc[kl_][e] = sv; mx = fmaxf(mx, sv); }
        mx = fmaxf(mx, __shfl_xor(mx, 16)); mx = fmaxf(mx, __shfl_xor(mx, 32));
        float lsum = 0.f;
#pragma unroll
        for (int kl_ = 0; kl_ < 10; ++kl_)
#pragma unroll
            for (int e = 0; e < 4; ++e) { const float p = __expf(sc[kl_][e] - mx); sc[kl_][e] = p; lsum += p; }
        lsum += __shfl_xor(lsum, 16); lsum += __shfl_xor(lsum, 32);
        f32x4 oacc[4];
#pragma unroll
        for (int dt = 0; dt < 4; ++dt) oacc[dt] = (f32x4){0.f, 0.f, 0.f, 0.f};
#pragma unroll
        for (int sl = 0; sl < 5; ++sl) { u32x4 pw; pw.x = cvt_pk_bf16(sc[2 * sl][0], sc[2 * sl][1]); pw.y = cvt_pk_bf16(sc[2 * sl][2], sc[2 * sl][3]);
            pw.z = cvt_pk_bf16(sc[2 * sl + 1][0], sc[2 * sl + 1][1]); pw.w = cvt_pk_bf16(sc[2 * sl + 1][2], sc[2 * sl + 1][3]);
            const bf16x8 bp = __builtin_bit_cast(bf16x8, pw); const int kpb = 16 * ((kt0 >> 1) + sl) + 2 * qp;
#pragma unroll
            for (int dt = 0; dt < 4; ++dt) { const int dim = dt * 16 + lq; const u32x2 lo = *(const u32x2*)(vt + vt_addr(dim, kpb)); const u32x2 hi = *(const u32x2*)(vt + vt_addr(dim, kpb + 8));
                u32x4 aw; aw.x = lo.x; aw.y = lo.y; aw.z = hi.x; aw.w = hi.y;
                oacc[dt] = MFMA16(__builtin_bit_cast(bf16x8, aw), bp, oacc[dt]); } }
        const float il = 1.f / lsum;
        bf16_t* op = OG + (size_t)g * T * D + (size_t)tq * D + h * 64 + 4 * qp;
#pragma unroll
        for (int dt = 0; dt < 4; ++dt) st4(op + dt * 16, oacc[dt][0] * il, oacc[dt][1] * il, oacc[dt][2] * il, oacc[dt][3] * il);
        if (qp == 0) LSE[(size_t)g * T * 16 + (size_t)tq * 16 + h] = mx + __logf(lsum);
    }
}
__device__ __forceinline__ void comb_phase(const Args& a) {
    unsigned char* ws = pg8::opq_ptr(a.ws); const int lane = pg8::opq_tid() & 63; const int gw = pg8::opq_bid() * 8 + (pg8::opq_tid() >> 6), NGW = gridDim.x * 8;
    const bf16_t* OG = (const bf16_t*)(ws + WS_BIG + BIG_OG); const float* LSE = (const float*)(ws + WS_BIG + BIG_LSE); bf16_t* O = (bf16_t*)(ws + WS_MIX + (size_t)T * KVW * 2);
    const int c0 = lane * 16, h = lane >> 2;
    for (int t = gw; t < T; t += NGW) {
        const float l0 = LSE[(size_t)t * 16 + h], l1 = LSE[(size_t)T * 16 + (size_t)t * 16 + h], l2 = LSE[(size_t)2 * T * 16 + (size_t)t * 16 + h];
        const float mx = fmaxf(l0, fmaxf(l1, l2)); float e0 = __expf(l0 - mx), e1 = __expf(l1 - mx), e2 = __expf(l2 - mx); const float is = 1.f / (e0 + e1 + e2); e0 *= is; e1 *= is; e2 *= is;
        float o[16];
#pragma unroll
        for (int hf = 0; hf < 2; ++hf) { float x0[8], x1[8], x2[8]; const size_t off = (size_t)t * D + c0 + hf * 8;
            ld8(OG + off, x0); ld8(OG + (size_t)T * D + off, x1); ld8(OG + (size_t)2 * T * D + off, x2);
#pragma unroll
            for (int j = 0; j < 8; ++j) o[hf * 8 + j] = e0 * x0[j] + e1 * x1[j] + e2 * x2[j]; }
        u32x4 w0, w1; w0.x = cvt_pk_bf16(o[0], o[1]); w0.y = cvt_pk_bf16(o[2], o[3]); w0.z = cvt_pk_bf16(o[4], o[5]); w0.w = cvt_pk_bf16(o[6], o[7]);
        w1.x = cvt_pk_bf16(o[8], o[9]); w1.y = cvt_pk_bf16(o[10], o[11]); w1.z = cvt_pk_bf16(o[12], o[13]); w1.w = cvt_pk_bf16(o[14], o[15]);
        *(u32x4*)(O + (size_t)t * D + c0) = w0; *(u32x4*)(O + (size_t)t * D + c0 + 8) = w1; }
}
__global__ void __launch_bounds__(512, 2) mega(Args a) {
    extern __shared__ __attribute__((aligned(16))) unsigned char lds[];
    { volatile LAS unsigned* stw = (volatile LAS unsigned*)((LAS unsigned char*)lds + (LDS_BYTES - 64)); if (threadIdx.x < 2) stw[threadIdx.x] = 0u; }
    __syncthreads();
    { cg::grid_group grid = cg::this_grid(); if (a.ph_hi < 0) grid.sync(); }
    XcdBarrier bar = xcd_barrier_post((unsigned*)(a.ws + WS_BAR), (volatile LAS unsigned*)((LAS unsigned char*)lds + (LDS_BYTES - 64)));
    for (int s = a.ph_lo; s < a.ph_hi; ++s) {
        if (s > a.ph_lo) xcd_barrier(bar);
        unsigned char* ws = pg8::opq_ptr(a.ws); PG8_LAS unsigned char* glds = (PG8_LAS unsigned char*)lds; float* ssb = (float*)(ws + WS_SS); bf16_t* XB = (bf16_t*)(ws + WS_XB); const int bid = pg8::opq_bid();
        int type, l = 0, j = 0;
        if (s == 0) type = 0; else if (s == 21) type = 8;
        else { int o; if (s <= 10) { l = 0; o = s - 1; } else if (s <= 20) { l = 1; o = s - 11; } else if (s <= 29) { l = 2; o = s - 22; } else { l = 3; o = s - 30; }
            if (l < 2) { if (o < 2) type = 1 + o; else if (o < 6) type = o + 1; else if (o == 6) type = 13; else if (o == 7) type = 7; else { type = o - 7; j = 1; } }
            else { if (o < 2) type = 1 + o; else if (o < 6) type = o + 7; else { type = o - 5; j = 1; } } }
#ifndef DUP_MASK
#define DUP_MASK 0
#endif
        for (int rep = 0; rep < (((DUP_MASK >> type) & 1) ? 2 : 1); ++rep) {
#define FILL_RTAB(S_, ssp_) do { PG8_LAS float* rt_ = (PG8_LAS float*)(glds + 131072); for (int i_ = 0; i_ < 8; ++i_) { pg8::Unit u_; if (!(S_).next(i_, u_)) break; \
            if (threadIdx.x < 256) rt_[i_ * 256 + threadIdx.x] = row_rs((ssp_), u_.pm * 256 + (int)threadIdx.x); } __syncthreads(); } while (0)
        if (type == 0) { p0_phase(a, (float*)lds); }
        else if (type == 1) { pg8::Gemm g{XB, (const bf16_t*)(ws + WS_WIN + (size_t)(l * 2 + j) * SZ_WIN), T, 2 * FF, D}; pg8::StaticOrder S; S.init(T, 2 * FF, gridDim.x, bid);
            EpiSwiglu E{(bf16_t*)(ws + WS_BIG), ssb + (size_t)(3 * l + (j ? 2 : 0)) * T * 16, (const PG8_LAS float*)(glds + 131072)}; FILL_RTAB(S, E.ss);
            pg8::gemm_phase<EpiSwiglu, pg8::StaticOrder, true, true>(glds, g, S, E); }
        else if (type == 2 || type == 7 || type == 12) {
            pg8::Gemm g; EpiResid E; E.xnew = a.out; E.xb = XB; E.xold = a.out;
            if (type == 2) { g = pg8::Gemm{(const bf16_t*)(ws + WS_BIG), (const bf16_t*)(ws + WS_WOUT + (size_t)(l * 2 + j) * SZ_WOUT), T, D, FF}; E.alpha = 0.5f; E.ssn = ssb + (size_t)(3 * l + (j ? 3 : 1)) * T * 16; if (l == 0 && j == 0) E.xold = a.in[0]; }
            else if (type == 7) { g = pg8::Gemm{(const bf16_t*)(ws + WS_MIX + (size_t)3 * SZ_TD2), (const bf16_t*)(ws + WS_WOR + (size_t)l * SZ_SQ), T, D, D}; E.alpha = 1.f; E.ssn = ssb + (size_t)(3 * l + 2) * T * 16; }
            else { g = pg8::Gemm{(const bf16_t*)(ws + WS_MIX + (size_t)T * KVW * 2), (const bf16_t*)(ws + WS_WOA + (size_t)(l - 2) * SZ_SQ), T, D, D}; E.alpha = 1.f; E.ssn = ssb + (size_t)(3 * l + 2) * T * 16; }
            pg8::StaticOrder S; S.init(T, D, gridDim.x, bid);
            pg8::gemm_phase<EpiResid, pg8::StaticOrder, true, true>(glds, g, S, E); }
        else if (type == 3) { pg8::Gemm g{XB, (const bf16_t*)(ws + WS_WCAT + (size_t)l * SZ_WCAT), T, NCAT, D}; pg8::StaticOrder S; S.init(T, NCAT, gridDim.x, bid);
            EpiPlain E{(bf16_t*)(ws + WS_BIG), NCAT};
            pg8::gemm_phase<EpiPlain, pg8::StaticOrder, true, true>(glds, g, S, E); }
        else if (type == 4) f1_phase(a, l, lds);
        else if (type == 5) r4_phase(a, l, lds);
        else if (type == 6) { if (bid >= 64 && gridDim.x > 64) p0_convert(a, (float*)lds, l + 1, bid - 64, gridDim.x - 64); else r5_phase(a, lds); }
        else if (type == 13) r6_phase(a, l);
        else if (type == 8 || type == 9) {
            pg8::Gemm g; EpiHeadNorm E; E.nnorm = 48;
            if (type == 8) { g = pg8::Gemm{XB, (const bf16_t*)(ws + WS_WKV), T, KVW, D}; E.O = (bf16_t*)(ws + WS_MIX); E.ldc = KVW; E.ss = ssb + (size_t)6 * T * 16; E.gain = a.in[26]; E.scale = 1.f; }
            else { g = pg8::Gemm{XB, (const bf16_t*)(ws + WS_WQ + (size_t)(l - 2) * SZ_WQ), T, QW, D}; E.O = (bf16_t*)(ws + WS_BIG + BIG_Q); E.ldc = QW; E.ss = ssb + (size_t)(3 * l + 1) * T * 16; E.gain = a.in[28] + (l - 2) * 192; E.scale = 0.125f; }
            pg8::StaticOrder S; S.init(T, g.N, gridDim.x, bid); E.rtab = (const PG8_LAS float*)(glds + 131072); FILL_RTAB(S, E.ss);
            pg8::gemm_phase<EpiHeadNorm, pg8::StaticOrder, true, true>(glds, g, S, E); }
        else if (type == 10) attn_phase(a, (unsigned*)lds);
        else if (type == 11) comb_phase(a);
        }
    }
}

extern "C" void kernel_launch(void* const* d_in, const int* in_sizes, int n_in, void* d_out, int out_size, void* d_ws, size_t ws_size, hipStream_t stream) {
    static int grid = 0;
    if (grid == 0) {
        if (n_in != 30 || out_size != T * D || ws_size < WS_END) { fprintf(stderr, "kernel_launch: unexpected shapes: n_in %d out %d ws %zu (need %zu)\n", n_in, out_size, ws_size, (size_t)WS_END); grid = -1; return; }
        int dev = 0, cus = 0, per_cu = 0;
        (void)hipGetDevice(&dev); (void)hipDeviceGetAttribute(&cus, hipDeviceAttributeMultiprocessorCount, dev);
        if (hipFuncSetAttribute((const void*)mega, hipFuncAttributeMaxDynamicSharedMemorySize, LDS_BYTES) != hipSuccess) { fprintf(stderr, "kernel_launch: hipFuncSetAttribute failed\n"); grid = -1; return; }
        if (hipOccupancyMaxActiveBlocksPerMultiprocessor(&per_cu, (const void*)mega, 512, LDS_BYTES) != hipSuccess || per_cu < 1) { fprintf(stderr, "kernel_launch: occupancy query says %d\n", per_cu); per_cu = 1; }
        (void)hipGetLastError();
        grid = cus * 1;
        if (grid <= 0) grid = 256;
    }
    if (grid < 0) return;
    if (hipMemsetAsync((char*)d_ws + WS_BAR, 0, XCD_BAR_WORDS * 4, stream) != hipSuccess) { fprintf(stderr, "kernel_launch: memset failed\n"); return; }
    Args a{};
    for (int i = 0; i < 30; ++i) a.in[i] = (const float*)d_in[i];
    a.out = (float*)d_out; a.ws = (unsigned char*)d_ws;
#if ONE_LAUNCH
    a.ph_lo = 0; a.ph_hi = NSTEPS;
    void* args[] = {&a};
    hipError_t e = hipLaunchCooperativeKernel((const void*)mega, dim3(grid), dim3(512), args, LDS_BYTES, stream);
    if (e != hipSuccess) fprintf(stderr, "cooperative launch failed: %s (grid %d)\n", hipGetErrorString(e), grid);
#else
    for (int s = 0; s < NSTEPS; ++s) { a.ph_lo = s; a.ph_hi = s + 1; hipLaunchKernelGGL(mega, dim3(grid), dim3(512), LDS_BYTES, stream, a); }
#endif
}
```

```cpp
#include <hip/hip_runtime.h>
#include <hip/hip_cooperative_groups.h>
#include <cstdio>
#include <cstdint>
namespace cg = cooperative_groups;
namespace pg8 {
#define PG8_LAS __attribute__((address_space(3)))
typedef unsigned short bf16_t;
typedef short bf16x8 __attribute__((ext_vector_type(8)));
typedef float f32x4 __attribute__((ext_vector_type(4)));
typedef unsigned u32x4 __attribute__((ext_vector_type(4)));
__device__ __forceinline__ int opq_tid() { int t = threadIdx.x; asm volatile("" : "+v"(t)); return t; }
__device__ __forceinline__ int opq_bid() { int t = blockIdx.x; asm volatile("" : "+s"(t)); return t; }
__device__ __forceinline__ unsigned char* opq_ptr(unsigned char* q) { size_t off = 0; asm volatile("" : "+s"(off)); return q + off; }
constexpr int BM = 256, BK = 64, HALF = 128, HTB = HALF * BK * 2  , STAGE_BYTES = 8 * HTB, NXCD = 8, WGM = 8;

__host__ __device__ __forceinline__ int lds_byte(int r, int c) { const int st = (r >> 4) * 2 + (c >> 5), rr = r & 15, cc = c & 31, ob = rr * 64 + cc * 2; return st * 1024 + (ob ^ (((ob >> 9) & 1) << 5)); }
__host__ __device__ __forceinline__ void stage_rc(int b, int& R, int& C) { const int st = b / 1024, sb = b % 1024, swz = sb ^ (((sb >> 9) & 1) << 5); R = (st >> 1) * 16 + swz / 64; C = (st & 1) * 32 + (swz % 64) / 2; }
__host__ __device__ __forceinline__ int perm32(int rho) { const int n = rho >> 4, i = rho & 15; return 8 * (i >> 2) + 4 * n + (i & 3); }

struct Unit { int pm, pn, ord; };
struct Gemm { const bf16_t* A; const bf16_t* Bt; int M, N, K; };

struct StaticOrder {
    int nM, nN, nwg, G, c;
    __host__ __device__ void init(int M, int N, int G_, int c_) { nM = M / BM; nN = N / BM; nwg = nM * nN; G = G_; c = c_; }
    __host__ __device__ __forceinline__ bool next(int i, Unit& u) const {
        const long L = (long)i * G + c; if (L >= nwg) return false;
        int wgid = (int)L; { const int q = nwg / NXCD, r = nwg % NXCD, xcd = wgid % NXCD, off = wgid / NXCD; wgid = (xcd < r ? xcd * (q + 1) : r * (q + 1) + (xcd - r) * q) + off; }
        const int nig = WGM * nN, gid = wgid / nig, fm = gid * WGM, gsz = (nM - fm) < WGM ? (nM - fm) : WGM;
        u.pm = fm + ((wgid % nig) % gsz); u.pn = (wgid % nig) / gsz; u.ord = i; return true;
    }
    __device__ __forceinline__ void a_ready(const Unit&) const {}
    __device__ __forceinline__ void done(const Unit&) const {}
};

typedef __bf16 bf16x2v_ __attribute__((ext_vector_type(2))); typedef float f32x2v_ __attribute__((ext_vector_type(2)));
__device__ __forceinline__ unsigned cvt_pk_bf16(float lo, float hi) { const f32x2v_ v = {lo, hi}; const bf16x2v_ b = __builtin_convertvector(v, bf16x2v_); return __builtin_bit_cast(unsigned, b); }
typedef float f32x2 __attribute__((ext_vector_type(2)));
template <class Epi, class Sched, bool ALIGN_EPI = false, bool SP2 = false>
__device__ __forceinline__ void gemm_phase(PG8_LAS unsigned char* lds, const Gemm g, const Sched& S, const Epi& E) {
    const int tid = opq_tid(), wid = __builtin_amdgcn_readfirstlane(tid >> 6), lane = tid & 63, wr = wid >> 2, wc = wid & 3, fr = lane & 15, fq = lane >> 4;
    const int K = g.K, nt = K / BK;
    unsigned voffA[2], voffB[2];
#pragma unroll
    for (int i = 0; i < 2; ++i) { int R, C; stage_rc(tid * 16 + i * 8192, R, C); const int Rb = Epi::PERM ? ((R & ~31) + perm32(R & 31)) : R;
        voffA[i] = (unsigned)(R * K + C) * 2u; voffB[i] = (unsigned)(Rb * K + C) * 2u; }
    const size_t kstep = (size_t)(BK * 2);
    const size_t hstep = (size_t)HALF * K * 2;
    const size_t tstep = 2 * hstep;
    const unsigned ldsw = (unsigned)wid * 1024u;
    const int aoff = lds_byte(wr * 64 + fr, fq * 8), boff = lds_byte(wc * 32 + fr, fq * 8);
#define PG8_SA(b, h) (((b) * 2 + (h)) * HTB)
#define PG8_SB(b, h) ((4 + (b) * 2 + (h)) * HTB)
#define PG8_STAGE(bufoff, gbase, voff) do { _Pragma("unroll") for (int _i = 0; _i < 2; ++_i) \
        __builtin_amdgcn_global_load_lds((const unsigned*)((const char*)(gbase) + (voff)[_i]), (PG8_LAS unsigned*)(lds + (bufoff) + ldsw + _i * 8192), 16, 0, 0); } while (0)
#define PG8_LDA(dst, b, h) do { _Pragma("unroll") for (int m = 0; m < 4; ++m) _Pragma("unroll") for (int k = 0; k < 2; ++k) dst[m][k] = *(const PG8_LAS bf16x8*)(lds + PG8_SA(b, h) + aoff + m * 2048 + k * 1024); } while (0)
#define PG8_LDB(dst, b, h) do { _Pragma("unroll") for (int n = 0; n < 2; ++n) _Pragma("unroll") for (int k = 0; k < 2; ++k) dst[n][k] = *(const PG8_LAS bf16x8*)(lds + PG8_SB(b, h) + boff + n * 2048 + k * 1024); } while (0)
#define PG8_MMA(ai, bj, At, Bt) do { __builtin_amdgcn_s_setprio(1); _Pragma("unroll") for (int m = 0; m < 4; ++m) _Pragma("unroll") for (int n = 0; n < 2; ++n) _Pragma("unroll") for (int k = 0; k < 2; ++k) \
        acc[ai][bj][m][n] = __builtin_amdgcn_mfma_f32_16x16x32_bf16(Bt[n][k], At[m][k], acc[ai][bj][m][n], 0, 0, 0); __builtin_amdgcn_s_setprio(0); } while (0)
#define PG8_WAIT_V(n) asm volatile("s_waitcnt vmcnt(" #n ")" ::: "memory")
#define PG8_WAIT_L(n) asm volatile("s_waitcnt lgkmcnt(" #n ")" ::: "memory")
#define PG8_BAR __builtin_amdgcn_s_barrier()
#define PG8_SCHED __builtin_amdgcn_sched_barrier(0)
    Unit cur, nxt; int ui = 0;
    if (!S.next(0, cur)) return;
    f32x4 acc[2][2][4][2];
#pragma unroll
    for (int a = 0; a < 2; ++a)
#pragma unroll
        for (int b = 0; b < 2; ++b)
#pragma unroll
            for (int m = 0; m < 4; ++m)
#pragma unroll
                for (int n = 0; n < 2; ++n) acc[a][b][m][n] = (f32x4){0.f, 0.f, 0.f, 0.f};
    bf16x8 At[4][2], B0[2][2], B1[2][2];
    const char* cA = (const char*)g.A + (size_t)cur.pm * tstep; const char* cB = (const char*)g.Bt + (size_t)cur.pn * tstep;
    S.a_ready(cur);
    if constexpr (SP2) {
        PG8_STAGE(PG8_SB(0, 0), cB, voffB); PG8_STAGE(PG8_SB(0, 1), cB + hstep, voffB); PG8_STAGE(PG8_SA(0, 0), cA, voffA); PG8_STAGE(PG8_SA(0, 1), cA + hstep, voffA);
        if (wr == 1) PG8_BAR;
        PG8_WAIT_V(2); PG8_BAR;
        PG8_STAGE(PG8_SB(1, 0), cB + kstep, voffB); PG8_STAGE(PG8_SA(1, 0), cA + kstep, voffA); PG8_STAGE(PG8_SB(1, 1), cB + hstep + kstep, voffB);
        PG8_WAIT_V(6); PG8_BAR;
    } else {
        PG8_STAGE(PG8_SB(0, 0), cB, voffB); PG8_STAGE(PG8_SA(0, 0), cA, voffA); PG8_STAGE(PG8_SB(0, 1), cB + hstep, voffB); PG8_STAGE(PG8_SA(0, 1), cA + hstep, voffA);
        if (wr == 1) PG8_BAR;
        PG8_WAIT_V(4); PG8_BAR;
        PG8_STAGE(PG8_SB(1, 0), cB + kstep, voffB); PG8_STAGE(PG8_SA(1, 0), cA + kstep, voffA); PG8_STAGE(PG8_SB(1, 1), cB + hstep + kstep, voffB);
        PG8_WAIT_V(6); PG8_BAR;
    }
    for (;;) {
        const bool has_next = S.next(ui + 1, nxt);
        const char* nA = has_next ? (const char*)g.A + (size_t)nxt.pm * tstep : cA; const char* nB = has_next ? (const char*)g.Bt + (size_t)nxt.pn * tstep : cB;
        for (int t = 0; t < nt; t += 2) {
            const bool last = (t == nt - 2);
            const char* a1 = cA + (size_t)(t + 1) * kstep;
            const char* a2 = last ? nA : cA + (size_t)(t + 2) * kstep; const char* b2 = last ? nB : cB + (size_t)(t + 2) * kstep;
            const char* a3 = a2 + kstep; const char* b3 = b2 + kstep;
            if (last && has_next) S.a_ready(nxt);
            if constexpr (SP2) {
            PG8_LDB(B0, 0, 0); PG8_LDB(B1, 0, 1); PG8_SCHED; PG8_LDA(At, 0, 0); PG8_STAGE(PG8_SA(1, 1), a1 + hstep, voffA);
            PG8_WAIT_V(8); PG8_WAIT_L(0); PG8_BAR; PG8_MMA(0, 0, At, B0); PG8_MMA(0, 1, At, B1); PG8_BAR; PG8_SCHED;
            PG8_LDA(At, 0, 1); PG8_STAGE(PG8_SB(0, 0), b2, voffB); PG8_STAGE(PG8_SB(0, 1), b2 + hstep, voffB); PG8_STAGE(PG8_SA(0, 0), a2, voffA);
            PG8_WAIT_V(8); PG8_WAIT_L(0); PG8_BAR; PG8_MMA(1, 0, At, B0); PG8_MMA(1, 1, At, B1); PG8_BAR; PG8_SCHED;
            PG8_LDB(B0, 1, 0); PG8_LDB(B1, 1, 1); PG8_SCHED; PG8_LDA(At, 1, 0); PG8_STAGE(PG8_SA(0, 1), a2 + hstep, voffA);
            PG8_WAIT_V(8); PG8_WAIT_L(0); PG8_BAR; PG8_MMA(0, 0, At, B0); PG8_MMA(0, 1, At, B1); PG8_BAR; PG8_SCHED;
            PG8_LDA(At, 1, 1); PG8_STAGE(PG8_SB(1, 0), b3, voffB); PG8_STAGE(PG8_SB(1, 1), b3 + hstep, voffB); PG8_STAGE(PG8_SA(1, 0), a3, voffA);
            PG8_WAIT_V(8); PG8_WAIT_L(0); PG8_BAR; PG8_MMA(1, 0, At, B0); PG8_MMA(1, 1, At, B1); PG8_BAR; PG8_SCHED;
            } else {
            PG8_LDB(B0, 0, 0); PG8_SCHED; PG8_LDA(At, 0, 0); PG8_STAGE(PG8_SA(1, 1), a1 + hstep, voffA);
            PG8_WAIT_L(8); PG8_BAR; PG8_WAIT_L(0); PG8_MMA(0, 0, At, B0); PG8_BAR; PG8_SCHED;
            PG8_LDB(B1, 0, 1); PG8_STAGE(PG8_SB(0, 0), b2, voffB);
            PG8_BAR; PG8_WAIT_L(0); PG8_MMA(0, 1, At, B1); PG8_BAR;
            PG8_LDA(At, 0, 1); PG8_STAGE(PG8_SA(0, 0), a2, voffA);
            PG8_BAR; PG8_WAIT_L(0); PG8_MMA(1, 0, At, B0); PG8_BAR; PG8_SCHED;
            PG8_STAGE(PG8_SB(0, 1), b2 + hstep, voffB);
            PG8_WAIT_V(6); PG8_BAR; PG8_MMA(1, 1, At, B1); PG8_BAR;
            PG8_LDB(B0, 1, 0); PG8_SCHED; PG8_LDA(At, 1, 0); PG8_STAGE(PG8_SA(0, 1), a2 + hstep, voffA);
            PG8_WAIT_L(8); PG8_BAR; PG8_WAIT_L(0); PG8_MMA(0, 0, At, B0); PG8_BAR; PG8_SCHED;
            PG8_LDB(B1, 1, 1); PG8_STAGE(PG8_SB(1, 0), b3, voffB);
            PG8_BAR; PG8_WAIT_L(0); PG8_MMA(0, 1, At, B1); PG8_BAR;
            PG8_LDA(At, 1, 1); PG8_STAGE(PG8_SA(1, 0), a3, voffA);
            PG8_BAR; PG8_WAIT_L(0); PG8_MMA(1, 0, At, B0); PG8_BAR; PG8_SCHED;
            PG8_STAGE(PG8_SB(1, 1), b3 + hstep, voffB);
            PG8_WAIT_V(6); PG8_BAR; PG8_MMA(1, 1, At, B1); PG8_BAR;
            }
        }
        if constexpr (ALIGN_EPI) { if (wr == 0) PG8_BAR; }
        if constexpr (!Epi::AFTER_DRAIN) { E(acc, cur, wr, wc, fr, fq); S.done(cur); }
        if (!has_next) break;
#pragma unroll
        for (int a = 0; a < 2; ++a)
#pragma unroll
            for (int b = 0; b < 2; ++b)
#pragma unroll
                for (int m = 0; m < 4; ++m)
#pragma unroll
                    for (int n = 0; n < 2; ++n) acc[a][b][m][n] = (f32x4){0.f, 0.f, 0.f, 0.f};
        cur = nxt; cA = nA; cB = nB; ++ui;
        if constexpr (ALIGN_EPI) { if (wr == 1) PG8_BAR; }
    }
    PG8_WAIT_V(0);
    if constexpr (!ALIGN_EPI) { if (wr == 0) PG8_BAR; }
    PG8_BAR;
    if constexpr (Epi::AFTER_DRAIN) { E.fused(acc, cur, wr, wc, fr, fq, lds, wid, lane); S.done(cur); }
#undef PG8_SA
#undef PG8_SB
#undef PG8_STAGE
#undef PG8_LDA
#undef PG8_LDB
#undef PG8_MMA
#undef PG8_WAIT_V
#undef PG8_WAIT_L
#undef PG8_BAR
#undef PG8_SCHED
}
}

#ifndef ONE_LAUNCH
#define ONE_LAUNCH 1
#endif
using pg8::bf16_t; using pg8::bf16x8; using pg8::f32x4; using pg8::u32x4; using pg8::Unit; using pg8::cvt_pk_bf16;
typedef unsigned u32x2 __attribute__((ext_vector_type(2)));
typedef unsigned short u16x4 __attribute__((ext_vector_type(4)));

constexpr int T = 16384, D = 1024, FF = 2816, NCAT = 6656, HALFCAT = 3328, QW = 3072, KVW = 6144;
constexpr float RMS_EPS = 1e-6f;
constexpr int LDS_BYTES = 147456;
constexpr int NSTEPS = 38;

constexpr size_t WS_BAR = 0;
constexpr size_t WS_WIN = 1u << 20;
constexpr size_t SZ_WIN = (size_t)5632 * 1024 * 2;
constexpr size_t WS_WOUT = WS_WIN + 8 * SZ_WIN;
constexpr size_t SZ_WOUT = (size_t)1024 * 2816 * 2;
constexpr size_t WS_WCAT = WS_WOUT + 8 * SZ_WOUT;
constexpr size_t SZ_WCAT = (size_t)NCAT * 1024 * 2;
constexpr size_t WS_WOR = WS_WCAT + 2 * SZ_WCAT;
constexpr size_t SZ_SQ = (size_t)1024 * 1024 * 2;
constexpr size_t WS_WUP = WS_WOR + 2 * SZ_SQ;
constexpr size_t SZ_UP = (size_t)1024 * 64 * 2;
constexpr size_t WS_WKV = WS_WUP + 8 * SZ_UP;
constexpr size_t WS_WQ = WS_WKV + (size_t)KVW * 1024 * 2;
constexpr size_t SZ_WQ = (size_t)QW * 1024 * 2;
constexpr size_t WS_WOA = WS_WQ + 2 * SZ_WQ;
constexpr size_t WS_XB = WS_WOA + 2 * SZ_SQ;
constexpr size_t SZ_TD2 = (size_t)T * 1024 * 2;
constexpr size_t WS_BIG = WS_XB + SZ_TD2;
constexpr size_t SZ_BIG = (size_t)T * NCAT * 2;
constexpr size_t WS_MIX = WS_BIG + SZ_BIG;
constexpr size_t WS_SS = WS_MIX + 8 * SZ_TD2;
constexpr size_t SZ_SS = (size_t)T * 16 * 4;
constexpr size_t WS_END = WS_SS + 13 * SZ_SS;
constexpr size_t BIG_Y = 0, BIG_YG = (size_t)T * 1024 * 4;
constexpr size_t BIG_Q = 0, BIG_OG = (size_t)T * QW * 2, BIG_LSE = BIG_OG + 3 * SZ_TD2;
static_assert(BIG_LSE + (size_t)3 * T * 16 * 4 <= SZ_BIG, "big");

struct Args { const float* in[30]; float* out; unsigned char* ws; int ph_lo, ph_hi; };

__device__ __forceinline__ float bf2f(unsigned short v) { return __uint_as_float((unsigned)v << 16); }
__device__ __forceinline__ float bflo(unsigned v) { return __uint_as_float(v << 16); }
__device__ __forceinline__ float bfhi(unsigned v) { return __uint_as_float(v & 0xffff0000u); }
__device__ __forceinline__ float row_rs(const float* ssp, int row) { const f32x4* q = (const f32x4*)(ssp + (size_t)row * 16); const f32x4 a = q[0], b = q[1], c = q[2], d = q[3];
    const float s = ((a[0] + a[1]) + (a[2] + a[3])) + ((b[0] + b[1]) + (b[2] + b[3])) + (((c[0] + c[1]) + (c[2] + c[3])) + ((d[0] + d[1]) + (d[2] + d[3]))); return rsqrtf(s * (1.f / 1024.f) + RMS_EPS); }
__device__ __forceinline__ float sigm(float x) { return __builtin_amdgcn_rcpf(1.f + __expf(-x)); }
__device__ __forceinline__ float tanh_fast(float x) { const float e = __expf(2.f * x); return 1.f - 2.f * __builtin_amdgcn_rcpf(e + 1.f); }
#define LAS __attribute__((address_space(3)))
#define XB_TMO      128
#define XB_XCNT(j)  (256  + 64 * (j))
#define XB_XSUB(j)  (1280 + 64 * (j))
#define XB_XGEN(j)  (2304 + 64 * (j))
#define XB_TOP      3328
#define XB_TOPGEN   3392
#define XCD_BAR_WORDS 3456
#define XB_SPIN_CAP (1u << 18)

__device__ __forceinline__ unsigned xb_ld(unsigned* p)              { return __hip_atomic_load(p, __ATOMIC_RELAXED, __HIP_MEMORY_SCOPE_AGENT); }
__device__ __forceinline__ unsigned xb_add(unsigned* p, unsigned v) { return __hip_atomic_fetch_add(p, v, __ATOMIC_RELAXED, __HIP_MEMORY_SCOPE_AGENT); }
__device__ __forceinline__ unsigned xb_xcc_id() { return (unsigned)__builtin_amdgcn_s_getreg((3 << 11) | 20) & 0xFu; }
#define XB_SPIN(cond, bar) do { unsigned _sp = 0; while (cond) { __builtin_amdgcn_s_sleep(1); \
    if ((++_sp & 255u) == 0u) { if (xb_ld(&(bar)[XB_TMO])) break; if (_sp > XB_SPIN_CAP) { atomicAdd(&(bar)[XB_TMO], 1u); break; } } } } while (0)

struct XcdBarrier {
    unsigned* bar; unsigned x;
    volatile LAS unsigned* st;
};

__device__ __forceinline__ XcdBarrier xcd_barrier_post(unsigned* bar, volatile LAS unsigned* st) {
    XcdBarrier b; b.bar = bar; b.x = xb_xcc_id(); b.st = st;
    if (threadIdx.x == 0) (void)xb_add(&bar[XB_XCNT(b.x)], 1u);
    return b;
}
__device__ __forceinline__ void xcd_barrier_complete(unsigned* bar, unsigned x, unsigned& nloc, unsigned& nx) {
    const unsigned G = gridDim.x * gridDim.y * gridDim.z;
    unsigned sum, cnt, mine, sp = 0u;
    for (;;) {
        sum = 0u; cnt = 0u; mine = 0u;
#pragma unroll
        for (unsigned j = 0; j < 16; ++j) { const unsigned c = xb_ld(&bar[XB_XCNT(j)]); sum += c; cnt += (c > 0u) ? 1u : 0u; mine = (j == x) ? c : mine; }
        if (sum == G) break;
        __builtin_amdgcn_s_sleep(1);
        if ((++sp & 255u) == 0u) { if (xb_ld(&bar[XB_TMO])) break; if (sp > XB_SPIN_CAP) { atomicAdd(&bar[XB_TMO], 1u); break; } }
    }
    nloc = mine > 0u ? mine : 1u; nx = cnt > 0u ? cnt : 1u;
}

__device__ __forceinline__ void xcd_barrier(const XcdBarrier& b) {
    asm volatile("s_waitcnt vmcnt(0)" ::: "memory");
    __syncthreads();
    if (threadIdx.x == 0) {
        unsigned* bar = b.bar;
        __builtin_amdgcn_s_waitcnt(0);
        unsigned nloc = b.st[0], nx = b.st[1];
        if (nloc == 0u) { xcd_barrier_complete(bar, b.x, nloc, nx); b.st[0] = nloc; b.st[1] = nx; }
        const unsigned old = xb_add(&bar[XB_XSUB(b.x)], 1u);
        const unsigned gen = old / nloc;
        if (old + 1u == (gen + 1u) * nloc) {
            __builtin_amdgcn_fence(__ATOMIC_RELEASE, "agent");
            asm volatile("s_waitcnt vmcnt(0)" ::: "memory");
            const unsigned og = xb_add(&bar[XB_TOP], 1u);
            const unsigned tg = og / nx;
            if (og + 1u == (tg + 1u) * nx) xb_add(&bar[XB_TOPGEN], 1u);
            else XB_SPIN(xb_ld(&bar[XB_TOPGEN]) == tg, bar);
            __builtin_amdgcn_fence(__ATOMIC_ACQUIRE, "agent");
            xb_add(&bar[XB_XGEN(b.x)], 1u);
            asm volatile("s_waitcnt vmcnt(0)" ::: "memory");
        } else {
            XB_SPIN(xb_ld(&bar[XB_XGEN(b.x)]) == gen, bar);
            __builtin_amdgcn_fence(__ATOMIC_ACQUIRE, "agent");
            asm volatile("s_waitcnt vmcnt(0)" ::: "memory");
        }
    }
    __syncthreads();
}
struct EpiPlain {
    static constexpr bool PERM = true, AFTER_DRAIN = false;
    bf16_t* O; int ldc;
    __device__ __forceinline__ void operator()(const f32x4 (&acc)[2][2][4][2], const Unit& u, int wr, int wc, int fr, int fq) const {
        const int row0 = u.pm * 256 + wr * 64 + fr, col0 = u.pn * 256 + wc * 32 + 8 * fq;
#pragma unroll
        for (int ai = 0; ai < 2; ++ai)
#pragma unroll
            for (int m = 0; m < 4; ++m) { bf16_t* rowp = O + (size_t)(row0 + ai * 128 + m * 16) * ldc + col0;
#pragma unroll
                for (int bj = 0; bj < 2; ++bj) { const f32x4 v0 = acc[ai][bj][m][0], v1 = acc[ai][bj][m][1]; u32x4 w;
                    w.x = cvt_pk_bf16(v0[0], v0[1]); w.y = cvt_pk_bf16(v0[2], v0[3]); w.z = cvt_pk_bf16(v1[0], v1[1]); w.w = cvt_pk_bf16(v1[2], v1[3]);
                    *(u32x4*)(rowp + bj * 128) = w; } }
    }
};
struct EpiSwiglu {
    static constexpr bool PERM = true, AFTER_DRAIN = false;
    bf16_t* O; const float* ss; const PG8_LAS float* rtab;
    __device__ __forceinline__ void operator()(const f32x4 (&acc)[2][2][4][2], const Unit& u, int wr, int wc, int fr, int fq) const {
        const int row0 = u.pm * 256 + wr * 64 + fr, col0 = u.pn * 128 + wc * 32 + 8 * fq; const PG8_LAS float* rt = rtab + u.ord * 256 + wr * 64 + fr;
#pragma unroll
        for (int ai = 0; ai < 2; ++ai)
#pragma unroll
            for (int m = 0; m < 4; ++m) { const int row = row0 + ai * 128 + m * 16; const float rs = rt[ai * 128 + m * 16];
                float o[8];
#pragma unroll
                for (int n = 0; n < 2; ++n)
#pragma unroll
                    for (int e = 0; e < 4; ++e) { const float g = acc[ai][0][m][n][e] * rs, up = acc[ai][1][m][n][e] * rs; o[n * 4 + e] = g * sigm(g) * up; }
                u32x4 w; w.x = cvt_pk_bf16(o[0], o[1]); w.y = cvt_pk_bf16(o[2], o[3]); w.z = cvt_pk_bf16(o[4], o[5]); w.w = cvt_pk_bf16(o[6], o[7]);
                *(u32x4*)(O + (size_t)row * FF + col0) = w; }
    }
};
struct EpiResid {
    static constexpr bool PERM = true, AFTER_DRAIN = false;
    const float* xold; float* xnew; bf16_t* xb; float* ssn; float alpha;
    __device__ __forceinline__ void operator()(const f32x4 (&acc)[2][2][4][2], const Unit& u, int wr, int wc, int fr, int fq) const {
        const int row0 = u.pm * 256 + wr * 64 + fr, col0 = u.pn * 256 + wc * 32 + 8 * fq;
#pragma unroll
        for (int ai = 0; ai < 2; ++ai)
#pragma unroll
          for (int mh = 0; mh < 2; ++mh) {
            f32x4 xo[2][2][2];
#pragma unroll
            for (int m2 = 0; m2 < 2; ++m2)
#pragma unroll
                for (int bj = 0; bj < 2; ++bj) { const size_t off = (size_t)(row0 + ai * 128 + (mh * 2 + m2) * 16) * D + col0 + bj * 128; xo[m2][bj][0] = *(const f32x4*)(xold + off); xo[m2][bj][1] = *(const f32x4*)(xold + off + 4); }
#pragma unroll
            for (int m2 = 0; m2 < 2; ++m2) { const int m = mh * 2 + m2; const int row = row0 + ai * 128 + m * 16; float s = 0.f;
#pragma unroll
                for (int bj = 0; bj < 2; ++bj) { const size_t off = (size_t)row * D + col0 + bj * 128;
                    const f32x4 xn0 = xo[m2][bj][0] + acc[ai][bj][m][0] * alpha, xn1 = xo[m2][bj][1] + acc[ai][bj][m][1] * alpha;
                    *(f32x4*)(xnew + off) = xn0; *(f32x4*)(xnew + off + 4) = xn1;
                    s += ((xn0[0] * xn0[0] + xn0[1] * xn0[1]) + (xn0[2] * xn0[2] + xn0[3] * xn0[3])) + ((xn1[0] * xn1[0] + xn1[1] * xn1[1]) + (xn1[2] * xn1[2] + xn1[3] * xn1[3]));
                    u32x4 w; w.x = cvt_pk_bf16(xn0[0], xn0[1]); w.y = cvt_pk_bf16(xn0[2], xn0[3]); w.z = cvt_pk_bf16(xn1[0], xn1[1]); w.w = cvt_pk_bf16(xn1[2], xn1[3]); *(u32x4*)(xb + off) = w; }
                s += __shfl_xor(s, 16); s += __shfl_xor(s, 32);
                if (fq == 0) ssn[(size_t)row * 16 + u.pn * 4 + wc] = s; } }
    }
};
struct EpiHeadNorm {
    static constexpr bool PERM = true, AFTER_DRAIN = false;
    bf16_t* O; int ldc; const float* ss; const float* gain; int nnorm; float scale; const PG8_LAS float* rtab;
    __device__ __forceinline__ void operator()(const f32x4 (&acc)[2][2][4][2], const Unit& u, int wr, int wc, int fr, int fq) const {
        const int row0 = u.pm * 256 + wr * 64 + fr; const int head = u.pn * 4 + wc; const bool normed = head < nnorm; const int g = (head >> 4) % 3;
        float gn[2][8];
#pragma unroll
        for (int bj = 0; bj < 2; ++bj)
#pragma unroll
            for (int j = 0; j < 8; ++j) gn[bj][j] = normed ? gain[g * 64 + bj * 32 + 8 * fq + j] * scale : 1.f;
#pragma unroll
        for (int ai = 0; ai < 2; ++ai)
#pragma unroll
            for (int m = 0; m < 4; ++m) { const int row = row0 + ai * 128 + m * 16; const float rs = rtab[u.ord * 256 + wr * 64 + fr + ai * 128 + m * 16];
                float v[2][8]; float s = 0.f;
#pragma unroll
                for (int bj = 0; bj < 2; ++bj)
#pragma unroll
                    for (int n = 0; n < 2; ++n)
#pragma unroll
                        for (int e = 0; e < 4; ++e) { const float x = acc[ai][bj][m][n][e] * rs; v[bj][n * 4 + e] = x; s += x * x; }
                s += __shfl_xor(s, 16); s += __shfl_xor(s, 32);
                const float inv = normed ? rsqrtf(s * (1.f / 64.f) + RMS_EPS) : 1.f;
#pragma unroll
                for (int bj = 0; bj < 2; ++bj) { float o[8];
#pragma unroll
                    for (int j = 0; j < 8; ++j) o[j] = v[bj][j] * inv * gn[bj][j];
                    u32x4 w; w.x = cvt_pk_bf16(o[0], o[1]); w.y = cvt_pk_bf16(o[2], o[3]); w.z = cvt_pk_bf16(o[4], o[5]); w.w = cvt_pk_bf16(o[6], o[7]);
                    const int hh = head % 48, pg_ = hh >> 4, sh_ = 2 * pg_; const int pos = (row & ((1 << sh_) - 1)) * (T >> sh_) + (row >> sh_);
                    *(u32x4*)(O + (head >= 48 ? (size_t)48 * T * 64 : (size_t)0) + ((size_t)hh * T + pos) * 64 + bj * 32 + 8 * fq) = w; } }
    }
};
struct MatDesc { const float* W; int K, N; bf16_t* dst; int dstK, row_off, maptype; const float* s1; const float* s2; int s2mode; };
__device__ __forceinline__ int map_row(int maptype, int n) {
    if (maptype == 1) { const int u = n % FF, isup = n / FF; return (u >> 7) * 256 + isup * 128 + (u & 127); }
    if (maptype == 2) { const int tile = n >> 8, w = n & 255, head = w >> 6, d = w & 63; return tile * 256 + (d >> 5) * 128 + head * 32 + (d & 31); }
    return n;
}
struct ConvRegs { f32x4 v[2]; float sc[2]; };
__device__ __forceinline__ void conv_load(const MatDesc& md, int tile, ConvRegs& R) {
    const int tid = pg8::opq_tid(); const int ntn = (md.N + 63) >> 6; const int kt = tile / ntn, nt = tile - kt * ntn; const int k0 = kt * 64, n0 = nt * 64;
#pragma unroll
    for (int p = 0; p < 2; ++p) { const int kk = p * 32 + (tid >> 4), nn = (tid & 15) * 4, k = k0 + kk;
        f32x4 v = {0.f, 0.f, 0.f, 0.f}; float sc = 1.f;
        if (k < md.K) { if (n0 + nn < md.N) v = *(const f32x4*)(md.W + (size_t)k * md.N + n0 + nn);
            if (md.s1) sc = md.s1[k]; if (md.s2mode == 1) sc *= md.s2[k]; else if (md.s2mode == 2) sc *= (1.f - md.s2[k]); }
        R.v[p] = v; R.sc[p] = sc; }
}
__device__ __forceinline__ void conv_store(const MatDesc& md, int tile, const ConvRegs& R, float* tl) {
    const int tid = pg8::opq_tid(); const int ntn = (md.N + 63) >> 6; const int kt = tile / ntn, nt = tile - kt * ntn; const int k0 = kt * 64, n0 = nt * 64;
#pragma unroll
    for (int p = 0; p < 2; ++p) { const int kk = p * 32 + (tid >> 4), nn = (tid & 15) * 4; const f32x4 v = R.v[p]; const float sc = R.sc[p];
        tl[kk * 65 + nn + 0] = v[0] * sc; tl[kk * 65 + nn + 1] = v[1] * sc; tl[kk * 65 + nn + 2] = v[2] * sc; tl[kk * 65 + nn + 3] = v[3] * sc; }
    asm volatile("s_waitcnt lgkmcnt(0)" ::: "memory"); __builtin_amdgcn_s_barrier(); asm volatile("" ::: "memory");
    { const int n = tid >> 3, kc = tid & 7;
      if (n0 + n < md.N && k0 + kc * 8 < md.dstK) { float o[8];
#pragma unroll
          for (int j = 0; j < 8; ++j) o[j] = tl[(kc * 8 + j) * 65 + n];
          u32x4 w; w.x = cvt_pk_bf16(o[0], o[1]); w.y = cvt_pk_bf16(o[2], o[3]); w.z = cvt_pk_bf16(o[4], o[5]); w.w = cvt_pk_bf16(o[6], o[7]);
          const int drow = md.row_off + map_row(md.maptype, n0 + n);
          *(u32x4*)(md.dst + (size_t)drow * md.dstK + k0 + kc * 8) = w; } }
    asm volatile("s_waitcnt lgkmcnt(0)" ::: "memory"); __builtin_amdgcn_s_barrier(); asm volatile("" ::: "memory");
}
__device__ __forceinline__ bool get_mat(const Args& a, int mi, MatDesc& md) {
    unsigned char* ws = pg8::opq_ptr(a.ws); md.s1 = nullptr; md.s2 = nullptr; md.s2mode = 0; md.row_off = 0; md.maptype = 0;
    if (mi < 8) { md.W = a.in[2] + (size_t)mi * 1024 * 5632; md.K = 1024; md.N = 5632; md.dst = (bf16_t*)(ws + WS_WIN + mi * SZ_WIN); md.dstK = 1024; md.maptype = 1; md.s1 = a.in[1] + mi * 1024; return true; }
    mi -= 8;
    if (mi < 8) { md.W = a.in[3] + (size_t)mi * 2816 * 1024; md.K = 2816; md.N = 1024; md.dst = (bf16_t*)(ws + WS_WOUT + mi * SZ_WOUT); md.dstK = 2816; return true; }
    mi -= 8;
    if (mi < 38) { const int l = mi / 19, r = mi % 19;
        if (r < 14) { const int part = r / 7, s = r % 7; md.K = 1024; md.dstK = 1024; md.dst = (bf16_t*)(ws + WS_WCAT + l * SZ_WCAT); md.s1 = a.in[4] + l * 1024; md.s2mode = part ? 1 : 2;
            const float* mu = a.in[5] + (size_t)l * 6 * 1024; int off;
            if (s == 0) { md.W = a.in[6] + (size_t)(l * 3 + 0) * 1024 * 1024; md.N = 1024; md.s2 = mu + 0 * 1024; off = 0; }
            else if (s == 1) { md.W = a.in[6] + (size_t)(l * 3 + 1) * 1024 * 1024; md.N = 1024; md.s2 = mu + 2 * 1024; off = 1024; }
            else if (s == 2) { md.W = a.in[6] + (size_t)(l * 3 + 2) * 1024 * 1024; md.N = 1024; md.s2 = mu + 3 * 1024; off = 2048; }
            else if (s == 3) { md.W = a.in[8] + (size_t)l * 1024 * 64; md.N = 64; md.s2 = mu + 1 * 1024; off = 3072; }
            else if (s == 4) { md.W = a.in[11] + (size_t)l * 1024 * 64; md.N = 64; md.s2 = mu + 4 * 1024; off = 3136; }
            else if (s == 5) { if (l == 0) return false; md.W = a.in[14]; md.N = 32; md.s2 = mu + 3 * 1024; off = 3200; }
            else { md.W = a.in[16] + (size_t)l * 1024 * 64; md.N = 64; md.s2 = mu + 5 * 1024; off = 3232; }
            md.row_off = off + part * HALFCAT; return true; }
        if (r == 14) { md.W = a.in[23] + (size_t)l * 1024 * 1024; md.K = 1024; md.N = 1024; md.dst = (bf16_t*)(ws + WS_WOR + l * SZ_SQ); md.dstK = 1024; return true; }
        const int ui = r - 15; md.N = 1024; md.dstK = 64; md.K = 64; md.dst = (bf16_t*)(ws + WS_WUP + (size_t)(l * 4 + ui) * SZ_UP);
        if (ui == 0) md.W = a.in[9] + (size_t)l * 64 * 1024;
        else if (ui == 1) md.W = a.in[12] + (size_t)l * 64 * 1024;
        else if (ui == 2) { if (l == 0) return false; md.W = a.in[15]; md.K = 32; }
        else md.W = a.in[17] + (size_t)l * 64 * 1024;
        return true; }
    mi -= 38;
    if (mi == 0) { md.W = a.in[25]; md.K = 1024; md.N = KVW; md.dst = (bf16_t*)(ws + WS_WKV); md.dstK = 1024; md.maptype = 2; md.s1 = a.in[24]; return true; }
    mi -= 1;
    if (mi < 2) { md.W = a.in[27] + (size_t)mi * 1024 * QW; md.K = 1024; md.N = QW; md.dst = (bf16_t*)(ws + WS_WQ + mi * SZ_WQ); md.dstK = 1024; md.maptype = 2; md.s1 = a.in[4] + (2 + mi) * 1024; return true; }
    mi -= 2;
    md.W = a.in[29] + (size_t)mi * 1024 * 1024; md.K = 1024; md.N = 1024; md.dst = (bf16_t*)(ws + WS_WOA + mi * SZ_SQ); md.dstK = 1024; return true;
}
constexpr int NMAT = 8 + 8 + 38 + 1 + 2 + 2;
__device__ __forceinline__ void zero_rows(bf16_t* base, int row0, int nrows) {
    const int gt = pg8::opq_bid() * 512 + pg8::opq_tid(), NT = gridDim.x * 512;
    for (int i = gt; i < nrows * 128; i += NT) *(u32x4*)(base + (size_t)row0 * 1024 + (size_t)i * 8) = (u32x4){0u, 0u, 0u, 0u};
}
__device__ __forceinline__ int conv_sel(int mi) {
    if (mi < 16) { const int idx = mi & 7; return idx == 0 ? 0 : (idx < 4 ? 1 : 2); }
    if (mi < 54) return (mi - 16) / 19;
    return 2;
}
__device__ __forceinline__ void p0_convert(const Args& a, float* tl, int sel, int vbid, int vG) {
    for (int mi = 0; mi < NMAT; ++mi) { if (conv_sel(mi) != sel) continue; MatDesc md; if (!get_mat(a, mi, md)) continue;
        const int ntiles = ((md.K + 63) >> 6) * ((md.N + 63) >> 6);
        const int G = vG; int tile = (vbid + mi * 37) % G; ConvRegs R[4];
#pragma unroll
        for (int k = 0; k < 4; ++k) if (tile + k * G < ntiles) conv_load(md, tile + k * G, R[k]);
        for (; tile < ntiles; tile += 4 * G) {
#pragma unroll
            for (int k = 0; k < 4; ++k) { const int tk = tile + k * G; if (tk < ntiles) { conv_store(md, tk, R[k], tl); const int tn = tk + 4 * G; if (tn < ntiles) conv_load(md, tn, R[k]); } } } }
}
__device__ __forceinline__ void p0_phase(const Args& a, float* tl) {
    unsigned char* ws = pg8::opq_ptr(a.ws);
    p0_convert(a, tl, 0, pg8::opq_bid(), gridDim.x);
    if (gridDim.x <= 64) { p0_convert(a, tl, 1, pg8::opq_bid(), gridDim.x); p0_convert(a, tl, 2, pg8::opq_bid(), gridDim.x); }
    for (int l = 0; l < 2; ++l) { bf16_t* wc = (bf16_t*)(ws + WS_WCAT + l * SZ_WCAT);
        zero_rows(wc, 3296, 32); zero_rows(wc, HALFCAT + 3296, 32);
        if (l == 0) { zero_rows(wc, 3200, 32); zero_rows(wc, HALFCAT + 3200, 32); } }
    { const int gw = pg8::opq_bid() * 8 + (pg8::opq_tid() >> 6), NGW = gridDim.x * 8, lane = pg8::opq_tid() & 63;
      const float* x = a.in[0]; bf16_t* xb = (bf16_t*)(ws + WS_XB); float* ss = (float*)(ws + WS_SS);
      for (int m = gw; m < T; m += NGW) { float s = 0.f;
#pragma unroll
          for (int j = 0; j < 4; ++j) { const f32x4 v = *(const f32x4*)(x + (size_t)m * D + j * 256 + lane * 4); s += (v[0] * v[0] + v[1] * v[1]) + (v[2] * v[2] + v[3] * v[3]);
              u32x2 w; w.x = cvt_pk_bf16(v[0], v[1]); w.y = cvt_pk_bf16(v[2], v[3]); *(u32x2*)(xb + (size_t)m * D + j * 256 + lane * 4) = w; }
#pragma unroll
          for (int o = 1; o < 64; o <<= 1) s += __shfl_xor(s, o);
          if (lane < 16) ss[(size_t)m * 16 + lane] = lane == 0 ? s : 0.f; }
    }
}
#define MFMA16(a, b, c) __builtin_amdgcn_mfma_f32_16x16x32_bf16((a), (b), (c), 0, 0, 0)
__device__ __forceinline__ void ld8(const bf16_t* p, float (&o)[8]) { const u32x4 w = *(const u32x4*)p; o[0] = bflo(w.x); o[1] = bfhi(w.x); o[2] = bflo(w.y); o[3] = bfhi(w.y); o[4] = bflo(w.z); o[5] = bfhi(w.z); o[6] = bflo(w.w); o[7] = bfhi(w.w); }
__device__ __forceinline__ void ld4(const bf16_t* p, float (&o)[4]) { const u32x2 w = *(const u32x2*)p; o[0] = bflo(w.x); o[1] = bfhi(w.x); o[2] = bflo(w.y); o[3] = bfhi(w.y); }
__device__ __forceinline__ void up8(const u32x4 w, float (&o)[8]) { o[0] = bflo(w.x); o[1] = bfhi(w.x); o[2] = bflo(w.y); o[3] = bfhi(w.y); o[4] = bflo(w.z); o[5] = bfhi(w.z); o[6] = bflo(w.w); o[7] = bfhi(w.w); }
__device__ __forceinline__ void up4(const u32x2 w, float (&o)[4]) { o[0] = bflo(w.x); o[1] = bfhi(w.x); o[2] = bflo(w.y); o[3] = bfhi(w.y); }
__device__ __forceinline__ bf16x8 pack8(const float (&o)[8]) { u32x4 w; w.x = cvt_pk_bf16(o[0], o[1]); w.y = cvt_pk_bf16(o[2], o[3]); w.z = cvt_pk_bf16(o[4], o[5]); w.w = cvt_pk_bf16(o[6], o[7]); return __builtin_bit_cast(bf16x8, w); }
__device__ __forceinline__ void st4(bf16_t* p, float a, float b, float c, float d) { u32x2 w; w.x = cvt_pk_bf16(a, b); w.y = cvt_pk_bf16(c, d); *(u32x2*)p = w; }

__device__ __forceinline__ void f1_phase(const Args& a, int l, unsigned char* lds) {
    unsigned char* ws = pg8::opq_ptr(a.ws); const int lane = pg8::opq_tid() & 63, wave = pg8::opq_tid() >> 6; const int gw = pg8::opq_bid() * 8 + wave, NGW = gridDim.x * 8;
    const int tok = lane & 15, q = lane >> 4;
    const bf16_t* P = (const bf16_t*)(ws + WS_BIG); const float* ss = (const float*)(ws + WS_SS) + (size_t)(3 * l + 1) * T * 16;
    const bf16_t* WUP = (const bf16_t*)(ws + WS_WUP + (size_t)l * 4 * SZ_UP);
    bf16_t* oR = (bf16_t*)(ws + WS_MIX); bf16_t* oLD = oR + (size_t)T * D; bf16_t* oK = oLD + (size_t)T * D; bf16_t* oA = oK + (size_t)T * D; bf16_t* oB = oA + (size_t)T * D;
    bf16_t* oV0 = oB + (size_t)T * D; bf16_t* oV1 = oV0 + (size_t)T * D; bf16_t* oG = oV1 + (size_t)T * D;
    bf16_t* oV = l ? oV1 : oV0;
    const float* w0 = a.in[7] + l * D; const float* a0 = a.in[10] + l * D; const float* v0 = a.in[13]; const float* kkp = a.in[18] + l * D; const float* kap = a.in[19] + l * D;
    const int bidf = pg8::opq_bid(); const int h = bidf & 15, grp = bidf >> 4, ngrp = gridDim.x >> 4; (void)gw; (void)NGW;
    bf16_t* wl = (bf16_t*)lds; float* pl = (float*)(lds + 4 * 64 * 72 * 2);
    { const int tidf = pg8::opq_tid();
      for (int i = tidf; i < 4 * 64 * 8; i += 512) { const int m = i >> 9, r = (i >> 3) & 63, c8 = (i & 7) * 8;
          u32x4 v = {0u, 0u, 0u, 0u}; if (m != 2 || l) v = *(const u32x4*)(WUP + (size_t)m * 1024 * 64 + (size_t)(h * 64 + r) * 64 + c8);
          *(u32x4*)(wl + (m * 64 + r) * 72 + c8) = v; }
      if (tidf < 320) { const int m = tidf >> 6, c = tidf & 63; float v = 0.f;
          if (m == 0) v = w0[h * 64 + c]; else if (m == 1) v = a0[h * 64 + c]; else if (m == 2) { if (l) v = v0[h * 64 + c]; } else if (m == 3) v = kkp[h * 64 + c]; else v = kap[h * 64 + c];
          pl[m * 64 + c] = v; } }
    __syncthreads();
    bf16_t* stg = (bf16_t*)(lds + 38400 + wave * 12288);
    for (int tt = grp * 8 + wave; tt < T / 16 && grp < ngrp; tt += ngrp * 8) {
        const int t = tt * 16 + tok;
        const float rs_c = row_rs(ss, t); const float rs_p = t > 0 ? row_rs(ss, t > 0 ? t - 1 : 0) : 0.f;
        const bf16_t* Pc = P + (size_t)t * NCAT; const bf16_t* Pp = P + (size_t)(t > 0 ? t - 1 : 0) * NCAT + HALFCAT;
        u32x4 Lw[2][2], La[2][2], Lg[2][2], Lv[2]; u32x2 Lr[4][2], Lk[4][2], Lvv[4][2], Lvf[4];
#pragma unroll
        for (int ks = 0; ks < 2; ++ks) { const int ko = ks * 32 + q * 8;
            Lw[ks][0] = *(const u32x4*)(Pc + 3072 + ko); Lw[ks][1] = *(const u32x4*)(Pp + 3072 + ko); La[ks][0] = *(const u32x4*)(Pc + 3136 + ko); La[ks][1] = *(const u32x4*)(Pp + 3136 + ko);
            Lg[ks][0] = *(const u32x4*)(Pc + 3232 + ko); Lg[ks][1] = *(const u32x4*)(Pp + 3232 + ko); }
        Lv[0] = *(const u32x4*)(Pc + 3200 + q * 8); Lv[1] = *(const u32x4*)(Pp + 3200 + q * 8);
        { const int srow = lane >> 3, ch8 = (lane & 7) * 8; const int t0 = tt * 16; u32x4 sv[6][2];
#pragma unroll
          for (int a6 = 0; a6 < 6; ++a6)
#pragma unroll
              for (int hf = 0; hf < 2; ++hf) { int tr = t0 + 8 * hf + srow - (a6 & 1); tr = tr < 0 ? 0 : tr;
                  sv[a6][hf] = *(const u32x4*)(P + (size_t)tr * NCAT + (a6 & 1) * HALFCAT + (a6 >> 1) * 1024 + h * 64 + ch8); }
#pragma unroll
          for (int a6 = 0; a6 < 6; ++a6)
#pragma unroll
              for (int hf = 0; hf < 2; ++hf) *(u32x4*)(stg + (a6 * 16 + 8 * hf + srow) * 64 + ch8) = sv[a6][hf];
          asm volatile("s_waitcnt lgkmcnt(0)" ::: "memory"); }
#pragma unroll
        for (int nt = 0; nt < 4; ++nt) { const int c0 = h * 64 + nt * 16 + 4 * q; const int cl4 = nt * 16 + 4 * q;
            Lr[nt][0] = *(const u32x2*)(stg + (0 * 16 + tok) * 64 + cl4); Lr[nt][1] = *(const u32x2*)(stg + (1 * 16 + tok) * 64 + cl4);
            Lk[nt][0] = *(const u32x2*)(stg + (2 * 16 + tok) * 64 + cl4); Lk[nt][1] = *(const u32x2*)(stg + (3 * 16 + tok) * 64 + cl4);
            Lvv[nt][0] = *(const u32x2*)(stg + (4 * 16 + tok) * 64 + cl4); Lvv[nt][1] = *(const u32x2*)(stg + (5 * 16 + tok) * 64 + cl4);
            Lvf[nt] = (u32x2){0u, 0u}; if (l) Lvf[nt] = *(const u32x2*)(oV0 + (size_t)t * D + c0); }
        asm volatile("s_waitcnt lgkmcnt(0)" ::: "memory");
        bf16x8 actW[2], actA[2], actG[2], actV;
#pragma unroll
        for (int ks = 0; ks < 2; ++ks) { float c[8], p[8], x[8];
            up8(Lw[ks][0], c); up8(Lw[ks][1], p);
#pragma unroll
            for (int j = 0; j < 8; ++j) x[j] = tanh_fast(rs_c * c[j] + rs_p * p[j]);
            actW[ks] = pack8(x);
            up8(La[ks][0], c); up8(La[ks][1], p);
#pragma unroll
            for (int j = 0; j < 8; ++j) x[j] = rs_c * c[j] + rs_p * p[j];
            actA[ks] = pack8(x);
            up8(Lg[ks][0], c); up8(Lg[ks][1], p);
#pragma unroll
            for (int j = 0; j < 8; ++j) x[j] = sigm(rs_c * c[j] + rs_p * p[j]);
            actG[ks] = pack8(x); }
        { float c[8], p[8], x[8]; up8(Lv[0], c); up8(Lv[1], p);
#pragma unroll
          for (int j = 0; j < 8; ++j) x[j] = rs_c * c[j] + rs_p * p[j];
          actV = pack8(x); }
        f32x4 Dw[4], Da[4], Dv[4], Dg[4];
#pragma unroll
        for (int nt = 0; nt < 4; ++nt) { const f32x4 z = {0.f, 0.f, 0.f, 0.f}; Dw[nt] = z; Da[nt] = z; Dv[nt] = z; Dg[nt] = z;
            const int wo = (nt * 16 + tok) * 72 + q * 8;
#pragma unroll
            for (int ks = 0; ks < 2; ++ks) {
                Dw[nt] = MFMA16(*(const bf16x8*)(wl + wo + ks * 32), actW[ks], Dw[nt]);
                Da[nt] = MFMA16(*(const bf16x8*)(wl + 64 * 72 + wo + ks * 32), actA[ks], Da[nt]);
                Dg[nt] = MFMA16(*(const bf16x8*)(wl + 3 * 64 * 72 + wo + ks * 32), actG[ks], Dg[nt]); }
            if (l) Dv[nt] = MFMA16(*(const bf16x8*)(wl + 2 * 64 * 72 + wo), actV, Dv[nt]);
            __builtin_amdgcn_sched_barrier(0); }
        float kkv[4][4], asg[4][4]; float ssq = 0.f;
#pragma unroll
        for (int nt = 0; nt < 4; ++nt) { const int c0 = h * 64 + nt * 16 + 4 * q; const size_t off = (size_t)t * D + c0;
            float rc[4], rp[4], kc[4], kp[4], vc[4], vp[4];
            up4(Lr[nt][0], rc); up4(Lr[nt][1], rp); up4(Lk[nt][0], kc); up4(Lk[nt][1], kp); up4(Lvv[nt][0], vc); up4(Lvv[nt][1], vp);
            const int cl = nt * 16 + 4 * q; const f32x4 w0v = *(const f32x4*)(pl + cl), a0v = *(const f32x4*)(pl + 64 + cl), kkw = *(const f32x4*)(pl + 192 + cl), kaw = *(const f32x4*)(pl + 256 + cl);
            float vf[4] = {0.f, 0.f, 0.f, 0.f}; f32x4 v0v = {0.f, 0.f, 0.f, 0.f};
            if (l) { up4(Lvf[nt], vf); v0v = *(const f32x4*)(pl + 128 + cl); }
            float ro[4], ldo[4], ko[4], vo[4], go[4];
#pragma unroll
            for (int e = 0; e < 4; ++e) {
                const float rr = rs_c * rc[e] + rs_p * rp[e], kx = rs_c * kc[e] + rs_p * kp[e]; float vx = rs_c * vc[e] + rs_p * vp[e];
                const float wl = w0v[e] + Dw[nt][e]; const float xx = -wl; const float sp = fmaxf(xx, 0.f) + __logf(1.f + __expf(-fabsf(xx)));
                ldo[e] = -__expf(-sp - 0.5f);
                const float as = sigm(a0v[e] + Da[nt][e]);
                if (l) vx = vx + (vf[e] - vx) * sigm(v0v[e] + Dv[nt][e]);
                const float kk = kx * kkw[e]; ssq += kk * kk; kkv[nt][e] = kk; asg[nt][e] = as;
                ro[e] = rr; ko[e] = kx * (1.f + (as - 1.f) * kaw[e]); vo[e] = vx; go[e] = Dg[nt][e]; }
            { const int so = tok * 64 + nt * 16 + 4 * q; (void)off;
              st4(stg + 0 * 1024 + so, ro[0], ro[1], ro[2], ro[3]); st4(stg + 1 * 1024 + so, ldo[0], ldo[1], ldo[2], ldo[3]); st4(stg + 2 * 1024 + so, ko[0], ko[1], ko[2], ko[3]);
              st4(stg + 3 * 1024 + so, vo[0], vo[1], vo[2], vo[3]); st4(stg + 4 * 1024 + so, go[0], go[1], go[2], go[3]); } }
        asm volatile("s_waitcnt lgkmcnt(0)" ::: "memory");
        { const int srow = lane >> 3, ch8 = (lane & 7) * 8;
#define F1_OUT(ptr, sl) do { _Pragma("unroll") for (int hf = 0; hf < 2; ++hf) *(u32x4*)((ptr) + (size_t)(tt * 16 + 8 * hf + srow) * D + h * 64 + ch8) = *(const u32x4*)(stg + (sl) * 1024 + (8 * hf + srow) * 64 + ch8); } while (0)
          F1_OUT(oR, 0); F1_OUT(oLD, 1); F1_OUT(oK, 2); F1_OUT(oV, 3); F1_OUT(oG, 4); }
        asm volatile("s_waitcnt lgkmcnt(0)" ::: "memory");
        ssq += __shfl_xor(ssq, 16); ssq += __shfl_xor(ssq, 32);
        const float inv = 1.f / fmaxf(sqrtf(ssq), 1e-12f);
#pragma unroll
        for (int nt = 0; nt < 4; ++nt) { const size_t off = (size_t)t * D + h * 64 + nt * 16 + 4 * q;
            float av[4], bv[4];
#pragma unroll
            for (int e = 0; e < 4; ++e) { const float kn = kkv[nt][e] * inv; av[e] = -kn; bv[e] = kn * asg[nt][e]; }
            { const int so = tok * 64 + nt * 16 + 4 * q; (void)off; st4(stg + so, av[0], av[1], av[2], av[3]); st4(stg + 1024 + so, bv[0], bv[1], bv[2], bv[3]); } }
        asm volatile("s_waitcnt lgkmcnt(0)" ::: "memory");
        { const int srow = lane >> 3, ch8 = (lane & 7) * 8; F1_OUT(oA, 0); F1_OUT(oB, 1); }
        asm volatile("s_waitcnt lgkmcnt(0)" ::: "memory");
    }
}

__device__ __forceinline__ void rseq_phase(const Args& a, int l, float* lds) {
    if (pg8::opq_bid() >= 16) return;
    unsigned char* ws = pg8::opq_ptr(a.ws); const int tid = pg8::opq_tid(), h = pg8::opq_bid();
    const bf16_t* base = (const bf16_t*)(ws + WS_MIX);
    float* Y = (float*)(ws + WS_BIG + BIG_Y);
    const int row = tid >> 2, cgp = tid & 3;
    float s[16];
#pragma unroll
    for (int j = 0; j < 16; ++j) s[j] = 0.f;
    for (int c0 = 0; c0 < T; c0 += 16) {
        __syncthreads();
#pragma unroll
        for (int i = 0; i < 12; ++i) { const int idx = tid + i * 512; const int arr = idx >> 10, rem = idx & 1023, st = rem >> 6, j = rem & 63;
            const int ga = arr == 5 ? (5 + l) : arr;
            float v = bf2f(base[(size_t)ga * T * D + (size_t)(c0 + st) * D + h * 64 + j]); if (arr == 1) v = __expf(v);
            lds[idx] = v; }
        __syncthreads();
        if (tid < 256) {
#pragma unroll 4
            for (int st = 0; st < 16; ++st) {
                const float* pR = lds + 0 * 1024 + st * 64 + cgp * 16; const float* pD = lds + 1 * 1024 + st * 64 + cgp * 16; const float* pK = lds + 2 * 1024 + st * 64 + cgp * 16;
                const float* pA = lds + 3 * 1024 + st * 64 + cgp * 16; const float* pB = lds + 4 * 1024 + st * 64 + cgp * 16;
                const float vv = lds[5 * 1024 + st * 64 + row];
                float sa = 0.f;
#pragma unroll
                for (int j = 0; j < 16; ++j) sa += s[j] * pA[j];
                sa += __shfl_xor(sa, 1); sa += __shfl_xor(sa, 2);
                float y = 0.f;
#pragma unroll
                for (int j = 0; j < 16; ++j) { s[j] = s[j] * pD[j] + sa * pB[j] + vv * pK[j]; y += s[j] * pR[j]; }
                y += __shfl_xor(y, 1); y += __shfl_xor(y, 2);
                if (cgp == 0) Y[(size_t)(c0 + st) * D + h * 64 + row] = y;
            }
        }
    }
}

__device__ __forceinline__ void f2_phase(const Args& a, int l) {
    unsigned char* ws = pg8::opq_ptr(a.ws); const int lane = pg8::opq_tid() & 63; const int gw = pg8::opq_bid() * 8 + (pg8::opq_tid() >> 6), NGW = gridDim.x * 8;
    const bf16_t* base = (const bf16_t*)(ws + WS_MIX); const float* Y = (const float*)(ws + WS_BIG + BIG_Y); bf16_t* YG = (bf16_t*)(ws + WS_BIG + BIG_YG);
    const bf16_t* pR = base; const bf16_t* pK = base + (size_t)2 * T * D; const bf16_t* pV = base + (size_t)(5 + l) * T * D; const bf16_t* pG = base + (size_t)7 * T * D;
    const float* lnw = a.in[21] + l * D; const float* lnb = a.in[22] + l * D; const float* rk = a.in[20] + l * D;
    const int c0 = lane * 16;
    for (int t = gw; t < T; t += NGW) { const size_t off = (size_t)t * D + c0;
        float y[16], r[16], k[16], v[16], g[16];
#pragma unroll
        for (int j = 0; j < 4; ++j) { const f32x4 yy = *(const f32x4*)(Y + off + j * 4); y[j * 4] = yy[0]; y[j * 4 + 1] = yy[1]; y[j * 4 + 2] = yy[2]; y[j * 4 + 3] = yy[3]; }
        { float tmp[8]; ld8(pR + off, tmp);
#pragma unroll
          for (int j = 0; j < 8; ++j) r[j] = tmp[j];
          ld8(pR + off + 8, tmp);
#pragma unroll
          for (int j = 0; j < 8; ++j) r[8 + j] = tmp[j];
          ld8(pK + off, tmp);
#pragma unroll
          for (int j = 0; j < 8; ++j) k[j] = tmp[j];
          ld8(pK + off + 8, tmp);
#pragma unroll
          for (int j = 0; j < 8; ++j) k[8 + j] = tmp[j];
          ld8(pV + off, tmp);
#pragma unroll
          for (int j = 0; j < 8; ++j) v[j] = tmp[j];
          ld8(pV + off + 8, tmp);
#pragma unroll
          for (int j = 0; j < 8; ++j) v[8 + j] = tmp[j];
          ld8(pG + off, tmp);
#pragma unroll
          for (int j = 0; j < 8; ++j) g[j] = tmp[j];
          ld8(pG + off + 8, tmp);
#pragma unroll
          for (int j = 0; j < 8; ++j) g[8 + j] = tmp[j]; }
        float sm = 0.f, bs = 0.f;
#pragma unroll
        for (int j = 0; j < 16; ++j) { sm += y[j]; bs += r[j] * k[j] * rk[c0 + j]; }
        sm += __shfl_xor(sm, 1); sm += __shfl_xor(sm, 2); bs += __shfl_xor(bs, 1); bs += __shfl_xor(bs, 2);
        const float mean = sm * (1.f / 64.f); float vr = 0.f;
#pragma unroll
        for (int j = 0; j < 16; ++j) { const float d = y[j] - mean; vr += d * d; }
        vr += __shfl_xor(vr, 1); vr += __shfl_xor(vr, 2);
        const float rstd = rsqrtf(vr * (1.f / 64.f) + 64e-5f);
        float o[16];
#pragma unroll
        for (int j = 0; j < 16; ++j) o[j] = ((y[j] - mean) * rstd * lnw[c0 + j] + lnb[c0 + j] + bs * v[j]) * g[j];
        u32x4 w0, w1; w0.x = cvt_pk_bf16(o[0], o[1]); w0.y = cvt_pk_bf16(o[2], o[3]); w0.z = cvt_pk_bf16(o[4], o[5]); w0.w = cvt_pk_bf16(o[6], o[7]);
        w1.x = cvt_pk_bf16(o[8], o[9]); w1.y = cvt_pk_bf16(o[10], o[11]); w1.z = cvt_pk_bf16(o[12], o[13]); w1.w = cvt_pk_bf16(o[14], o[15]);
        *(u32x4*)(YG + off) = w0; *(u32x4*)(YG + off + 8) = w1; }
}
constexpr size_t BIG_RH = 0, BIG_Y0 = (size_t)4096 * 8192, BIG_MM = BIG_Y0 + (size_t)4096 * 16384, BIG_NT = BIG_MM + (size_t)4096 * 8192;
static_assert(BIG_NT + (size_t)4096 * 16384 <= SZ_BIG, "big2");
__device__ __forceinline__ f32x4 ldbf4(const bf16_t* p) { const u32x2 w = *(const u32x2*)p; return (f32x4){bflo(w.x), bfhi(w.x), bflo(w.y), bfhi(w.y)}; }
__device__ __forceinline__ int nat_frag(int rtile, int ks, int lane) { return ((rtile * 2 + ks) * 64 + lane) * 8; }
__device__ __forceinline__ int nat_st4(int rtile, int lq, int c0) { return ((rtile * 2 + (c0 >> 5)) * 64 + ((c0 >> 3) & 3) * 16 + lq) * 8 + (c0 & 7); }
constexpr int R4_RHS = 0, R4_AAB = 34816, R4_PL = 51200, R4_SEG = 51456, R4_BF = 53504, R4_ASZ = 9216, R4_LD = 72, XLD = 68;
__device__ __forceinline__ bf16x8 ldsfrag(const bf16_t* arr, int row, int koff) { return *(const bf16x8*)(arr + row * R4_LD + koff); }
__device__ __forceinline__ void r4_phase(const Args& a, int l, unsigned char* lds) {
    unsigned char* ws = pg8::opq_ptr(a.ws); const int tid = pg8::opq_tid(), lane = tid & 63, w = tid >> 6, lq = lane & 15, q = lane >> 4;
    const bf16_t* base = (const bf16_t*)(ws + WS_MIX);
    float* RHS = (float*)(lds + R4_RHS); float* AAB = (float*)(lds + R4_AAB); float* PL = (float*)(lds + R4_PL); float* SEG = (float*)(lds + R4_SEG);
    bf16_t* Arow = (bf16_t*)(lds + R4_BF); bf16_t* Brow = Arow + R4_ASZ / 2; bf16_t* Krow = Brow + R4_ASZ / 2; bf16_t* Rrow = Krow + R4_ASZ / 2;
    bf16_t* BT = Rrow + R4_ASZ / 2; bf16_t* KT = BT + R4_ASZ / 2; bf16_t* VT = KT + R4_ASZ / 2; bf16_t* AAK = VT + R4_ASZ / 2; bf16_t* ARB = AAK + R4_ASZ / 2; bf16_t* ARK = ARB + R4_ASZ / 2;
    bf16_t* AhT = Arow; bf16_t* W1T = Krow;
    const int bid = pg8::opq_bid();
    u32x4 pre[6]; bf16_t* raw = (bf16_t*)lds;
#define R4_PREFETCH(uu) do { const int h_ = (uu) & 15, c_ = (uu) >> 4; _Pragma("unroll") for (int k_ = 0; k_ < 6; ++k_) { const int idx_ = tid + 512 * k_; const int arr_ = idx_ >> 9, t_ = (idx_ >> 3) & 63, j8_ = (idx_ & 7) * 8; \
        pre[k_] = *(const u32x4*)(base + (size_t)(arr_ == 5 ? 5 + l : arr_) * T * D + (size_t)(c_ * 64 + t_) * D + h_ * 64 + j8_); } } while (0)
    for (int u = bid; u < 4096; u += gridDim.x) {
        const int h = u & 15, c = u >> 4;
        R4_PREFETCH(u);
        __syncthreads();
#pragma unroll
        for (int k_ = 0; k_ < 6; ++k_) { const int idx_ = tid + 512 * k_; *(u32x4*)(raw + (size_t)idx_ * 8) = pre[k_]; }
        __syncthreads();
#ifndef NO_S1
        { const int j = lane, seg = w; const size_t g0 = (size_t)(c * 64 + seg * 8) * D + h * 64 + j;
          float r[8], ld[8], k[8], v[8], aa[8], bb[8];
#pragma unroll
          for (int i = 0; i < 8; ++i) { const int o = (seg * 8 + i) * 64 + j; r[i] = bf2f(raw[o]); ld[i] = bf2f(raw[4096 + o]); k[i] = bf2f(raw[2 * 4096 + o]);
              aa[i] = bf2f(raw[3 * 4096 + o]); bb[i] = bf2f(raw[4 * 4096 + o]); v[i] = bf2f(raw[5 * 4096 + o]); }
          (void)g0;
          float cum[8]; float run = 0.f;
#pragma unroll
          for (int i = 0; i < 8; ++i) { run += ld[i]; cum[i] = run; }
          SEG[seg * 64 + j] = run;
          __syncthreads();
          float off = 0.f;
#pragma unroll
          for (int s = 0; s < 8; ++s) off += (s < seg) ? SEG[s * 64 + j] : 0.f;
          float at[8], rt[8], bt[8], kt[8];
#pragma unroll
          for (int i = 0; i < 8; ++i) { const float cm = cum[i] + off; const float ep = __expf(cm), em = __expf(-cm), epp = __expf(cm - ld[i]);
              at[i] = aa[i] * epp; rt[i] = r[i] * ep; bt[i] = bb[i] * em; kt[i] = k[i] * em;
              const int t = seg * 8 + i;
              Arow[t * R4_LD + j] = (bf16_t)(cvt_pk_bf16(at[i], 0.f) & 0xffffu); Brow[t * R4_LD + j] = (bf16_t)(cvt_pk_bf16(bt[i], 0.f) & 0xffffu);
              Krow[t * R4_LD + j] = (bf16_t)(cvt_pk_bf16(kt[i], 0.f) & 0xffffu); Rrow[t * R4_LD + j] = (bf16_t)(cvt_pk_bf16(rt[i], 0.f) & 0xffffu);
              if (i == 7 && seg == 7) PL[j] = ep; }
          *(f32x4*)(RHS + j * XLD + seg * 8) = (f32x4){at[0], at[1], at[2], at[3]}; *(f32x4*)(RHS + j * XLD + seg * 8 + 4) = (f32x4){at[4], at[5], at[6], at[7]};
          *(bf16x8*)(BT + j * R4_LD + seg * 8) = pack8(bt); *(bf16x8*)(KT + j * R4_LD + seg * 8) = pack8(kt); *(bf16x8*)(VT + j * R4_LD + seg * 8) = pack8(v); }
#endif
        __syncthreads();
        { const int tt = w >> 1; const int t = 16 * tt + lq;
          bf16x8 fa[2], fr[2];
#pragma unroll
          for (int ks = 0; ks < 2; ++ks) { fa[ks] = ldsfrag(Arow, t, ks * 32 + 8 * q); fr[ks] = ldsfrag(Rrow, t, ks * 32 + 8 * q); }
#pragma unroll
          for (int k2 = 0; k2 < 2; ++k2) { const int st = 2 * (w & 1) + k2; const int s0 = 16 * st + 4 * q;
              f32x4 dab = {0.f, 0.f, 0.f, 0.f}, dak = dab, drb = dab, drk = dab;
              if (st <= tt) {
#pragma unroll
                  for (int ks = 0; ks < 2; ++ks) { const bf16x8 fb = ldsfrag(Brow, 16 * st + lq, ks * 32 + 8 * q), fk = ldsfrag(Krow, 16 * st + lq, ks * 32 + 8 * q);
                      dab = MFMA16(fb, fa[ks], dab); dak = MFMA16(fk, fa[ks], dak); drb = MFMA16(fb, fr[ks], drb); drk = MFMA16(fk, fr[ks], drk); } }
#pragma unroll
              for (int e = 0; e < 4; ++e) { const int s = s0 + e; if (!(s < t)) { dab[e] = 0.f; dak[e] = 0.f; } if (!(s <= t)) { drb[e] = 0.f; drk[e] = 0.f; } }
              *(f32x4*)(AAB + t * 64 + s0) = dab;
              st4(AAK + t * R4_LD + s0, dak[0], dak[1], dak[2], dak[3]); st4(ARB + t * R4_LD + s0, drb[0], drb[1], drb[2], drb[3]); st4(ARK + t * R4_LD + s0, drk[0], drk[1], drk[2], drk[3]); } }
        __syncthreads();
        { bf16_t* AOFF = Brow; const int t = tid >> 3, s8 = (tid & 7) * 8; const f32x4 a0 = *(const f32x4*)(AAB + t * 64 + s8), a1 = *(const f32x4*)(AAB + t * 64 + s8 + 4);
          const bool keep = (s8 >> 4) < (t >> 4); const float o[8] = {keep ? a0[0] : 0.f, keep ? a0[1] : 0.f, keep ? a0[2] : 0.f, keep ? a0[3] : 0.f, keep ? a1[0] : 0.f, keep ? a1[1] : 0.f, keep ? a1[2] : 0.f, keep ? a1[3] : 0.f};
          *(bf16x8*)(AOFF + t * R4_LD + s8) = pack8(o); }
        { const int tt = w >> 1; const int t = 16 * tt + lq;
          bf16x8 fb[2];
#pragma unroll
          for (int ks = 0; ks < 2; ++ks) fb[ks] = ldsfrag(AAK, t, ks * 32 + 8 * q);
#pragma unroll
          for (int k2 = 0; k2 < 2; ++k2) { const int it = 2 * (w & 1) + k2; f32x4 d = {0.f, 0.f, 0.f, 0.f};
#pragma unroll
              for (int ks = 0; ks < 2; ++ks) d = MFMA16(ldsfrag(VT, 16 * it + lq, ks * 32 + 8 * q), fb[ks], d);
#pragma unroll
              for (int e = 0; e < 4; ++e) RHS[(64 + 16 * it + 4 * q + e) * XLD + t] = d[e]; } }
        __syncthreads();
        { bf16_t* AOFF = Brow;
#pragma unroll
          for (int b = 0; b < 4; ++b) {
              if (b > 0) { const bf16_t* xt = (w < 4 ? AhT : W1T); const int crow = 16 * (w & 3) + lq; f32x4 d = {0.f, 0.f, 0.f, 0.f};
#pragma unroll
                  for (int ks = 0; ks < (b + 1) / 2; ++ks) d = MFMA16(ldsfrag(xt, crow, ks * 32 + 8 * q), ldsfrag(AOFF, 16 * b + lq, ks * 32 + 8 * q), d);
                  const int t = 16 * b + lq; const int c0 = 16 * w + 4 * q;
#pragma unroll
                  for (int e = 0; e < 4; ++e) RHS[(c0 + e) * XLD + t] += d[e];
                  __syncthreads(); }
              if (tid < 128) { float* xr = RHS + tid * XLD + 16 * b; float x[16];
#pragma unroll
                  for (int k = 0; k < 4; ++k) { const f32x4 v = *(const f32x4*)(xr + 4 * k); x[4 * k] = v[0]; x[4 * k + 1] = v[1]; x[4 * k + 2] = v[2]; x[4 * k + 3] = v[3]; }
#pragma unroll
                  for (int t = 1; t < 16; ++t) { const float* ar = AAB + (16 * b + t) * 64 + 16 * b; float acc = x[t];
#pragma unroll
                      for (int k = 0; k < (t + 3) / 4; ++k) { const f32x4 av = *(const f32x4*)(ar + 4 * k);
#pragma unroll
                          for (int e = 0; e < 4; ++e) if (4 * k + e < t) acc += av[e] * x[4 * k + e]; }
                      x[t] = acc; }
#pragma unroll
                  for (int k = 0; k < 4; ++k) *(f32x4*)(xr + 4 * k) = (f32x4){x[4 * k], x[4 * k + 1], x[4 * k + 2], x[4 * k + 3]};
                  bf16_t* dst = (tid < 64 ? AhT : W1T) + (tid & 63) * R4_LD + 16 * b;
                  { const float o0[8] = {x[0], x[1], x[2], x[3], x[4], x[5], x[6], x[7]}; const float o1[8] = {x[8], x[9], x[10], x[11], x[12], x[13], x[14], x[15]};
                    *(bf16x8*)dst = pack8(o0); *(bf16x8*)(dst + 8) = pack8(o1); } }
              if (b < 3) __syncthreads();
          } }
        __syncthreads();
#ifndef NO_S5
        { const int rt_ = w >> 1; const int row = 16 * rt_ + lq;
          unsigned char* bigb = ws + WS_BIG;
          bf16_t* gRH = (bf16_t*)(bigb + BIG_RH) + (size_t)u * 4096; float* gY0 = (float*)((bf16_t*)(bigb + BIG_Y0) + (size_t)u * 4096);
          bf16_t* gMM = (bf16_t*)(bigb + BIG_MM) + (size_t)(h * 256 + c) * 4096; float* gNT = (float*)((bf16_t*)(bigb + BIG_NT) + (size_t)(h * 256 + c) * 4096);
          bf16x8 f_arb[2], f_ark[2], f_bt[2], f_w1[2], f_vt[2];
#pragma unroll
          for (int ks = 0; ks < 2; ++ks) { const int ko = ks * 32 + 8 * q; f_arb[ks] = ldsfrag(ARB, row, ko); f_ark[ks] = ldsfrag(ARK, row, ko); f_bt[ks] = ldsfrag(BT, row, ko); f_w1[ks] = ldsfrag(W1T, row, ko); f_vt[ks] = ldsfrag(VT, row, ko); }
          const float plrow = PL[row];
#pragma unroll
          for (int k2 = 0; k2 < 2; ++k2) { const int ct = 2 * (w & 1) + k2; const int c0 = 16 * ct + 4 * q;
              f32x4 drh = {0.f, 0.f, 0.f, 0.f}, dy0 = drh, dmm = drh, dnt = drh;
#pragma unroll
              for (int ks = 0; ks < 2; ++ks) { const int ko = ks * 32 + 8 * q;
                  const bf16x8 c_ah = ldsfrag(AhT, 16 * ct + lq, ko), c_w1 = ldsfrag(W1T, 16 * ct + lq, ko), c_vt = ldsfrag(VT, 16 * ct + lq, ko), c_bt = ldsfrag(BT, 16 * ct + lq, ko), c_kt = ldsfrag(KT, 16 * ct + lq, ko);
                  drh = MFMA16(c_ah, f_arb[ks], drh);
                  dy0 = MFMA16(c_w1, f_arb[ks], dy0); dy0 = MFMA16(c_vt, f_ark[ks], dy0);
                  dmm = MFMA16(c_ah, f_bt[ks], dmm);
                  dnt = MFMA16(c_bt, f_w1[ks], dnt); dnt = MFMA16(c_kt, f_vt[ks], dnt); }
              float rr[4]; ld4(Rrow + row * R4_LD + c0, rr);
              st4(gRH + nat_st4(rt_, lq, c0), drh[0] + rr[0], drh[1] + rr[1], drh[2] + rr[2], drh[3] + rr[3]);
              st4((bf16_t*)gY0 + ((rt_ * 4 + ct) * 64 + lane) * 4, dy0[0], dy0[1], dy0[2], dy0[3]);
#pragma unroll
              for (int e = 0; e < 4; ++e) { dmm[e] = plrow * (dmm[e] + ((c0 + e) == row ? 1.f : 0.f)); dnt[e] *= PL[c0 + e]; }
              st4(gMM + nat_st4(rt_, lq, c0), dmm[0], dmm[1], dmm[2], dmm[3]);
              st4((bf16_t*)gNT + ((rt_ * 4 + ct) * 64 + lane) * 4, dnt[0], dnt[1], dnt[2], dnt[3]); } }
#endif
    }
}
__device__ __forceinline__ void r5_phase(const Args& a, unsigned char* lds) {
    const int bid = pg8::opq_bid(); if (bid >= 64) return;
    unsigned char* ws = pg8::opq_ptr(a.ws); const int tid = pg8::opq_tid(), lane = tid & 63, w = tid >> 6, lq = lane & 15, q = lane >> 4; const int h = bid & 15, iq = bid >> 4;
    const bf16_t* gMM = (const bf16_t*)(ws + WS_BIG + BIG_MM); const float* gNT = (const float*)(ws + WS_BIG + BIG_NT);
    bf16_t* SC = (bf16_t*)(ws + WS_MIX + (size_t)1 * SZ_TD2);
    bf16_t* Sb = (bf16_t*)lds;
    for (int i = tid; i < 2 * 16 * R4_LD / 2; i += 512) ((unsigned*)Sb)[i] = 0u;
    for (int i = tid; i < 512; i += 512) ((unsigned*)(SC + (size_t)h * 4096 + iq * 1024))[i] = 0u;
    __syncthreads();
    if (w >= 4) {
        for (int c = 0; c < 256; ++c) { asm volatile("s_waitcnt lgkmcnt(0)" ::: "memory"); __builtin_amdgcn_s_barrier(); asm volatile("" ::: "memory"); }
        return; }
    const int jt = w; const int irow = 16 * iq + lq;
    bf16x8 Mr[8][2]; f32x4 Nr[8];
#pragma unroll
    for (int k = 0; k < 8; ++k) { const size_t ub = (size_t)(h * 256 + k) * 4096;
#pragma unroll
        for (int ks = 0; ks < 2; ++ks) Mr[k][ks] = *(const bf16x8*)(gMM + ub + nat_frag(jt, ks, lane));
        Nr[k] = ldbf4((const bf16_t*)gNT + ub + ((iq * 4 + jt) * 64 + lane) * 4); }
    for (int c0 = 0; c0 < 256; c0 += 8) {
#pragma unroll
        for (int k = 0; k < 8; ++k) { const int c = c0 + k;
            const bf16_t* Sc_ = Sb + (k & 1) * 16 * R4_LD; bf16_t* Sn_ = Sb + ((k & 1) ^ 1) * 16 * R4_LD;
            bf16_t* scn = SC + (size_t)((c + 1) * 16 + h) * 4096;
            f32x4 d = Nr[k];
#pragma unroll
            for (int ks = 0; ks < 2; ++ks) d = MFMA16(Mr[k][ks], ldsfrag(Sc_, lq, ks * 32 + 8 * q), d);
            st4(Sn_ + lq * R4_LD + 16 * jt + 4 * q, d[0], d[1], d[2], d[3]);
            if (c < 255) st4(scn + nat_st4(iq, lq, 16 * jt + 4 * q), d[0], d[1], d[2], d[3]);
            { const int cn = (c + 8 < 256) ? c + 8 : 255; const size_t ub = (size_t)(h * 256 + cn) * 4096;
#pragma unroll
              for (int ks = 0; ks < 2; ++ks) Mr[k][ks] = *(const bf16x8*)(gMM + ub + nat_frag(jt, ks, lane));
              Nr[k] = ldbf4((const bf16_t*)gNT + ub + ((iq * 4 + jt) * 64 + lane) * 4); }
            asm volatile("s_waitcnt lgkmcnt(0)" ::: "memory"); __builtin_amdgcn_s_barrier(); asm volatile("" ::: "memory");
        }
    }
}
__device__ __forceinline__ void r6_phase(const Args& a, int l) {
    unsigned char* ws = pg8::opq_ptr(a.ws); const int tid = pg8::opq_tid(), lane = tid & 63, lq = lane & 15, q = lane >> 4; const int gw = pg8::opq_bid() * 8 + (tid >> 6), NGW = gridDim.x * 8;
    const bf16_t* gRH = (const bf16_t*)(ws + WS_BIG + BIG_RH); const float* gY0 = (const float*)(ws + WS_BIG + BIG_Y0); const bf16_t* SC = (const bf16_t*)(ws + WS_MIX + (size_t)1 * SZ_TD2);
    const bf16_t* base = (const bf16_t*)(ws + WS_MIX); const bf16_t* pR = base; const bf16_t* pK = base + (size_t)2 * T * D; const bf16_t* pV = base + (size_t)(5 + l) * T * D; const bf16_t* pG = base + (size_t)7 * T * D;
    bf16_t* YG = (bf16_t*)(ws + WS_MIX + (size_t)3 * SZ_TD2);
    const float* lnw = a.in[21] + l * D; const float* lnb = a.in[22] + l * D; const float* rk = a.in[20] + l * D;
    struct R6In { bf16x8 fr[2]; bf16x8 fs[4][2]; u32x2 Ly[4], Lr[4], Lk[4], Lv[4], Lg[4]; };
#define R6_LOAD(R_, item_) do { const int tt_ = (item_) & 3, u_ = (item_) >> 2; const int h_ = u_ & 15, c_ = u_ >> 4; const int t_ = c_ * 64 + tt_ * 16 + lq; const size_t ub_ = (size_t)u_ * 4096; \
        _Pragma("unroll") for (int ks = 0; ks < 2; ++ks) (R_).fr[ks] = *(const bf16x8*)(gRH + ub_ + nat_frag(tt_, ks, lane)); \
        _Pragma("unroll") for (int it = 0; it < 4; ++it) { (R_).Ly[it] = *(const u32x2*)((const bf16_t*)gY0 + ub_ + ((tt_ * 4 + it) * 64 + lane) * 4); \
            _Pragma("unroll") for (int ks = 0; ks < 2; ++ks) (R_).fs[it][ks] = *(const bf16x8*)(SC + ub_ + nat_frag(it, ks, lane)); \
            const size_t off_ = (size_t)t_ * D + h_ * 64 + 16 * it + 4 * q; (R_).Lr[it] = *(const u32x2*)(pR + off_); (R_).Lk[it] = *(const u32x2*)(pK + off_); (R_).Lv[it] = *(const u32x2*)(pV + off_); (R_).Lg[it] = *(const u32x2*)(pG + off_); } } while (0)
    R6In Rn; if (gw < 16384) R6_LOAD(Rn, gw);
    for (int item = gw; item < 16384; item += NGW) { const int tt = item & 3, u = item >> 2; const int h = u & 15, c = u >> 4; const int t = c * 64 + tt * 16 + lq;
        const R6In Rc = Rn; { const int nx = item + NGW; if (nx < 16384) R6_LOAD(Rn, nx); }
        f32x4 y[4]; u32x2 Lr[4], Lk[4], Lv[4], Lg[4]; bf16x8 fr[2], fs[4][2];
#pragma unroll
        for (int ks = 0; ks < 2; ++ks) fr[ks] = Rc.fr[ks];
#pragma unroll
        for (int it = 0; it < 4; ++it) { y[it] = (f32x4){bflo(Rc.Ly[it].x), bfhi(Rc.Ly[it].x), bflo(Rc.Ly[it].y), bfhi(Rc.Ly[it].y)}; fs[it][0] = Rc.fs[it][0]; fs[it][1] = Rc.fs[it][1]; Lr[it] = Rc.Lr[it]; Lk[it] = Rc.Lk[it]; Lv[it] = Rc.Lv[it]; Lg[it] = Rc.Lg[it]; }
#pragma unroll
        for (int it = 0; it < 4; ++it)
#pragma unroll
            for (int ks = 0; ks < 2; ++ks) y[it] = MFMA16(fs[it][ks], fr[ks], y[it]);
        float sm = 0.f, bs = 0.f; float vv[4][4], gg[4][4];
#pragma unroll
        for (int it = 0; it < 4; ++it) { const int c0 = h * 64 + 16 * it + 4 * q; float r4[4], k4[4];
            up4(Lr[it], r4); up4(Lk[it], k4); up4(Lv[it], vv[it]); up4(Lg[it], gg[it]); const f32x4 rkv = *(const f32x4*)(rk + c0);
#pragma unroll
            for (int e = 0; e < 4; ++e) { sm += y[it][e]; bs += r4[e] * k4[e] * rkv[e]; } }
        sm += __shfl_xor(sm, 16); sm += __shfl_xor(sm, 32); bs += __shfl_xor(bs, 16); bs += __shfl_xor(bs, 32);
        const float mean = sm * (1.f / 64.f); float vr = 0.f;
#pragma unroll
        for (int it = 0; it < 4; ++it)
#pragma unroll
            for (int e = 0; e < 4; ++e) { const float dd = y[it][e] - mean; vr += dd * dd; }
        vr += __shfl_xor(vr, 16); vr += __shfl_xor(vr, 32);
        const float rstd = rsqrtf(vr * (1.f / 64.f) + 64e-5f);
#pragma unroll
        for (int it = 0; it < 4; ++it) { const int c0 = h * 64 + 16 * it + 4 * q; const f32x4 lw = *(const f32x4*)(lnw + c0), lb = *(const f32x4*)(lnb + c0); float o[4];
#pragma unroll
            for (int e = 0; e < 4; ++e) o[e] = ((y[it][e] - mean) * rstd * lw[e] + lb[e] + bs * vv[it][e]) * gg[it][e];
            st4(YG + (size_t)t * D + c0, o[0], o[1], o[2], o[3]); }
    }
}
constexpr int VT_LD = 136;
__device__ __forceinline__ int vt_addr(int dim, int kp) { return dim * VT_LD + (dim >> 4) * 8 + kp; }
constexpr int KL_LD = 72;
struct AttRegs { u32x4 k[4], v0a, v0b, v1a, v1b; bf16x8 q[2]; };
__device__ __forceinline__ void att_decode(int u, int& g, int& h, int& d, int& rsd, int& n) { g = u >> 11; const int rem = u & 2047; h = rem >> 7; const int rr = rem & 127; const int sh = 2 * g; d = 1 << sh; rsd = rr & (d - 1); n = rr >> sh; }
__device__ __forceinline__ void att_load(const bf16_t* Q, const bf16_t* KV, int u, int tid, AttRegs& R) {
    int g, h, d, rsd, n; att_decode(u, g, h, d, rsd, n); const int hc = g * 1024 + h * 64; const int lane = tid & 63, w = tid >> 6, lq = lane & 15, qp = lane >> 4;
    const int sh = 2 * g; const size_t plane = ((size_t)(g * 16 + h) * T + (size_t)rsd * (T >> sh)) * 64; (void)hc;
    { const int key = tid >> 1, half = tid & 1; int mk = 128 * (n - 1) + key; mk = mk < 0 ? 0 : mk; const bf16_t* p = KV + plane + (size_t)mk * 64 + half * 32;
#pragma unroll
      for (int i = 0; i < 4; ++i) R.k[i] = *(const u32x4*)(p + 8 * i); }
    { const int kp = tid >> 2, dg = tid & 3; const u32x4 z = {0u, 0u, 0u, 0u}; R.v0a = z; R.v0b = z; R.v1a = z; R.v1b = z; const int m0 = 128 * (n - 1) + 2 * kp;
      if (m0 >= 0) { const bf16_t* p0 = KV + (size_t)48 * T * 64 + plane + (size_t)m0 * 64 + dg * 16; const bf16_t* p1 = p0 + 64;
          R.v0a = *(const u32x4*)p0; R.v0b = *(const u32x4*)(p0 + 8); R.v1a = *(const u32x4*)p1; R.v1b = *(const u32x4*)(p1 + 8); } }
    { const int qi = 16 * w + lq; const int tq = (128 * n + qi) * d + rsd;
#pragma unroll
      for (int ks = 0; ks < 2; ++ks) R.q[ks] = *(const bf16x8*)(Q + plane + (size_t)(128 * n + qi) * 64 + ks * 32 + qp * 8); (void)tq; }
}
__device__ __forceinline__ void attn_phase(const Args& a, unsigned* vt) {
    unsigned char* ws = pg8::opq_ptr(a.ws); const int tid = pg8::opq_tid(), lane = tid & 63, w = tid >> 6, lq = lane & 15, qp = lane >> 4;
    const bf16_t* Q = (const bf16_t*)(ws + WS_BIG + BIG_Q); const bf16_t* KV = (const bf16_t*)(ws + WS_MIX);
    bf16_t* OG = (bf16_t*)(ws + WS_BIG + BIG_OG); float* LSE = (float*)(ws + WS_BIG + BIG_LSE);
    bf16_t* kl = (bf16_t*)(vt + 9216);
    const int G = gridDim.x; int u = pg8::opq_bid();
    AttRegs R, R2; if (u < 6144) { att_load(Q, KV, u, tid, R); att_load(Q, KV, (u + G < 6144) ? u + G : u, tid, R2); }
    for (; u < 6144; u += G) {
        int g, h, d, rsd, n; att_decode(u, g, h, d, rsd, n);
        asm volatile("s_waitcnt lgkmcnt(0)" ::: "memory"); __builtin_amdgcn_s_barrier(); asm volatile("" ::: "memory");
        { const int key = tid >> 1, half = tid & 1;
#pragma unroll
          for (int i = 0; i < 4; ++i) *(u32x4*)(kl + key * KL_LD + half * 32 + 8 * i) = R.k[i]; }
        { const int kp = tid >> 2, dg = tid & 3;
          const unsigned e0[8] = {R.v0a.x, R.v0a.y, R.v0a.z, R.v0a.w, R.v0b.x, R.v0b.y, R.v0b.z, R.v0b.w}; const unsigned e1[8] = {R.v1a.x, R.v1a.y, R.v1a.z, R.v1a.w, R.v1b.x, R.v1b.y, R.v1b.z, R.v1b.w};
#pragma unroll
          for (int j = 0; j < 8; ++j) { const int dim = dg * 16 + 2 * j;
              vt[vt_addr(dim, kp)] = (e0[j] & 0xffffu) | (e1[j] << 16);
              vt[vt_addr(dim + 1, kp)] = (e0[j] >> 16) | (e1[j] & 0xffff0000u); } }
        bf16x8 bq[2]; bq[0] = R.q[0]; bq[1] = R.q[1];
        asm volatile("s_waitcnt lgkmcnt(0)" ::: "memory"); __builtin_amdgcn_s_barrier(); asm volatile("" ::: "memory");
        R = R2; { const int un = (u + 2 * G < 6144) ? u + 2 * G : u; att_load(Q, KV, un, tid, R2); }
        const int qi = 16 * w + lq; const int tq = (128 * n + qi) * d + rsd;
        const int kt0 = 2 * (w >> 1);
        f32x4 sc[10];
#pragma unroll
        for (int kl_ = 0; kl_ < 10; ++kl_) { const int krow = 16 * (kt0 + kl_) + lq; f32x4 acc = {0.f, 0.f, 0.f, 0.f};
            acc = MFMA16(*(const bf16x8*)(kl + krow * KL_LD + qp * 8), bq[0], acc); acc = MFMA16(*(const bf16x8*)(kl + krow * KL_LD + 32 + qp * 8), bq[1], acc); sc[kl_] = acc; }
        float mx = -3.0e38f;
#pragma unroll
        for (int kl_ = 0; kl_ < 10; ++kl_)
#pragma unroll
            for (int e = 0; e < 4; ++e) { const int kj = 16 * (kt0 + kl_) + 4 * qp + e; const bool valid = (kj >= qi) && (kj <= qi + 128) && (n > 0 || kj >= 128);
                const float sv = valid ? sc[kl_][e] : -1e30f; sc[kl_][e] = sv; mx = fmaxf(mx, sv); }
        mx = fmaxf(mx, __shfl_xor(mx, 16)); mx = fmaxf(mx, __shfl_xor(mx, 32));
        float lsum = 0.f;
#pragma unroll
        for (int kl_ = 0; kl_ < 10; ++kl_)
#pragma unroll
            for (int e = 0; e < 4; ++e) { const float p = __expf(sc[kl_][e] - mx); sc[kl_][e] = p; lsum += p; }
        lsum += __shfl_xor(lsum, 16); lsum += __shfl_xor(lsum, 32);
        f32x4 oacc[4];
#pragma unroll
        for (int dt = 0; dt < 4; ++dt) oacc[dt] = (f32x4){0.f, 0.f, 0.f, 0.f};
#pragma unroll
        for (int sl = 0; sl < 5; ++sl) { u32x4 pw; pw.x = cvt_pk_bf16(sc[2 * sl][0], sc[2 * sl][1]); pw.y = cvt_pk_bf16(sc[2 * sl][2], sc[2 * sl][3]);
            pw.z = cvt_pk_bf16(sc[2 * sl + 1][0], sc[2 * sl + 1][1]); pw.w = cvt_pk_bf16(sc[2 * sl + 1][2], sc[2 * sl + 1][3]);
            const bf16x8 bp = __builtin_bit_cast(bf16x8, pw); const int kpb = 16 * ((kt0 >> 1) + sl) + 2 * qp;
#pragma unroll
            for (int dt = 0; dt < 4; ++dt) { const int dim = dt * 16 + lq; const u32x2 lo = *(const u32x2*)(vt + vt_addr(dim, kpb)); const u32x2 hi = *(const u32x2*)(vt + vt_addr(dim, kpb + 8));
                u32x4 aw; aw.x = lo.x; aw.y = lo.y; aw.z = hi.x; aw.w = hi.y;
                oacc[dt] = MFMA16(__builtin_bit_cast(bf16x8, aw), bp, oacc[dt]); } }
        const float il = 1.f / lsum;
        bf16_t* op = OG + (size_t)g * T * D + (size_t)tq * D + h * 64 + 4 * qp;
#pragma unroll
        for (int dt = 0; dt < 4; ++dt) st4(op + dt * 16, oacc[dt][0] * il, oacc[dt][1] * il, oacc[dt][2] * il, oacc[dt][3] * il);
        if (qp == 0) LSE[(size_t)g * T * 16 + (size_t)tq * 16 + h] = mx + __logf(lsum);
    }
}
__device__ __forceinline__ void comb_phase(const Args& a) {
    unsigned char* ws = pg8::opq_ptr(a.ws); const int lane = pg8::opq_tid() & 63; const int gw = pg8::opq_bid() * 8 + (pg8::opq_tid() >> 6), NGW = gridDim.x * 8;
    const bf16_t* OG = (const bf16_t*)(ws + WS_BIG + BIG_OG); const float* LSE = (const float*)(ws + WS_BIG + BIG_LSE); bf16_t* O = (bf16_t*)(ws + WS_MIX + (size_t)T * KVW * 2);
    const int c0 = lane * 16, h = lane >> 2;
    for (int t = gw; t < T; t += NGW) {
        const float l0 = LSE[(size_t)t * 16 + h], l1 = LSE[(size_t)T * 16 + (size_t)t * 16 + h], l2 = LSE[(size_t)2 * T * 16 + (size_t)t * 16 + h];
        const float mx = fmaxf(l0, fmaxf(l1, l2)); float e0 = __expf(l0 - mx), e1 = __expf(l1 - mx), e2 = __expf(l2 - mx); const float is = 1.f / (e0 + e1 + e2); e0 *= is; e1 *= is; e2 *= is;
        float o[16];
#pragma unroll
        for (int hf = 0; hf < 2; ++hf) { float x0[8], x1[8], x2[8]; const size_t off = (size_t)t * D + c0 + hf * 8;
            ld8(OG + off, x0); ld8(OG + (size_t)T * D + off, x1); ld8(OG + (size_t)2 * T * D + off, x2);
#pragma unroll
            for (int j = 0; j < 8; ++j) o[hf * 8 + j] = e0 * x0[j] + e1 * x1[j] + e2 * x2[j]; }
        u32x4 w0, w1; w0.x = cvt_pk_bf16(o[0], o[1]); w0.y = cvt_pk_bf16(o[2], o[3]); w0.z = cvt_pk_bf16(o[4], o[5]); w0.w = cvt_pk_bf16(o[6], o[7]);
        w1.x = cvt_pk_bf16(o[8], o[9]); w1.y = cvt_pk_bf16(o[10], o[11]); w1.z = cvt_pk_bf16(o[12], o[13]); w1.w = cvt_pk_bf16(o[14], o[15]);
        *(u32x4*)(O + (size_t)t * D + c0) = w0; *(u32x4*)(O + (size_t)t * D + c0 + 8) = w1; }
}
__global__ void __launch_bounds__(512, 2) mega(Args a) {
    extern __shared__ __attribute__((aligned(16))) unsigned char lds[];
    { volatile LAS unsigned* stw = (volatile LAS unsigned*)((LAS unsigned char*)lds + (LDS_BYTES - 64)); if (threadIdx.x < 2) stw[threadIdx.x] = 0u; }
    __syncthreads();
    { cg::grid_group grid = cg::this_grid(); if (a.ph_hi < 0) grid.sync(); }
    XcdBarrier bar = xcd_barrier_post((unsigned*)(a.ws + WS_BAR), (volatile LAS unsigned*)((LAS unsigned char*)lds + (LDS_BYTES - 64)));
    for (int s = a.ph_lo; s < a.ph_hi; ++s) {
        if (s > a.ph_lo) xcd_barrier(bar);
        unsigned char* ws = pg8::opq_ptr(a.ws); PG8_LAS unsigned char* glds = (PG8_LAS unsigned char*)lds; float* ssb = (float*)(ws + WS_SS); bf16_t* XB = (bf16_t*)(ws + WS_XB); const int bid = pg8::opq_bid();
        int type, l = 0, j = 0;
        if (s == 0) type = 0; else if (s == 21) type = 8;
        else { int o; if (s <= 10) { l = 0; o = s - 1; } else if (s <= 20) { l = 1; o = s - 11; } else if (s <= 29) { l = 2; o = s - 22; } else { l = 3; o = s - 30; }
            if (l < 2) { if (o < 2) type = 1 + o; else if (o < 6) type = o + 1; else if (o == 6) type = 13; else if (o == 7) type = 7; else { type = o - 7; j = 1; } }
            else { if (o < 2) type = 1 + o; else if (o < 6) type = o + 7; else { type = o - 5; j = 1; } } }
#ifndef DUP_MASK
#define DUP_MASK 0
#endif
        for (int rep = 0; rep < (((DUP_MASK >> type) & 1) ? 2 : 1); ++rep) {
#define FILL_RTAB(S_, ssp_) do { PG8_LAS float* rt_ = (PG8_LAS float*)(glds + 131072); for (int i_ = 0; i_ < 8; ++i_) { pg8::Unit u_; if (!(S_).next(i_, u_)) break; \
            if (threadIdx.x < 256) rt_[i_ * 256 + threadIdx.x] = row_rs((ssp_), u_.pm * 256 + (int)threadIdx.x); } __syncthreads(); } while (0)
        if (type == 0) { p0_phase(a, (float*)lds); }
        else if (type == 1) { pg8::Gemm g{XB, (const bf16_t*)(ws + WS_WIN + (size_t)(l * 2 + j) * SZ_WIN), T, 2 * FF, D}; pg8::StaticOrder S; S.init(T, 2 * FF, gridDim.x, bid);
            EpiSwiglu E{(bf16_t*)(ws + WS_BIG), ssb + (size_t)(3 * l + (j ? 2 : 0)) * T * 16, (const PG8_LAS float*)(glds + 131072)}; FILL_RTAB(S, E.ss);
            pg8::gemm_phase<EpiSwiglu, pg8::StaticOrder, true, true>(glds, g, S, E); }
        else if (type == 2 || type == 7 || type == 12) {
            pg8::Gemm g; EpiResid E; E.xnew = a.out; E.xb = XB; E.xold = a.out;
            if (type == 2) { g = pg8::Gemm{(const bf16_t*)(ws + WS_BIG), (const bf16_t*)(ws + WS_WOUT + (size_t)(l * 2 + j) * SZ_WOUT), T, D, FF}; E.alpha = 0.5f; E.ssn = ssb + (size_t)(3 * l + (j ? 3 : 1)) * T * 16; if (l == 0 && j == 0) E.xold = a.in[0]; }
            else if (type == 7) { g = pg8::Gemm{(const bf16_t*)(ws + WS_MIX + (size_t)3 * SZ_TD2), (const bf16_t*)(ws + WS_WOR + (size_t)l * SZ_SQ), T, D, D}; E.alpha = 1.f; E.ssn = ssb + (size_t)(3 * l + 2) * T * 16; }
            else { g = pg8::Gemm{(const bf16_t*)(ws + WS_MIX + (size_t)T * KVW * 2), (const bf16_t*)(ws + WS_WOA + (size_t)(l - 2) * SZ_SQ), T, D, D}; E.alpha = 1.f; E.ssn = ssb + (size_t)(3 * l + 2) * T * 16; }
            pg8::StaticOrder S; S.init(T, D, gridDim.x, bid);
            pg8::gemm_phase<EpiResid, pg8::StaticOrder, true, true>(glds, g, S, E); }
        else if (type == 3) { pg8::Gemm g{XB, (const bf16_t*)(ws + WS_WCAT + (size_t)l * SZ_WCAT), T, NCAT, D}; pg8::StaticOrder S; S.init(T, NCAT, gridDim.x, bid);
            EpiPlain E{(bf16_t*)(ws + WS_BIG), NCAT};
            pg8::gemm_phase<EpiPlain, pg8::StaticOrder, true, true>(glds, g, S, E); }
        else if (type == 4) f1_phase(a, l, lds);
        else if (type == 5) r4_phase(a, l, lds);
        else if (type == 6) { if (bid >= 64 && gridDim.x > 64) p0_convert(a, (float*)lds, l + 1, bid - 64, gridDim.x - 64); else r5_phase(a, lds); }
        else if (type == 13) r6_phase(a, l);
        else if (type == 8 || type == 9) {
            pg8::Gemm g; EpiHeadNorm E; E.nnorm = 48;
            if (type == 8) { g = pg8::Gemm{XB, (const bf16_t*)(ws + WS_WKV), T, KVW, D}; E.O = (bf16_t*)(ws + WS_MIX); E.ldc = KVW; E.ss = ssb + (size_t)6 * T * 16; E.gain = a.in[26]; E.scale = 1.f; }
            else { g = pg8::Gemm{XB, (const bf16_t*)(ws + WS_WQ + (size_t)(l - 2) * SZ_WQ), T, QW, D}; E.O = (bf16_t*)(ws + WS_BIG + BIG_Q); E.ldc = QW; E.ss = ssb + (size_t)(3 * l + 1) * T * 16; E.gain = a.in[28] + (l - 2) * 192; E.scale = 0.125f; }
            pg8::StaticOrder S; S.init(T, g.N, gridDim.x, bid); E.rtab = (const PG8_LAS float*)(glds + 131072); FILL_RTAB(S, E.ss);
            pg8::gemm_phase<EpiHeadNorm, pg8::StaticOrder, true, true>(glds, g, S, E); }
        else if (type == 10) attn_phase(a, (unsigned*)lds);
        else if (type == 11) comb_phase(a);
        }
    }
}

extern "C" void kernel_launch(void* const* d_in, const int* in_sizes, int n_in, void* d_out, int out_size, void* d_ws, size_t ws_size, hipStream_t stream) {
    static int grid = 0;
    if (grid == 0) {
        if (n_in != 30 || out_size != T * D || ws_size < WS_END) { fprintf(stderr, "kernel_launch: unexpected shapes: n_in %d out %d ws %zu (need %zu)\n", n_in, out_size, ws_size, (size_t)WS_END); grid = -1; return; }
        int dev = 0, cus = 0, per_cu = 0;
        (void)hipGetDevice(&dev); (void)hipDeviceGetAttribute(&cus, hipDeviceAttributeMultiprocessorCount, dev);
        if (hipFuncSetAttribute((const void*)mega, hipFuncAttributeMaxDynamicSharedMemorySize, LDS_BYTES) != hipSuccess) { fprintf(stderr, "kernel_launch: hipFuncSetAttribute failed\n"); grid = -1; return; }
        if (hipOccupancyMaxActiveBlocksPerMultiprocessor(&per_cu, (const void*)mega, 512, LDS_BYTES) != hipSuccess || per_cu < 1) { fprintf(stderr, "kernel_launch: occupancy query says %d\n", per_cu); per_cu = 1; }
        (void)hipGetLastError();
        grid = cus * 1;
        if (grid <= 0) grid = 256;
    }
    if (grid < 0) return;
    if (hipMemsetAsync((char*)d_ws + WS_BAR, 0, XCD_BAR_WORDS * 4, stream) != hipSuccess) { fprintf(stderr, "kernel_launch: memset failed\n"); return; }
    Args a{};
    for (int i = 0; i < 30; ++i) a.in[i] = (const float*)d_in[i];
    a.out = (float*)d_out; a.ws = (unsigned char*)d_ws;
#if ONE_LAUNCH
    a.ph_lo = 0; a.ph_hi = NSTEPS;
    void* args[] = {&a};
    hipError_t e = hipLaunchCooperativeKernel((const void*)mega, dim3(grid), dim3(512), args, LDS_BYTES, stream);
    if (e != hipSuccess) fprintf(stderr, "cooperative launch failed: %s (grid %d)\n", hipGetErrorString(e), grid);
#else
    for (int s = 0; s < NSTEPS; ++s) { a.ph_lo = s; a.ph_hi = s + 1; hipLaunchKernelGGL(mega, dim3(grid), dim3(512), LDS_BYTES, stream, a); }
#endif
}
```

```cpp
#include <hip/hip_runtime.h>
#include <hip/hip_cooperative_groups.h>
#include <cstdio>
#include <cstdint>
namespace cg = cooperative_groups;
namespace pg8 {
#define PG8_LAS __attribute__((address_space(3)))
typedef unsigned short bf16_t;
typedef short bf16x8 __attribute__((ext_vector_type(8)));
typedef float f32x4 __attribute__((ext_vector_type(4)));
typedef unsigned u32x4 __attribute__((ext_vector_type(4)));
__device__ __forceinline__ int opq_tid() { int t = threadIdx.x; asm volatile("" : "+v"(t)); return t; }
__device__ __forceinline__ int opq_bid() { int t = blockIdx.x; asm volatile("" : "+s"(t)); return t; }
__device__ __forceinline__ unsigned char* opq_ptr(unsigned char* q) { size_t off = 0; asm volatile("" : "+s"(off)); return q + off; }
constexpr int BM = 256, BK = 64, HALF = 128, HTB = HALF * BK * 2  , STAGE_BYTES = 8 * HTB, NXCD = 8, WGM = 8;

__host__ __device__ __forceinline__ int lds_byte(int r, int c) { const int st = (r >> 4) * 2 + (c >> 5), rr = r & 15, cc = c & 31, ob = rr * 64 + cc * 2; return st * 1024 + (ob ^ (((ob >> 9) & 1) << 5)); }
__host__ __device__ __forceinline__ void stage_rc(int b, int& R, int& C) { const int st = b / 1024, sb = b % 1024, swz = sb ^ (((sb >> 9) & 1) << 5); R = (st >> 1) * 16 + swz / 64; C = (st & 1) * 32 + (swz % 64) / 2; }
__host__ __device__ __forceinline__ int perm32(int rho) { const int n = rho >> 4, i = rho & 15; return 8 * (i >> 2) + 4 * n + (i & 3); }

struct Unit { int pm, pn, ord; };
struct Gemm { const bf16_t* A; const bf16_t* Bt; int M, N, K; };

struct StaticOrder {
    int nM, nN, nwg, G, c;
    __host__ __device__ void init(int M, int N, int G_, int c_) { nM = M / BM; nN = N / BM; nwg = nM * nN; G = G_; c = c_; }
    __host__ __device__ __forceinline__ bool next(int i, Unit& u) const {
        const long L = (long)i * G + c; if (L >= nwg) return false;
        int wgid = (int)L; { const int q = nwg / NXCD, r = nwg % NXCD, xcd = wgid % NXCD, off = wgid / NXCD; wgid = (xcd < r ? xcd * (q + 1) : r * (q + 1) + (xcd - r) * q) + off; }
        const int nig = WGM * nN, gid = wgid / nig, fm = gid * WGM, gsz = (nM - fm) < WGM ? (nM - fm) : WGM;
        u.pm = fm + ((wgid % nig) % gsz); u.pn = (wgid % nig) / gsz; u.ord = i; return true;
    }
    __device__ __forceinline__ void a_ready(const Unit&) const {}
    __device__ __forceinline__ void done(const Unit&) const {}
};

typedef __bf16 bf16x2v_ __attribute__((ext_vector_type(2))); typedef float f32x2v_ __attribute__((ext_vector_type(2)));
__device__ __forceinline__ unsigned cvt_pk_bf16(float lo, float hi) { const f32x2v_ v = {lo, hi}; const bf16x2v_ b = __builtin_convertvector(v, bf16x2v_); return __builtin_bit_cast(unsigned, b); }
typedef float f32x2 __attribute__((ext_vector_type(2)));
template <class Epi, class Sched, bool ALIGN_EPI = false, bool SP2 = false>
__device__ __forceinline__ void gemm_phase(PG8_LAS unsigned char* lds, const Gemm g, const Sched& S, const Epi& E) {
    const int tid = opq_tid(), wid = __builtin_amdgcn_readfirstlane(tid >> 6), lane = tid & 63, wr = wid >> 2, wc = wid & 3, fr = lane & 15, fq = lane >> 4;
    const int K = g.K, nt = K / BK;
    unsigned voffA[2], voffB[2];
#pragma unroll
    for (int i = 0; i < 2; ++i) { int R, C; stage_rc(tid * 16 + i * 8192, R, C); const int Rb = Epi::PERM ? ((R & ~31) + perm32(R & 31)) : R;
        voffA[i] = (unsigned)(R * K + C) * 2u; voffB[i] = (unsigned)(Rb * K + C) * 2u; }
    const size_t kstep = (size_t)(BK * 2);
    const size_t hstep = (size_t)HALF * K * 2;
    const size_t tstep = 2 * hstep;
    const unsigned ldsw = (unsigned)wid * 1024u;
    const int aoff = lds_byte(wr * 64 + fr, fq * 8), boff = lds_byte(wc * 32 + fr, fq * 8);
#define PG8_SA(b, h) (((b) * 2 + (h)) * HTB)
#define PG8_SB(b, h) ((4 + (b) * 2 + (h)) * HTB)
#define PG8_STAGE(bufoff, gbase, voff) do { _Pragma("unroll") for (int _i = 0; _i < 2; ++_i) \
        __builtin_amdgcn_global_load_lds((const unsigned*)((const char*)(gbase) + (voff)[_i]), (PG8_LAS unsigned*)(lds + (bufoff) + ldsw + _i * 8192), 16, 0, 0); } while (0)
#define PG8_LDA(dst, b, h) do { _Pragma("unroll") for (int m = 0; m < 4; ++m) _Pragma("unroll") for (int k = 0; k < 2; ++k) dst[m][k] = *(const PG8_LAS bf16x8*)(lds + PG8_SA(b, h) + aoff + m * 2048 + k * 1024); } while (0)
#define PG8_LDB(dst, b, h) do { _Pragma("unroll") for (int n = 0; n < 2; ++n) _Pragma("unroll") for (int k = 0; k < 2; ++k) dst[n][k] = *(const PG8_LAS bf16x8*)(lds + PG8_SB(b, h) + boff + n * 2048 + k * 1024); } while (0)
#define PG8_MMA(ai, bj, At, Bt) do { __builtin_amdgcn_s_setprio(1); _Pragma("unroll") for (int m = 0; m < 4; ++m) _Pragma("unroll") for (int n = 0; n < 2; ++n) _Pragma("unroll") for (int k = 0; k < 2; ++k) \
        acc[ai][bj][m][n] = __builtin_amdgcn_mfma_f32_16x16x32_bf16(Bt[n][k], At[m][k], acc[ai][bj][m][n], 0, 0, 0); __builtin_amdgcn_s_setprio(0); } while (0)
#define PG8_WAIT_V(n) asm volatile("s_waitcnt vmcnt(" #n ")" ::: "memory")
#define PG8_WAIT_L(n) asm volatile("s_waitcnt lgkmcnt(" #n ")" ::: "memory")
#define PG8_BAR __builtin_amdgcn_s_barrier()
#define PG8_SCHED __builtin_amdgcn_sched_barrier(0)
    Unit cur, nxt; int ui = 0;
    if (!S.next(0, cur)) return;
    f32x4 acc[2][2][4][2];
#pragma unroll
    for (int a = 0; a < 2; ++a)
#pragma unroll
        for (int b = 0; b < 2; ++b)
#pragma unroll
            for (int m = 0; m < 4; ++m)
#pragma unroll
                for (int n = 0; n < 2; ++n) acc[a][b][m][n] = (f32x4){0.f, 0.f, 0.f, 0.f};
    bf16x8 At[4][2], B0[2][2], B1[2][2];
    const char* cA = (const char*)g.A + (size_t)cur.pm * tstep; const char* cB = (const char*)g.Bt + (size_t)cur.pn * tstep;
    S.a_ready(cur);
    if constexpr (SP2) {
        PG8_STAGE(PG8_SB(0, 0), cB, voffB); PG8_STAGE(PG8_SB(0, 1), cB + hstep, voffB); PG8_STAGE(PG8_SA(0, 0), cA, voffA); PG8_STAGE(PG8_SA(0, 1), cA + hstep, voffA);
        if (wr == 1) PG8_BAR;
        PG8_WAIT_V(2); PG8_BAR;
        PG8_STAGE(PG8_SB(1, 0), cB + kstep, voffB); PG8_STAGE(PG8_SA(1, 0), cA + kstep, voffA); PG8_STAGE(PG8_SB(1, 1), cB + hstep + kstep, voffB);
        PG8_WAIT_V(6); PG8_BAR;
    } else {
        PG8_STAGE(PG8_SB(0, 0), cB, voffB); PG8_STAGE(PG8_SA(0, 0), cA, voffA); PG8_STAGE(PG8_SB(0, 1), cB + hstep, voffB); PG8_STAGE(PG8_SA(0, 1), cA + hstep, voffA);
        if (wr == 1) PG8_BAR;
        PG8_WAIT_V(4); PG8_BAR;
        PG8_STAGE(PG8_SB(1, 0), cB + kstep, voffB); PG8_STAGE(PG8_SA(1, 0), cA + kstep, voffA); PG8_STAGE(PG8_SB(1, 1), cB + hstep + kstep, voffB);
        PG8_WAIT_V(6); PG8_BAR;
    }
    for (;;) {
        const bool has_next = S.next(ui + 1, nxt);
        const char* nA = has_next ? (const char*)g.A + (size_t)nxt.pm * tstep : cA; const char* nB = has_next ? (const char*)g.Bt + (size_t)nxt.pn * tstep : cB;
        for (int t = 0; t < nt; t += 2) {
            const bool last = (t == nt - 2);
            const char* a1 = cA + (size_t)(t + 1) * kstep;
            const char* a2 = last ? nA : cA + (size_t)(t + 2) * kstep; const char* b2 = last ? nB : cB + (size_t)(t + 2) * kstep;
            const char* a3 = a2 + kstep; const char* b3 = b2 + kstep;
            if (last && has_next) S.a_ready(nxt);
            if constexpr (SP2) {
            PG8_LDB(B0, 0, 0); PG8_LDB(B1, 0, 1); PG8_SCHED; PG8_LDA(At, 0, 0); PG8_STAGE(PG8_SA(1, 1), a1 + hstep, voffA);
            PG8_WAIT_V(8); PG8_WAIT_L(0); PG8_BAR; PG8_MMA(0, 0, At, B0); PG8_MMA(0, 1, At, B1); PG8_BAR; PG8_SCHED;
            PG8_LDA(At, 0, 1); PG8_STAGE(PG8_SB(0, 0), b2, voffB); PG8_STAGE(PG8_SB(0, 1), b2 + hstep, voffB); PG8_STAGE(PG8_SA(0, 0), a2, voffA);
            PG8_WAIT_V(8); PG8_WAIT_L(0); PG8_BAR; PG8_MMA(1, 0, At, B0); PG8_MMA(1, 1, At, B1); PG8_BAR; PG8_SCHED;
            PG8_LDB(B0, 1, 0); PG8_LDB(B1, 1, 1); PG8_SCHED; PG8_LDA(At, 1, 0); PG8_STAGE(PG8_SA(0, 1), a2 + hstep, voffA);
            PG8_WAIT_V(8); PG8_WAIT_L(0); PG8_BAR; PG8_MMA(0, 0, At, B0); PG8_MMA(0, 1, At, B1); PG8_BAR; PG8_SCHED;
            PG8_LDA(At, 1, 1); PG8_STAGE(PG8_SB(1, 0), b3, voffB); PG8_STAGE(PG8_SB(1, 1), b3 + hstep, voffB); PG8_STAGE(PG8_SA(1, 0), a3, voffA);
            PG8_WAIT_V(8); PG8_WAIT_L(0); PG8_BAR; PG8_MMA(1, 0, At, B0); PG8_MMA(1, 1, At, B1); PG8_BAR; PG8_SCHED;
            } else {
            PG8_LDB(B0, 0, 0); PG8_SCHED; PG8_LDA(At, 0, 0); PG8_STAGE(PG8_SA(1, 1), a1 + hstep, voffA);
            PG8_WAIT_L(8); PG8_BAR; PG8_WAIT_L(0); PG8_MMA(0, 0, At, B0); PG8_BAR; PG8_SCHED;
            PG8_LDB(B1, 0, 1); PG8_STAGE(PG8_SB(0, 0), b2, voffB);
            PG8_BAR; PG8_WAIT_L(0); PG8_MMA(0, 1, At, B1); PG8_BAR;
            PG8_LDA(At, 0, 1); PG8_STAGE(PG8_SA(0, 0), a2, voffA);
            PG8_BAR; PG8_WAIT_L(0); PG8_MMA(1, 0, At, B0); PG8_BAR; PG8_SCHED;
            PG8_STAGE(PG8_SB(0, 1), b2 + hstep, voffB);
            PG8_WAIT_V(6); PG8_BAR; PG8_MMA(1, 1, At, B1); PG8_BAR;
            PG8_LDB(B0, 1, 0); PG8_SCHED; PG8_LDA(At, 1, 0); PG8_STAGE(PG8_SA(0, 1), a2 + hstep, voffA);
            PG8_WAIT_L(8); PG8_BAR; PG8_WAIT_L(0); PG8_MMA(0, 0, At, B0); PG8_BAR; PG8_SCHED;
            PG8_LDB(B1, 1, 1); PG8_STAGE(PG8_SB(1, 0), b3, voffB);
            PG8_BAR; PG8_WAIT_L(0); PG8_MMA(0, 1, At, B1); PG8_BAR;
            PG8_LDA(At, 1, 1); PG8_STAGE(PG8_SA(1, 0), a3, voffA);
            PG8_BAR; PG8_WAIT_L(0); PG8_MMA(1, 0, At, B0); PG8_BAR; PG8_SCHED;
            PG8_STAGE(PG8_SB(1, 1), b3 + hstep, voffB);
            PG8_WAIT_V(6); PG8_BAR; PG8_MMA(1, 1, At, B1); PG8_BAR;
            }
        }
        if constexpr (ALIGN_EPI) { if (wr == 0) PG8_BAR; }
        if constexpr (!Epi::AFTER_DRAIN) { E(acc, cur, wr, wc, fr, fq); S.done(cur); }
        if (!has_next) break;
#pragma unroll
        for (int a = 0; a < 2; ++a)
#pragma unroll
            for (int b = 0; b < 2; ++b)
#pragma unroll
                for (int m = 0; m < 4; ++m)
#pragma unroll
                    for (int n = 0; n < 2; ++n) acc[a][b][m][n] = (f32x4){0.f, 0.f, 0.f, 0.f};
        cur = nxt; cA = nA; cB = nB; ++ui;
        if constexpr (ALIGN_EPI) { if (wr == 1) PG8_BAR; }
    }
    PG8_WAIT_V(0);
    if constexpr (!ALIGN_EPI) { if (wr == 0) PG8_BAR; }
    PG8_BAR;
    if constexpr (Epi::AFTER_DRAIN) { E.fused(acc, cur, wr, wc, fr, fq, lds, wid, lane); S.done(cur); }
#undef PG8_SA
#undef PG8_SB
#undef PG8_STAGE
#undef PG8_LDA
#undef PG8_LDB
#undef PG8_MMA
#undef PG8_WAIT_V
#undef PG8_WAIT_L
#undef PG8_BAR
#undef PG8_SCHED
}
}

#ifndef ONE_LAUNCH
#define ONE_LAUNCH 1
#endif
using pg8::bf16_t; using pg8::bf16x8; using pg8::f32x4; using pg8::u32x4; using pg8::Unit; using pg8::cvt_pk_bf16;
typedef unsigned u32x2 __attribute__((ext_vector_type(2)));
typedef unsigned short u16x4 __attribute__((ext_vector_type(4)));

constexpr int T = 16384, D = 1024, FF = 2816, NCAT = 6656, HALFCAT = 3328, QW = 3072, KVW = 6144;
constexpr float RMS_EPS = 1e-6f;
constexpr int LDS_BYTES = 147456;
constexpr int NSTEPS = 38;

constexpr size_t WS_BAR = 0;
constexpr size_t WS_WIN = 1u << 20;
constexpr size_t SZ_WIN = (size_t)5632 * 1024 * 2;
constexpr size_t WS_WOUT = WS_WIN + 8 * SZ_WIN;
constexpr size_t SZ_WOUT = (size_t)1024 * 2816 * 2;
constexpr size_t WS_WCAT = WS_WOUT + 8 * SZ_WOUT;
constexpr size_t SZ_WCAT = (size_t)NCAT * 1024 * 2;
constexpr size_t WS_WOR = WS_WCAT + 2 * SZ_WCAT;
constexpr size_t SZ_SQ = (size_t)1024 * 1024 * 2;
constexpr size_t WS_WUP = WS_WOR + 2 * SZ_SQ;
constexpr size_t SZ_UP = (size_t)1024 * 64 * 2;
constexpr size_t WS_WKV = WS_WUP + 8 * SZ_UP;
constexpr size_t WS_WQ = WS_WKV + (size_t)KVW * 1024 * 2;
constexpr size_t SZ_WQ = (size_t)QW * 1024 * 2;
constexpr size_t WS_WOA = WS_WQ + 2 * SZ_WQ;
constexpr size_t WS_XB = WS_WOA + 2 * SZ_SQ;
constexpr size_t SZ_TD2 = (size_t)T * 1024 * 2;
constexpr size_t WS_BIG = WS_XB + SZ_TD2;
constexpr size_t SZ_BIG = (size_t)T * NCAT * 2;
constexpr size_t WS_MIX = WS_BIG + SZ_BIG;
constexpr size_t WS_SS = WS_MIX + 8 * SZ_TD2;
constexpr size_t SZ_SS = (size_t)T * 16 * 4;
constexpr size_t WS_END = WS_SS + 13 * SZ_SS;
constexpr size_t BIG_Y = 0, BIG_YG = (size_t)T * 1024 * 4;
constexpr size_t BIG_Q = 0, BIG_OG = (size_t)T * QW * 2, BIG_LSE = BIG_OG + 3 * SZ_TD2;
static_assert(BIG_LSE + (size_t)3 * T * 16 * 4 <= SZ_BIG, "big");

struct Args { const float* in[30]; float* out; unsigned char* ws; int ph_lo, ph_hi; };

__device__ __forceinline__ float bf2f(unsigned short v) { return __uint_as_float((unsigned)v << 16); }
__device__ __forceinline__ float bflo(unsigned v) { return __uint_as_float(v << 16); }
__device__ __forceinline__ float bfhi(unsigned v) { return __uint_as_float(v & 0xffff0000u); }
__device__ __forceinline__ float row_rs(const float* ssp, int row) { const f32x4* q = (const f32x4*)(ssp + (size_t)row * 16); const f32x4 a = q[0], b = q[1], c = q[2], d = q[3];
    const float s = ((a[0] + a[1]) + (a[2] + a[3])) + ((b[0] + b[1]) + (b[2] + b[3])) + (((c[0] + c[1]) + (c[2] + c[3])) + ((d[0] + d[1]) + (d[2] + d[3]))); return rsqrtf(s * (1.f / 1024.f) + RMS_EPS); }
__device__ __forceinline__ float sigm(float x) { return __builtin_amdgcn_rcpf(1.f + __expf(-x)); }
__device__ __forceinline__ float tanh_fast(float x) { const float e = __expf(2.f * x); return 1.f - 2.f * __builtin_amdgcn_rcpf(e + 1.f); }
#define LAS __attribute__((address_space(3)))
#define XB_TMO      128
#define XB_XCNT(j)  (256  + 64 * (j))
#define XB_XSUB(j)  (1280 + 64 * (j))
#define XB_XGEN(j)  (2304 + 64 * (j))
#define XB_TOP      3328
#define XB_TOPGEN   3392
#define XCD_BAR_WORDS 3456
#define XB_SPIN_CAP (1u << 18)

__device__ __forceinline__ unsigned xb_ld(unsigned* p)              { return __hip_atomic_load(p, __ATOMIC_RELAXED, __HIP_MEMORY_SCOPE_AGENT); }
__device__ __forceinline__ unsigned xb_add(unsigned* p, unsigned v) { return __hip_atomic_fetch_add(p, v, __ATOMIC_RELAXED, __HIP_MEMORY_SCOPE_AGENT); }
__device__ __forceinline__ unsigned xb_xcc_id() { return (unsigned)__builtin_amdgcn_s_getreg((3 << 11) | 20) & 0xFu; }
#define XB_SPIN(cond, bar) do { unsigned _sp = 0; while (cond) { __builtin_amdgcn_s_sleep(1); \
    if ((++_sp & 255u) == 0u) { if (xb_ld(&(bar)[XB_TMO])) break; if (_sp > XB_SPIN_CAP) { atomicAdd(&(bar)[XB_TMO], 1u); break; } } } } while (0)

struct XcdBarrier {
    unsigned* bar; unsigned x;
    volatile LAS unsigned* st;
};

__device__ __forceinline__ XcdBarrier xcd_barrier_post(unsigned* bar, volatile LAS unsigned* st) {
    XcdBarrier b; b.bar = bar; b.x = xb_xcc_id(); b.st = st;
    if (threadIdx.x == 0) (void)xb_add(&bar[XB_XCNT(b.x)], 1u);
    return b;
}
__device__ __forceinline__ void xcd_barrier_complete(unsigned* bar, unsigned x, unsigned& nloc, unsigned& nx) {
    const unsigned G = gridDim.x * gridDim.y * gridDim.z;
    unsigned sum, cnt, mine, sp = 0u;
    for (;;) {
        sum = 0u; cnt = 0u; mine = 0u;
#pragma unroll
        for (unsigned j = 0; j < 16; ++j) { const unsigned c = xb_ld(&bar[XB_XCNT(j)]); sum += c; cnt += (c > 0u) ? 1u : 0u; mine = (j == x) ? c : mine; }
        if (sum == G) break;
        __builtin_amdgcn_s_sleep(1);
        if ((++sp & 255u) == 0u) { if (xb_ld(&bar[XB_TMO])) break; if (sp > XB_SPIN_CAP) { atomicAdd(&bar[XB_TMO], 1u); break; } }
    }
    nloc = mine > 0u ? mine : 1u; nx = cnt > 0u ? cnt : 1u;
}

__device__ __forceinline__ void xcd_barrier(const XcdBarrier& b) {
    asm volatile("s_waitcnt vmcnt(0)" ::: "memory");
    __syncthreads();
    if (threadIdx.x == 0) {
        unsigned* bar = b.bar;
        __builtin_amdgcn_s_waitcnt(0);
        unsigned nloc = b.st[0], nx = b.st[1];
        if (nloc == 0u) { xcd_barrier_complete(bar, b.x, nloc, nx); b.st[0] = nloc; b.st[1] = nx; }
        const unsigned old = xb_add(&bar[XB_XSUB(b.x)], 1u);
        const unsigned gen = old / nloc;
        if (old + 1u == (gen + 1u) * nloc) {
            __builtin_amdgcn_fence(__ATOMIC_RELEASE, "agent");
            asm volatile("s_waitcnt vmcnt(0)" ::: "memory");
            const unsigned og = xb_add(&bar[XB_TOP], 1u);
            const unsigned tg = og / nx;
            if (og + 1u == (tg + 1u) * nx) xb_add(&bar[XB_TOPGEN], 1u);
            else XB_SPIN(xb_ld(&bar[XB_TOPGEN]) == tg, bar);
            __builtin_amdgcn_fence(__ATOMIC_ACQUIRE, "agent");
            xb_add(&bar[XB_XGEN(b.x)], 1u);
            asm volatile("s_waitcnt vmcnt(0)" ::: "memory");
        } else {
            XB_SPIN(xb_ld(&bar[XB_XGEN(b.x)]) == gen, bar);
            __builtin_amdgcn_fence(__ATOMIC_ACQUIRE, "agent");
            asm volatile("s_waitcnt vmcnt(0)" ::: "memory");
        }
    }
    __syncthreads();
}
struct EpiPlain {
    static constexpr bool PERM = true, AFTER_DRAIN = false;
    bf16_t* O; int ldc;
    __device__ __forceinline__ void operator()(const f32x4 (&acc)[2][2][4][2], const Unit& u, int wr, int wc, int fr, int fq) const {
        const int row0 = u.pm * 256 + wr * 64 + fr, col0 = u.pn * 256 + wc * 32 + 8 * fq;
#pragma unroll
        for (int ai = 0; ai < 2; ++ai)
#pragma unroll
            for (int m = 0; m < 4; ++m) { bf16_t* rowp = O + (size_t)(row0 + ai * 128 + m * 16) * ldc + col0;
#pragma unroll
                for (int bj = 0; bj < 2; ++bj) { const f32x4 v0 = acc[ai][bj][m][0], v1 = acc[ai][bj][m][1]; u32x4 w;
                    w.x = cvt_pk_bf16(v0[0], v0[1]); w.y = cvt_pk_bf16(v0[2], v0[3]); w.z = cvt_pk_bf16(v1[0], v1[1]); w.w = cvt_pk_bf16(v1[2], v1[3]);
                    *(u32x4*)(rowp + bj * 128) = w; } }
    }
};
struct EpiSwiglu {
    static constexpr bool PERM = true, AFTER_DRAIN = false;
    bf16_t* O; const float* ss; const PG8_LAS float* rtab;
    __device__ __forceinline__ void operator()(const f32x4 (&acc)[2][2][4][2], const Unit& u, int wr, int wc, int fr, int fq) const {
        const int row0 = u.pm * 256 + wr * 64 + fr, col0 = u.pn * 128 + wc * 32 + 8 * fq; const PG8_LAS float* rt = rtab + u.ord * 256 + wr * 64 + fr;
#pragma unroll
        for (int ai = 0; ai < 2; ++ai)
#pragma unroll
            for (int m = 0; m < 4; ++m) { const int row = row0 + ai * 128 + m * 16; const float rs = rt[ai * 128 + m * 16];
                float o[8];
#pragma unroll
                for (int n = 0; n < 2; ++n)
#pragma unroll
                    for (int e = 0; e < 4; ++e) { const float g = acc[ai][0][m][n][e] * rs, up = acc[ai][1][m][n][e] * rs; o[n * 4 + e] = g * sigm(g) * up; }
                u32x4 w; w.x = cvt_pk_bf16(o[0], o[1]); w.y = cvt_pk_bf16(o[2], o[3]); w.z = cvt_pk_bf16(o[4], o[5]); w.w = cvt_pk_bf16(o[6], o[7]);
                *(u32x4*)(O + (size_t)row * FF + col0) = w; }
    }
};
struct EpiResid {
    static constexpr bool PERM = true, AFTER_DRAIN = false;
    const float* xold; float* xnew; bf16_t* xb; float* ssn; float alpha;
    __device__ __forceinline__ void operator()(const f32x4 (&acc)[2][2][4][2], const Unit& u, int wr, int wc, int fr, int fq) const {
        const int row0 = u.pm * 256 + wr * 64 + fr, col0 = u.pn * 256 + wc * 32 + 8 * fq;
#pragma unroll
        for (int ai = 0; ai < 2; ++ai)
#pragma unroll
          for (int mh = 0; mh < 2; ++mh) {
            f32x4 xo[2][2][2];
#pragma unroll
            for (int m2 = 0; m2 < 2; ++m2)
#pragma unroll
                for (int bj = 0; bj < 2; ++bj) { const size_t off = (size_t)(row0 + ai * 128 + (mh * 2 + m2) * 16) * D + col0 + bj * 128; xo[m2][bj][0] = *(const f32x4*)(xold + off); xo[m2][bj][1] = *(const f32x4*)(xold + off + 4); }
#pragma unroll
            for (int m2 = 0; m2 < 2; ++m2) { const int m = mh * 2 + m2; const int row = row0 + ai * 128 + m * 16; float s = 0.f;
#pragma unroll
                for (int bj = 0; bj < 2; ++bj) { const size_t off = (size_t)row * D + col0 + bj * 128;
                    const f32x4 xn0 = xo[m2][bj][0] + acc[ai][bj][m][0] * alpha, xn1 = xo[m2][bj][1] + acc[ai][bj][m][1] * alpha;
                    *(f32x4*)(xnew + off) = xn0; *(f32x4*)(xnew + off + 4) = xn1;
                    s += ((xn0[0] * xn0[0] + xn0[1] * xn0[1]) + (xn0[2] * xn0[2] + xn0[3] * xn0[3])) + ((xn1[0] * xn1[0] + xn1[1] * xn1[1]) + (xn1[2] * xn1[2] + xn1[3] * xn1[3]));
                    u32x4 w; w.x = cvt_pk_bf16(xn0[0], xn0[1]); w.y = cvt_pk_bf16(xn0[2], xn0[3]); w.z = cvt_pk_bf16(xn1[0], xn1[1]); w.w = cvt_pk_bf16(xn1[2], xn1[3]); *(u32x4*)(xb + off) = w; }
                s += __shfl_xor(s, 16); s += __shfl_xor(s, 32);
                if (fq == 0) ssn[(size_t)row * 16 + u.pn * 4 + wc] = s; } }
    }
};
struct EpiHeadNorm {
    static constexpr bool PERM = true, AFTER_DRAIN = false;
    bf16_t* O; int ldc; const float* ss; const float* gain; int nnorm; float scale; const PG8_LAS float* rtab;
    __device__ __forceinline__ void operator()(const f32x4 (&acc)[2][2][4][2], const Unit& u, int wr, int wc, int fr, int fq) const {
        const int row0 = u.pm * 256 + wr * 64 + fr; const int head = u.pn * 4 + wc; const bool normed = head < nnorm; const int g = (head >> 4) % 3;
        float gn[2][8];
#pragma unroll
        for (int bj = 0; bj < 2; ++bj)
#pragma unroll
            for (int j = 0; j < 8; ++j) gn[bj][j] = normed ? gain[g * 64 + bj * 32 + 8 * fq + j] * scale : 1.f;
#pragma unroll
        for (int ai = 0; ai < 2; ++ai)
#pragma unroll
            for (int m = 0; m < 4; ++m) { const int row = row0 + ai * 128 + m * 16; const float rs = rtab[u.ord * 256 + wr * 64 + fr + ai * 128 + m * 16];
                float v[2][8]; float s = 0.f;
#pragma unroll
                for (int bj = 0; bj < 2; ++bj)
#pragma unroll
                    for (int n = 0; n < 2; ++n)
#pragma unroll
                        for (int e = 0; e < 4; ++e) { const float x = acc[ai][bj][m][n][e] * rs; v[bj][n * 4 + e] = x; s += x * x; }
                s += __shfl_xor(s, 16); s += __shfl_xor(s, 32);
                const float inv = normed ? rsqrtf(s * (1.f / 64.f) + RMS_EPS) : 1.f;
#pragma unroll
                for (int bj = 0; bj < 2; ++bj) { float o[8];
#pragma unroll
                    for (int j = 0; j < 8; ++j) o[j] = v[bj][j] * inv * gn[bj][j];
                    u32x4 w; w.x = cvt_pk_bf16(o[0], o[1]); w.y = cvt_pk_bf16(o[2], o[3]); w.z = cvt_pk_bf16(o[4], o[5]); w.w = cvt_pk_bf16(o[6], o[7]);
                    const int hh = head % 48, pg_ = hh >> 4, sh_ = 2 * pg_; const int pos = (row & ((1 << sh_) - 1)) * (T >> sh_) + (row >> sh_);
                    *(u32x4*)(O + (head >= 48 ? (size_t)48 * T * 64 : (size_t)0) + ((size_t)hh * T + pos) * 64 + bj * 32 + 8 * fq) = w; } }
    }
};
struct MatDesc { const float* W; int K, N; bf16_t* dst; int dstK, row_off, maptype; const float* s1; const float* s2; int s2mode; };
__device__ __forceinline__ int map_row(int maptype, int n) {
    if (maptype == 1) { const int u = n % FF, isup = n / FF; return (u >> 7) * 256 + isup * 128 + (u & 127); }
    if (maptype == 2) { const int tile = n >> 8, w = n & 255, head = w >> 6, d = w & 63; return tile * 256 + (d >> 5) * 128 + head * 32 + (d & 31); }
    return n;
}
struct ConvRegs { f32x4 v[2]; float sc[2]; };
__device__ __forceinline__ void conv_load(const MatDesc& md, int tile, ConvRegs& R) {
    const int tid = pg8::opq_tid(); const int ntn = (md.N + 63) >> 6; const int kt = tile / ntn, nt = tile - kt * ntn; const int k0 = kt * 64, n0 = nt * 64;
#pragma unroll
    for (int p = 0; p < 2; ++p) { const int kk = p * 32 + (tid >> 4), nn = (tid & 15) * 4, k = k0 + kk;
        f32x4 v = {0.f, 0.f, 0.f, 0.f}; float sc = 1.f;
        if (k < md.K) { if (n0 + nn < md.N) v = *(const f32x4*)(md.W + (size_t)k * md.N + n0 + nn);
            if (md.s1) sc = md.s1[k]; if (md.s2mode == 1) sc *= md.s2[k]; else if (md.s2mode == 2) sc *= (1.f - md.s2[k]); }
        R.v[p] = v; R.sc[p] = sc; }
}
__device__ __forceinline__ void conv_store(const MatDesc& md, int tile, const ConvRegs& R, float* tl) {
    const int tid = pg8::opq_tid(); const int ntn = (md.N + 63) >> 6; const int kt = tile / ntn, nt = tile - kt * ntn; const int k0 = kt * 64, n0 = nt * 64;
#pragma unroll
    for (int p = 0; p < 2; ++p) { const int kk = p * 32 + (tid >> 4), nn = (tid & 15) * 4; const f32x4 v = R.v[p]; const float sc = R.sc[p];
        tl[kk * 65 + nn + 0] = v[0] * sc; tl[kk * 65 + nn + 1] = v[1] * sc; tl[kk * 65 + nn + 2] = v[2] * sc; tl[kk * 65 + nn + 3] = v[3] * sc; }
    asm volatile("s_waitcnt lgkmcnt(0)" ::: "memory"); __builtin_amdgcn_s_barrier(); asm volatile("" ::: "memory");
    { const int n = tid >> 3, kc = tid & 7;
      if (n0 + n < md.N && k0 + kc * 8 < md.dstK) { float o[8];
#pragma unroll
          for (int j = 0; j < 8; ++j) o[j] = tl[(kc * 8 + j) * 65 + n];
          u32x4 w; w.x = cvt_pk_bf16(o[0], o[1]); w.y = cvt_pk_bf16(o[2], o[3]); w.z = cvt_pk_bf16(o[4], o[5]); w.w = cvt_pk_bf16(o[6], o[7]);
          const int drow = md.row_off + map_row(md.maptype, n0 + n);
          *(u32x4*)(md.dst + (size_t)drow * md.dstK + k0 + kc * 8) = w; } }
    asm volatile("s_waitcnt lgkmcnt(0)" ::: "memory"); __builtin_amdgcn_s_barrier(); asm volatile("" ::: "memory");
}
__device__ __forceinline__ bool get_mat(const Args& a, int mi, MatDesc& md) {
    unsigned char* ws = pg8::opq_ptr(a.ws); md.s1 = nullptr; md.s2 = nullptr; md.s2mode = 0; md.row_off = 0; md.maptype = 0;
    if (mi < 8) { md.W = a.in[2] + (size_t)mi * 1024 * 5632; md.K = 1024; md.N = 5632; md.dst = (bf16_t*)(ws + WS_WIN + mi * SZ_WIN); md.dstK = 1024; md.maptype = 1; md.s1 = a.in[1] + mi * 1024; return true; }
    mi -= 8;
    if (mi < 8) { md.W = a.in[3] + (size_t)mi * 2816 * 1024; md.K = 2816; md.N = 1024; md.dst = (bf16_t*)(ws + WS_WOUT + mi * SZ_WOUT); md.dstK = 2816; return true; }
    mi -= 8;
    if (mi < 38) { const int l = mi / 19, r = mi % 19;
        if (r < 14) { const int part = r / 7, s = r % 7; md.K = 1024; md.dstK = 1024; md.dst = (bf16_t*)(ws + WS_WCAT + l * SZ_WCAT); md.s1 = a.in[4] + l * 1024; md.s2mode = part ? 1 : 2;
            const float* mu = a.in[5] + (size_t)l * 6 * 1024; int off;
            if (s == 0) { md.W = a.in[6] + (size_t)(l * 3 + 0) * 1024 * 1024; md.N = 1024; md.s2 = mu + 0 * 1024; off = 0; }
            else if (s == 1) { md.W = a.in[6] + (size_t)(l * 3 + 1) * 1024 * 1024; md.N = 1024; md.s2 = mu + 2 * 1024; off = 1024; }
            else if (s == 2) { md.W = a.in[6] + (size_t)(l * 3 + 2) * 1024 * 1024; md.N = 1024; md.s2 = mu + 3 * 1024; off = 2048; }
            else if (s == 3) { md.W = a.in[8] + (size_t)l * 1024 * 64; md.N = 64; md.s2 = mu + 1 * 1024; off = 3072; }
            else if (s == 4) { md.W = a.in[11] + (size_t)l * 1024 * 64; md.N = 64; md.s2 = mu + 4 * 1024; off = 3136; }
            else if (s == 5) { if (l == 0) return false; md.W = a.in[14]; md.N = 32; md.s2 = mu + 3 * 1024; off = 3200; }
            else { md.W = a.in[16] + (size_t)l * 1024 * 64; md.N = 64; md.s2 = mu + 5 * 1024; off = 3232; }
            md.row_off = off + part * HALFCAT; return true; }
        if (r == 14) { md.W = a.in[23] + (size_t)l * 1024 * 1024; md.K = 1024; md.N = 1024; md.dst = (bf16_t*)(ws + WS_WOR + l * SZ_SQ); md.dstK = 1024; return true; }
        const int ui = r - 15; md.N = 1024; md.dstK = 64; md.K = 64; md.dst = (bf16_t*)(ws + WS_WUP + (size_t)(l * 4 + ui) * SZ_UP);
        if (ui == 0) md.W = a.in[9] + (size_t)l * 64 * 1024;
        else if (ui == 1) md.W = a.in[12] + (size_t)l * 64 * 1024;
        else if (ui == 2) { if (l == 0) return false; md.W = a.in[15]; md.K = 32; }
        else md.W = a.in[17] + (size_t)l * 64 * 1024;
        return true; }
    mi -= 38;
    if (mi == 0) { md.W = a.in[25]; md.K = 1024; md.N = KVW; md.dst = (bf16_t*)(ws + WS_WKV); md.dstK = 1024; md.maptype = 2; md.s1 = a.in[24]; return true; }
    mi -= 1;
    if (mi < 2) { md.W = a.in[27] + (size_t)mi * 1024 * QW; md.K = 1024; md.N = QW; md.dst = (bf16_t*)(ws + WS_WQ + mi * SZ_WQ); md.dstK = 1024; md.maptype = 2; md.s1 = a.in[4] + (2 + mi) * 1024; return true; }
    mi -= 2;
    md.W = a.in[29] + (size_t)mi * 1024 * 1024; md.K = 1024; md.N = 1024; md.dst = (bf16_t*)(ws + WS_WOA + mi * SZ_SQ); md.dstK = 1024; return true;
}
constexpr int NMAT = 8 + 8 + 38 + 1 + 2 + 2;
__device__ __forceinline__ void zero_rows(bf16_t* base, int row0, int nrows) {
    const int gt = pg8::opq_bid() * 512 + pg8::opq_tid(), NT = gridDim.x * 512;
    for (int i = gt; i < nrows * 128; i += NT) *(u32x4*)(base + (size_t)row0 * 1024 + (size_t)i * 8) = (u32x4){0u, 0u, 0u, 0u};
}
__device__ __forceinline__ int conv_sel(int mi) {
    if (mi < 16) { const int idx = mi & 7; return idx == 0 ? 0 : (idx < 4 ? 1 : 2); }
    if (mi < 54) return (mi - 16) / 19;
    return 2;
}
__device__ __forceinline__ void p0_convert(const Args& a, float* tl, int sel, int vbid, int vG) {
    for (int mi = 0; mi < NMAT; ++mi) { if (conv_sel(mi) != sel) continue; MatDesc md; if (!get_mat(a, mi, md)) continue;
        const int ntiles = ((md.K + 63) >> 6) * ((md.N + 63) >> 6);
        const int G = vG; int tile = (vbid + mi * 37) % G; ConvRegs R[4];
#pragma unroll
        for (int k = 0; k < 4; ++k) if (tile + k * G < ntiles) conv_load(md, tile + k * G, R[k]);
        for (; tile < ntiles; tile += 4 * G) {
#pragma unroll
            for (int k = 0; k < 4; ++k) { const int tk = tile + k * G; if (tk < ntiles) { conv_store(md, tk, R[k], tl); const int tn = tk + 4 * G; if (tn < ntiles) conv_load(md, tn, R[k]); } } } }
}
__device__ __forceinline__ void p0_phase(const Args& a, float* tl) {
    unsigned char* ws = pg8::opq_ptr(a.ws);
    p0_convert(a, tl, 0, pg8::opq_bid(), gridDim.x);
    if (gridDim.x <= 64) { p0_convert(a, tl, 1, pg8::opq_bid(), gridDim.x); p0_convert(a, tl, 2, pg8::opq_bid(), gridDim.x); }
    for (int l = 0; l < 2; ++l) { bf16_t* wc = (bf16_t*)(ws + WS_WCAT + l * SZ_WCAT);
        zero_rows(wc, 3296, 32); zero_rows(wc, HALFCAT + 3296, 32);
        if (l == 0) { zero_rows(wc, 3200, 32); zero_rows(wc, HALFCAT + 3200, 32); } }
    { const int gw = pg8::opq_bid() * 8 + (pg8::opq_tid() >> 6), NGW = gridDim.x * 8, lane = pg8::opq_tid() & 63;
      const float* x = a.in[0]; bf16_t* xb = (bf16_t*)(ws + WS_XB); float* ss = (float*)(ws + WS_SS);
      for (int m = gw; m < T; m += NGW) { float s = 0.f;
#pragma unroll
          for (int j = 0; j < 4; ++j) { const f32x4 v = *(const f32x4*)(x + (size_t)m * D + j * 256 + lane * 4); s += (v[0] * v[0] + v[1] * v[1]) + (v[2] * v[2] + v[3] * v[3]);
              u32x2 w; w.x = cvt_pk_bf16(v[0], v[1]); w.y = cvt_pk_bf16(v[2], v[3]); *(u32x2*)(xb + (size_t)m * D + j * 256 + lane * 4) = w; }
#pragma unroll
          for (int o = 1; o < 64; o <<= 1) s += __shfl_xor(s, o);
          if (lane < 16) ss[(size_t)m * 16 + lane] = lane == 0 ? s : 0.f; }
    }
}
#define MFMA16(a, b, c) __builtin_amdgcn_mfma_f32_16x16x32_bf16((a), (b), (c), 0, 0, 0)
__device__ __forceinline__ void ld8(const bf16_t* p, float (&o)[8]) { const u32x4 w = *(const u32x4*)p; o[0] = bflo(w.x); o[1] = bfhi(w.x); o[2] = bflo(w.y); o[3] = bfhi(w.y); o[4] = bflo(w.z); o[5] = bfhi(w.z); o[6] = bflo(w.w); o[7] = bfhi(w.w); }
__device__ __forceinline__ void ld4(const bf16_t* p, float (&o)[4]) { const u32x2 w = *(const u32x2*)p; o[0] = bflo(w.x); o[1] = bfhi(w.x); o[2] = bflo(w.y); o[3] = bfhi(w.y); }
__device__ __forceinline__ void up8(const u32x4 w, float (&o)[8]) { o[0] = bflo(w.x); o[1] = bfhi(w.x); o[2] = bflo(w.y); o[3] = bfhi(w.y); o[4] = bflo(w.z); o[5] = bfhi(w.z); o[6] = bflo(w.w); o[7] = bfhi(w.w); }
__device__ __forceinline__ void up4(const u32x2 w, float (&o)[4]) { o[0] = bflo(w.x); o[1] = bfhi(w.x); o[2] = bflo(w.y); o[3] = bfhi(w.y); }
__device__ __forceinline__ bf16x8 pack8(const float (&o)[8]) { u32x4 w; w.x = cvt_pk_bf16(o[0], o[1]); w.y = cvt_pk_bf16(o[2], o[3]); w.z = cvt_pk_bf16(o[4], o[5]); w.w = cvt_pk_bf16(o[6], o[7]); return __builtin_bit_cast(bf16x8, w); }
__device__ __forceinline__ void st4(bf16_t* p, float a, float b, float c, float d) { u32x2 w; w.x = cvt_pk_bf16(a, b); w.y = cvt_pk_bf16(c, d); *(u32x2*)p = w; }

__device__ __forceinline__ void f1_phase(const Args& a, int l, unsigned char* lds) {
    unsigned char* ws = pg8::opq_ptr(a.ws); const int lane = pg8::opq_tid() & 63, wave = pg8::opq_tid() >> 6; const int gw = pg8::opq_bid() * 8 + wave, NGW = gridDim.x * 8;
    const int tok = lane & 15, q = lane >> 4;
    const bf16_t* P = (const bf16_t*)(ws + WS_BIG); const float* ss = (const float*)(ws + WS_SS) + (size_t)(3 * l + 1) * T * 16;
    const bf16_t* WUP = (const bf16_t*)(ws + WS_WUP + (size_t)l * 4 * SZ_UP);
    bf16_t* oR = (bf16_t*)(ws + WS_MIX); bf16_t* oLD = oR + (size_t)T * D; bf16_t* oK = oLD + (size_t)T * D; bf16_t* oA = oK + (size_t)T * D; bf16_t* oB = oA + (size_t)T * D;
    bf16_t* oV0 = oB + (size_t)T * D; bf16_t* oV1 = oV0 + (size_t)T * D; bf16_t* oG = oV1 + (size_t)T * D;
    bf16_t* oV = l ? oV1 : oV0;
    const float* w0 = a.in[7] + l * D; const float* a0 = a.in[10] + l * D; const float* v0 = a.in[13]; const float* kkp = a.in[18] + l * D; const float* kap = a.in[19] + l * D;
    const int bidf = pg8::opq_bid(); const int h = bidf & 15, grp = bidf >> 4, ngrp = gridDim.x >> 4; (void)gw; (void)NGW;
    bf16_t* wl = (bf16_t*)lds; float* pl = (float*)(lds + 4 * 64 * 72 * 2);
    { const int tidf = pg8::opq_tid();
      for (int i = tidf; i < 4 * 64 * 8; i += 512) { const int m = i >> 9, r = (i >> 3) & 63, c8 = (i & 7) * 8;
          u32x4 v = {0u, 0u, 0u, 0u}; if (m != 2 || l) v = *(const u32x4*)(WUP + (size_t)m * 1024 * 64 + (size_t)(h * 64 + r) * 64 + c8);
          *(u32x4*)(wl + (m * 64 + r) * 72 + c8) = v; }
      if (tidf < 320) { const int m = tidf >> 6, c = tidf & 63; float v = 0.f;
          if (m == 0) v = w0[h * 64 + c]; else if (m == 1) v = a0[h * 64 + c]; else if (m == 2) { if (l) v = v0[h * 64 + c]; } else if (m == 3) v = kkp[h * 64 + c]; else v = kap[h * 64 + c];
          pl[m * 64 + c] = v; } }
    __syncthreads();
    bf16_t* stg = (bf16_t*)(lds + 38400 + wave * 12288);
    for (int tt = grp * 8 + wave; tt < T / 16 && grp < ngrp; tt += ngrp * 8) {
        const int t = tt * 16 + tok;
        const float rs_c = row_rs(ss, t); const float rs_p = t > 0 ? row_rs(ss, t > 0 ? t - 1 : 0) : 0.f;
        const bf16_t* Pc = P + (size_t)t * NCAT; const bf16_t* Pp = P + (size_t)(t > 0 ? t - 1 : 0) * NCAT + HALFCAT;
        u32x4 Lw[2][2], La[2][2], Lg[2][2], Lv[2]; u32x2 Lr[4][2], Lk[4][2], Lvv[4][2], Lvf[4];
#pragma unroll
        for (int ks = 0; ks < 2; ++ks) { const int ko = ks * 32 + q * 8;
            Lw[ks][0] = *(const u32x4*)(Pc + 3072 + ko); Lw[ks][1] = *(const u32x4*)(Pp + 3072 + ko); La[ks][0] = *(const u32x4*)(Pc + 3136 + ko); La[ks][1] = *(const u32x4*)(Pp + 3136 + ko);
            Lg[ks][0] = *(const u32x4*)(Pc + 3232 + ko); Lg[ks][1] = *(const u32x4*)(Pp + 3232 + ko); }
        Lv[0] = *(const u32x4*)(Pc + 3200 + q * 8); Lv[1] = *(const u32x4*)(Pp + 3200 + q * 8);
        { const int srow = lane >> 3, ch8 = (lane & 7) * 8; const int t0 = tt * 16; u32x4 sv[6][2];
#pragma unroll
          for (int a6 = 0; a6 < 6; ++a6)
#pragma unroll
              for (int hf = 0; hf < 2; ++hf) { int tr = t0 + 8 * hf + srow - (a6 & 1); tr = tr < 0 ? 0 : tr;
                  sv[a6][hf] = *(const u32x4*)(P + (size_t)tr * NCAT + (a6 & 1) * HALFCAT + (a6 >> 1) * 1024 + h * 64 + ch8); }
#pragma unroll
          for (int a6 = 0; a6 < 6; ++a6)
#pragma unroll
              for (int hf = 0; hf < 2; ++hf) *(u32x4*)(stg + (a6 * 16 + 8 * hf + srow) * 64 + ch8) = sv[a6][hf];
          asm volatile("s_waitcnt lgkmcnt(0)" ::: "memory"); }
#pragma unroll
        for (int nt = 0; nt < 4; ++nt) { const int c0 = h * 64 + nt * 16 + 4 * q; const int cl4 = nt * 16 + 4 * q;
            Lr[nt][0] = *(const u32x2*)(stg + (0 * 16 + tok) * 64 + cl4); Lr[nt][1] = *(const u32x2*)(stg + (1 * 16 + tok) * 64 + cl4);
            Lk[nt][0] = *(const u32x2*)(stg + (2 * 16 + tok) * 64 + cl4); Lk[nt][1] = *(const u32x2*)(stg + (3 * 16 + tok) * 64 + cl4);
            Lvv[nt][0] = *(const u32x2*)(stg + (4 * 16 + tok) * 64 + cl4); Lvv[nt][1] = *(const u32x2*)(stg + (5 * 16 + tok) * 64 + cl4);
            Lvf[nt] = (u32x2){0u, 0u}; if (l) Lvf[nt] = *(const u32x2*)(oV0 + (size_t)t * D + c0); }
        asm volatile("s_waitcnt lgkmcnt(0)" ::: "memory");
        bf16x8 actW[2], actA[2], actG[2], actV;
#pragma unroll
        for (int ks = 0; ks < 2; ++ks) { float c[8], p[8], x[8];
            up8(Lw[ks][0], c); up8(Lw[ks][1], p);
#pragma unroll
            for (int j = 0; j < 8; ++j) x[j] = tanh_fast(rs_c * c[j] + rs_p * p[j]);
            actW[ks] = pack8(x);
            up8(La[ks][0], c); up8(La[ks][1], p);
#pragma unroll
            for (int j = 0; j < 8; ++j) x[j] = rs_c * c[j] + rs_p * p[j];
            actA[ks] = pack8(x);
            up8(Lg[ks][0], c); up8(Lg[ks][1], p);
#pragma unroll
            for (int j = 0; j < 8; ++j) x[j] = sigm(rs_c * c[j] + rs_p * p[j]);
            actG[ks] = pack8(x); }
        { float c[8], p[8], x[8]; up8(Lv[0], c); up8(Lv[1], p);
#pragma unroll
          for (int j = 0; j < 8; ++j) x[j] = rs_c * c[j] + rs_p * p[j];
          actV = pack8(x); }
        f32x4 Dw[4], Da[4], Dv[4], Dg[4];
#pragma unroll
        for (int nt = 0; nt < 4; ++nt) { const f32x4 z = {0.f, 0.f, 0.f, 0.f}; Dw[nt] = z; Da[nt] = z; Dv[nt] = z; Dg[nt] = z;
            const int wo = (nt * 16 + tok) * 72 + q * 8;
#pragma unroll
            for (int ks = 0; ks < 2; ++ks) {
                Dw[nt] = MFMA16(*(const bf16x8*)(wl + wo + ks * 32), actW[ks], Dw[nt]);
                Da[nt] = MFMA16(*(const bf16x8*)(wl + 64 * 72 + wo + ks * 32), actA[ks], Da[nt]);
                Dg[nt] = MFMA16(*(const bf16x8*)(wl + 3 * 64 * 72 + wo + ks * 32), actG[ks], Dg[nt]); }
            if (l) Dv[nt] = MFMA16(*(const bf16x8*)(wl + 2 * 64 * 72 + wo), actV, Dv[nt]);
            __builtin_amdgcn_sched_barrier(0); }
        float kkv[4][4], asg[4][4]; float ssq = 0.f;
#pragma unroll
        for (int nt = 0; nt < 4; ++nt) { const int c0 = h * 64 + nt * 16 + 4 * q; const size_t off = (size_t)t * D + c0;
            float rc[4], rp[4], kc[4], kp[4], vc[4], vp[4];
            up4(Lr[nt][0], rc); up4(Lr[nt][1], rp); up4(Lk[nt][0], kc); up4(Lk[nt][1], kp); up4(Lvv[nt][0], vc); up4(Lvv[nt][1], vp);
            const int cl = nt * 16 + 4 * q; const f32x4 w0v = *(const f32x4*)(pl + cl), a0v = *(const f32x4*)(pl + 64 + cl), kkw = *(const f32x4*)(pl + 192 + cl), kaw = *(const f32x4*)(pl + 256 + cl);
            float vf[4] = {0.f, 0.f, 0.f, 0.f}; f32x4 v0v = {0.f, 0.f, 0.f, 0.f};
            if (l) { up4(Lvf[nt], vf); v0v = *(const f32x4*)(pl + 128 + cl); }
            float ro[4], ldo[4], ko[4], vo[4], go[4];
#pragma unroll
            for (int e = 0; e < 4; ++e) {
                const float rr = rs_c * rc[e] + rs_p * rp[e], kx = rs_c * kc[e] + rs_p * kp[e]; float vx = rs_c * vc[e] + rs_p * vp[e];
                const float wl = w0v[e] + Dw[nt][e]; const float xx = -wl; const float sp = fmaxf(xx, 0.f) + __logf(1.f + __expf(-fabsf(xx)));
                ldo[e] = -__expf(-sp - 0.5f);
                const float as = sigm(a0v[e] + Da[nt][e]);
                if (l) vx = vx + (vf[e] - vx) * sigm(v0v[e] + Dv[nt][e]);
                const float kk = kx * kkw[e]; ssq += kk * kk; kkv[nt][e] = kk; asg[nt][e] = as;
                ro[e] = rr; ko[e] = kx * (1.f + (as - 1.f) * kaw[e]); vo[e] = vx; go[e] = Dg[nt][e]; }
            { const int so = tok * 64 + nt * 16 + 4 * q; (void)off;
              st4(stg + 0 * 1024 + so, ro[0], ro[1], ro[2], ro[3]); st4(stg + 1 * 1024 + so, ldo[0], ldo[1], ldo[2], ldo[3]); st4(stg + 2 * 1024 + so, ko[0], ko[1], ko[2], ko[3]);
              st4(stg + 3 * 1024 + so, vo[0], vo[1], vo[2], vo[3]); st4(stg + 4 * 1024 + so, go[0], go[1], go[2], go[3]); } }
        asm volatile("s_waitcnt lgkmcnt(0)" ::: "memory");
        { const int srow = lane >> 3, ch8 = (lane & 7) * 8;
#define F1_OUT(ptr, sl) do { _Pragma("unroll") for (int hf = 0; hf < 2; ++hf) *(u32x4*)((ptr) + (size_t)(tt * 16 + 8 * hf + srow) * D + h * 64 + ch8) = *(const u32x4*)(stg + (sl) * 1024 + (8 * hf + srow) * 64 + ch8); } while (0)
          F1_OUT(oR, 0); F1_OUT(oLD, 1); F1_OUT(oK, 2); F1_OUT(oV, 3); F1_OUT(oG, 4); }
        asm volatile("s_waitcnt lgkmcnt(0)" ::: "memory");
        ssq += __shfl_xor(ssq, 16); ssq += __shfl_xor(ssq, 32);
        const float inv = 1.f / fmaxf(sqrtf(ssq), 1e-12f);
#pragma unroll
        for (int nt = 0; nt < 4; ++nt) { const size_t off = (size_t)t * D + h * 64 + nt * 16 + 4 * q;
            float av[4], bv[4];
#pragma unroll
            for (int e = 0; e < 4; ++e) { const float kn = kkv[nt][e] * inv; av[e] = -kn; bv[e] = kn * asg[nt][e]; }
            { const int so = tok * 64 + nt * 16 + 4 * q; (void)off; st4(stg + so, av[0], av[1], av[2], av[3]); st4(stg + 1024 + so, bv[0], bv[1], bv[2], bv[3]); } }
        asm volatile("s_waitcnt lgkmcnt(0)" ::: "memory");
        { const int srow = lane >> 3, ch8 = (lane & 7) * 8; F1_OUT(oA, 0); F1_OUT(oB, 1); }
        asm volatile("s_waitcnt lgkmcnt(0)" ::: "memory");
    }
}

__device__ __forceinline__ void rseq_phase(const Args& a, int l, float* lds) {
    if (pg8::opq_bid() >= 16) return;
    unsigned char* ws = pg8::opq_ptr(a.ws); const int tid = pg8::opq_tid(), h = pg8::opq_bid();
    const bf16_t* base = (const bf16_t*)(ws + WS_MIX);
    float* Y = (float*)(ws + WS_BIG + BIG_Y);
    const int row = tid >> 2, cgp = tid & 3;
    float s[16];
#pragma unroll
    for (int j = 0; j < 16; ++j) s[j] = 0.f;
    for (int c0 = 0; c0 < T; c0 += 16) {
        __syncthreads();
#pragma unroll
        for (int i = 0; i < 12; ++i) { const int idx = tid + i * 512; const int arr = idx >> 10, rem = idx & 1023, st = rem >> 6, j = rem & 63;
            const int ga = arr == 5 ? (5 + l) : arr;
            float v = bf2f(base[(size_t)ga * T * D + (size_t)(c0 + st) * D + h * 64 + j]); if (arr == 1) v = __expf(v);
            lds[idx] = v; }
        __syncthreads();
        if (tid < 256) {
#pragma unroll 4
            for (int st = 0; st < 16; ++st) {
                const float* pR = lds + 0 * 1024 + st * 64 + cgp * 16; const float* pD = lds + 1 * 1024 + st * 64 + cgp * 16; const float* pK = lds + 2 * 1024 + st * 64 + cgp * 16;
                const float* pA = lds + 3 * 1024 + st * 64 + cgp * 16; const float* pB = lds + 4 * 1024 + st * 64 + cgp * 16;
                const float vv = lds[5 * 1024 + st * 64 + row];
                float sa = 0.f;
#pragma unroll
                for (int j = 0; j < 16; ++j) sa += s[j] * pA[j];
                sa += __shfl_xor(sa, 1); sa += __shfl_xor(sa, 2);
                float y = 0.f;
#pragma unroll
                for (int j = 0; j < 16; ++j) { s[j] = s[j] * pD[j] + sa * pB[j] + vv * pK[j]; y += s[j] * pR[j]; }
                y += __shfl_xor(y, 1); y += __shfl_xor(y, 2);
                if (cgp == 0) Y[(size_t)(c0 + st) * D + h * 64 + row] = y;
            }
        }
    }
}

__device__ __forceinline__ void f2_phase(const Args& a, int l) {
    unsigned char* ws = pg8::opq_ptr(a.ws); const int lane = pg8::opq_tid() & 63; const int gw = pg8::opq_bid() * 8 + (pg8::opq_tid() >> 6), NGW = gridDim.x * 8;
    const bf16_t* base = (const bf16_t*)(ws + WS_MIX); const float* Y = (const float*)(ws + WS_BIG + BIG_Y); bf16_t* YG = (bf16_t*)(ws + WS_BIG + BIG_YG);
    const bf16_t* pR = base; const bf16_t* pK = base + (size_t)2 * T * D; const bf16_t* pV = base + (size_t)(5 + l) * T * D; const bf16_t* pG = base + (size_t)7 * T * D;
    const float* lnw = a.in[21] + l * D; const float* lnb = a.in[22] + l * D; const float* rk = a.in[20] + l * D;
    const int c0 = lane * 16;
    for (int t = gw; t < T; t += NGW) { const size_t off = (size_t)t * D + c0;
        float y[16], r[16], k[16], v[16], g[16];
#pragma unroll
        for (int j = 0; j < 4; ++j) { const f32x4 yy = *(const f32x4*)(Y + off + j * 4); y[j * 4] = yy[0]; y[j * 4 + 1] = yy[1]; y[j * 4 + 2] = yy[2]; y[j * 4 + 3] = yy[3]; }
        { float tmp[8]; ld8(pR + off, tmp);
#pragma unroll
          for (int j = 0; j < 8; ++j) r[j] = tmp[j];
          ld8(pR + off + 8, tmp);
#pragma unroll
          for (int j = 0; j < 8; ++j) r[8 + j] = tmp[j];
          ld8(pK + off, tmp);
#pragma unroll
          for (int j = 0; j < 8; ++j) k[j] = tmp[j];
          ld8(pK + off + 8, tmp);
#pragma unroll
          for (int j = 0; j < 8; ++j) k[8 + j] = tmp[j];
          ld8(pV + off, tmp);
#pragma unroll
          for (int j = 0; j < 8; ++j) v[j] = tmp[j];
          ld8(pV + off + 8, tmp);
#pragma unroll
          for (int j = 0; j < 8; ++j) v[8 + j] = tmp[j];
          ld8(pG + off, tmp);
#pragma unroll
          for (int j = 0; j < 8; ++j) g[j] = tmp[j];
          ld8(pG + off + 8, tmp);
#pragma unroll
          for (int j = 0; j < 8; ++j) g[8 + j] = tmp[j]; }
        float sm = 0.f, bs = 0.f;
#pragma unroll
        for (int j = 0; j < 16; ++j) { sm += y[j]; bs += r[j] * k[j] * rk[c0 + j]; }
        sm += __shfl_xor(sm, 1); sm += __shfl_xor(sm, 2); bs += __shfl_xor(bs, 1); bs += __shfl_xor(bs, 2);
        const float mean = sm * (1.f / 64.f); float vr = 0.f;
#pragma unroll
        for (int j = 0; j < 16; ++j) { const float d = y[j] - mean; vr += d * d; }
        vr += __shfl_xor(vr, 1); vr += __shfl_xor(vr, 2);
        const float rstd = rsqrtf(vr * (1.f / 64.f) + 64e-5f);
        float o[16];
#pragma unroll
        for (int j = 0; j < 16; ++j) o[j] = ((y[j] - mean) * rstd * lnw[c0 + j] + lnb[c0 + j] + bs * v[j]) * g[j];
        u32x4 w0, w1; w0.x = cvt_pk_bf16(o[0], o[1]); w0.y = cvt_pk_bf16(o[2], o[3]); w0.z = cvt_pk_bf16(o[4], o[5]); w0.w = cvt_pk_bf16(o[6], o[7]);
        w1.x = cvt_pk_bf16(o[8], o[9]); w1.y = cvt_pk_bf16(o[10], o[11]); w1.z = cvt_pk_bf16(o[12], o[13]); w1.w = cvt_pk_bf16(o[14], o[15]);
        *(u32x4*)(YG + off) = w0; *(u32x4*)(YG + off + 8) = w1; }
}
constexpr size_t BIG_RH = 0, BIG_Y0 = (size_t)4096 * 8192, BIG_MM = BIG_Y0 + (size_t)4096 * 16384, BIG_NT = BIG_MM + (size_t)4096 * 8192;
static_assert(BIG_NT + (size_t)4096 * 16384 <= SZ_BIG, "big2");
__device__ __forceinline__ f32x4 ldbf4(const bf16_t* p) { const u32x2 w = *(const u32x2*)p; return (f32x4){bflo(w.x), bfhi(w.x), bflo(w.y), bfhi(w.y)}; }
__device__ __forceinline__ int nat_frag(int rtile, int ks, int lane) { return ((rtile * 2 + ks) * 64 + lane) * 8; }
__device__ __forceinline__ int nat_st4(int rtile, int lq, int c0) { return ((rtile * 2 + (c0 >> 5)) * 64 + ((c0 >> 3) & 3) * 16 + lq) * 8 + (c0 & 7); }
constexpr int R4_RHS = 0, R4_AAB = 34816, R4_PL = 51200, R4_SEG = 51456, R4_BF = 53504, R4_ASZ = 9216, R4_LD = 72, XLD = 68;
__device__ __forceinline__ bf16x8 ldsfrag(const bf16_t* arr, int row, int koff) { return *(const bf16x8*)(arr + row * R4_LD + koff); }
__device__ __forceinline__ void r4_phase(const Args& a, int l, unsigned char* lds) {
    unsigned char* ws = pg8::opq_ptr(a.ws); const int tid = pg8::opq_tid(), lane = tid & 63, w = tid >> 6, lq = lane & 15, q = lane >> 4;
    const bf16_t* base = (const bf16_t*)(ws + WS_MIX);
    float* RHS = (float*)(lds + R4_RHS); float* AAB = (float*)(lds + R4_AAB); float* PL = (float*)(lds + R4_PL); float* SEG = (float*)(lds + R4_SEG);
    bf16_t* Arow = (bf16_t*)(lds + R4_BF); bf16_t* Brow = Arow + R4_ASZ / 2; bf16_t* Krow = Brow + R4_ASZ / 2; bf16_t* Rrow = Krow + R4_ASZ / 2;
    bf16_t* BT = Rrow + R4_ASZ / 2; bf16_t* KT = BT + R4_ASZ / 2; bf16_t* VT = KT + R4_ASZ / 2; bf16_t* AAK = VT + R4_ASZ / 2; bf16_t* ARB = AAK + R4_ASZ / 2; bf16_t* ARK = ARB + R4_ASZ / 2;
    bf16_t* AhT = Arow; bf16_t* W1T = Krow;
    const int bid = pg8::opq_bid();
    bf16_t* raw = (bf16_t*)lds; PG8_LAS unsigned char* rawl = (PG8_LAS unsigned char*)lds;
#define R4_DMA(uu) do { const int h_ = (uu) & 15, c_ = (uu) >> 4; const int t_ = (tid >> 3) & 63, j8_ = (tid & 7) * 8; _Pragma("unroll") for (int k_ = 0; k_ < 6; ++k_) \
        __builtin_amdgcn_global_load_lds((const unsigned*)(base + (size_t)(k_ == 5 ? 5 + l : k_) * T * D + (size_t)(c_ * 64 + t_) * D + h_ * 64 + j8_), (PG8_LAS unsigned*)(rawl + k_ * 8192 + (tid >> 6) * 1024), 16, 0, 0); } while (0)
    if (bid < 4096) R4_DMA(bid);
    for (int u = bid; u < 4096; u += gridDim.x) {
        const int h = u & 15, c = u >> 4;
        __syncthreads();
#ifndef NO_S1
        { const int j = lane, seg = w; const size_t g0 = (size_t)(c * 64 + seg * 8) * D + h * 64 + j;
          float r[8], ld[8], k[8], v[8], aa[8], bb[8];
#pragma unroll
          for (int i = 0; i < 8; ++i) { const int o = (seg * 8 + i) * 64 + j; r[i] = bf2f(raw[o]); ld[i] = bf2f(raw[4096 + o]); k[i] = bf2f(raw[2 * 4096 + o]);
              aa[i] = bf2f(raw[3 * 4096 + o]); bb[i] = bf2f(raw[4 * 4096 + o]); v[i] = bf2f(raw[5 * 4096 + o]); }
          (void)g0;
          float cum[8]; float run = 0.f;
#pragma unroll
          for (int i = 0; i < 8; ++i) { run += ld[i]; cum[i] = run; }
          SEG[seg * 64 + j] = run;
          __syncthreads();
          float off = 0.f;
#pragma unroll
          for (int s = 0; s < 8; ++s) off += (s < seg) ? SEG[s * 64 + j] : 0.f;
          float at[8], rt[8], bt[8], kt[8];
#pragma unroll
          for (int i = 0; i < 8; ++i) { const float cm = cum[i] + off; const float ep = __expf(cm), em = __expf(-cm), epp = __expf(cm - ld[i]);
              at[i] = aa[i] * epp; rt[i] = r[i] * ep; bt[i] = bb[i] * em; kt[i] = k[i] * em;
              const int t = seg * 8 + i;
              Arow[t * R4_LD + j] = (bf16_t)(cvt_pk_bf16(at[i], 0.f) & 0xffffu); Brow[t * R4_LD + j] = (bf16_t)(cvt_pk_bf16(bt[i], 0.f) & 0xffffu);
              Krow[t * R4_LD + j] = (bf16_t)(cvt_pk_bf16(kt[i], 0.f) & 0xffffu); Rrow[t * R4_LD + j] = (bf16_t)(cvt_pk_bf16(rt[i], 0.f) & 0xffffu);
              if (i == 7 && seg == 7) PL[j] = ep; }
          *(f32x4*)(RHS + j * XLD + seg * 8) = (f32x4){at[0], at[1], at[2], at[3]}; *(f32x4*)(RHS + j * XLD + seg * 8 + 4) = (f32x4){at[4], at[5], at[6], at[7]};
          *(bf16x8*)(BT + j * R4_LD + seg * 8) = pack8(bt); *(bf16x8*)(KT + j * R4_LD + seg * 8) = pack8(kt); *(bf16x8*)(VT + j * R4_LD + seg * 8) = pack8(v); }
#endif
        __syncthreads();
        { const int tt = w >> 1; const int t = 16 * tt + lq;
          bf16x8 fa[2], fr[2];
#pragma unroll
          for (int ks = 0; ks < 2; ++ks) { fa[ks] = ldsfrag(Arow, t, ks * 32 + 8 * q); fr[ks] = ldsfrag(Rrow, t, ks * 32 + 8 * q); }
#pragma unroll
          for (int k2 = 0; k2 < 2; ++k2) { const int st = 2 * (w & 1) + k2; const int s0 = 16 * st + 4 * q;
              f32x4 dab = {0.f, 0.f, 0.f, 0.f}, dak = dab, drb = dab, drk = dab;
              if (st <= tt) {
#pragma unroll
                  for (int ks = 0; ks < 2; ++ks) { const bf16x8 fb = ldsfrag(Brow, 16 * st + lq, ks * 32 + 8 * q), fk = ldsfrag(Krow, 16 * st + lq, ks * 32 + 8 * q);
                      dab = MFMA16(fb, fa[ks], dab); dak = MFMA16(fk, fa[ks], dak); drb = MFMA16(fb, fr[ks], drb); drk = MFMA16(fk, fr[ks], drk); } }
#pragma unroll
              for (int e = 0; e < 4; ++e) { const int s = s0 + e; if (!(s < t)) { dab[e] = 0.f; dak[e] = 0.f; } if (!(s <= t)) { drb[e] = 0.f; drk[e] = 0.f; } }
              *(f32x4*)(AAB + t * 64 + s0) = dab;
              st4(AAK + t * R4_LD + s0, dak[0], dak[1], dak[2], dak[3]); st4(ARB + t * R4_LD + s0, drb[0], drb[1], drb[2], drb[3]); st4(ARK + t * R4_LD + s0, drk[0], drk[1], drk[2], drk[3]); } }
        __syncthreads();
        { bf16_t* AOFF = Brow; const int t = tid >> 3, s8 = (tid & 7) * 8; const f32x4 a0 = *(const f32x4*)(AAB + t * 64 + s8), a1 = *(const f32x4*)(AAB + t * 64 + s8 + 4);
          const bool keep = (s8 >> 4) < (t >> 4); const float o[8] = {keep ? a0[0] : 0.f, keep ? a0[1] : 0.f, keep ? a0[2] : 0.f, keep ? a0[3] : 0.f, keep ? a1[0] : 0.f, keep ? a1[1] : 0.f, keep ? a1[2] : 0.f, keep ? a1[3] : 0.f};
          *(bf16x8*)(AOFF + t * R4_LD + s8) = pack8(o); }
        { const int tt = w >> 1; const int t = 16 * tt + lq;
          bf16x8 fb[2];
#pragma unroll
          for (int ks = 0; ks < 2; ++ks) fb[ks] = ldsfrag(AAK, t, ks * 32 + 8 * q);
#pragma unroll
          for (int k2 = 0; k2 < 2; ++k2) { const int it = 2 * (w & 1) + k2; f32x4 d = {0.f, 0.f, 0.f, 0.f};
#pragma unroll
              for (int ks = 0; ks < 2; ++ks) d = MFMA16(ldsfrag(VT, 16 * it + lq, ks * 32 + 8 * q), fb[ks], d);
#pragma unroll
              for (int e = 0; e < 4; ++e) RHS[(64 + 16 * it + 4 * q + e) * XLD + t] = d[e]; } }
        __syncthreads();
        { bf16_t* AOFF = Brow;
#pragma unroll
          for (int b = 0; b < 4; ++b) {
              if (b > 0) { const bf16_t* xt = (w < 4 ? AhT : W1T); const int crow = 16 * (w & 3) + lq; f32x4 d = {0.f, 0.f, 0.f, 0.f};
#pragma unroll
                  for (int ks = 0; ks < (b + 1) / 2; ++ks) d = MFMA16(ldsfrag(xt, crow, ks * 32 + 8 * q), ldsfrag(AOFF, 16 * b + lq, ks * 32 + 8 * q), d);
                  const int t = 16 * b + lq; const int c0 = 16 * w + 4 * q;
#pragma unroll
                  for (int e = 0; e < 4; ++e) RHS[(c0 + e) * XLD + t] += d[e];
                  __syncthreads(); }
              if (tid < 128) { float* xr = RHS + tid * XLD + 16 * b; float x[16];
#pragma unroll
                  for (int k = 0; k < 4; ++k) { const f32x4 v = *(const f32x4*)(xr + 4 * k); x[4 * k] = v[0]; x[4 * k + 1] = v[1]; x[4 * k + 2] = v[2]; x[4 * k + 3] = v[3]; }
#pragma unroll
                  for (int t = 1; t < 16; ++t) { const float* ar = AAB + (16 * b + t) * 64 + 16 * b; float acc = x[t];
#pragma unroll
                      for (int k = 0; k < (t + 3) / 4; ++k) { const f32x4 av = *(const f32x4*)(ar + 4 * k);
#pragma unroll
                          for (int e = 0; e < 4; ++e) if (4 * k + e < t) acc += av[e] * x[4 * k + e]; }
                      x[t] = acc; }
#pragma unroll
                  for (int k = 0; k < 4; ++k) *(f32x4*)(xr + 4 * k) = (f32x4){x[4 * k], x[4 * k + 1], x[4 * k + 2], x[4 * k + 3]};
                  bf16_t* dst = (tid < 64 ? AhT : W1T) + (tid & 63) * R4_LD + 16 * b;
                  { const float o0[8] = {x[0], x[1], x[2], x[3], x[4], x[5], x[6], x[7]}; const float o1[8] = {x[8], x[9], x[10], x[11], x[12], x[13], x[14], x[15]};
                    *(bf16x8*)dst = pack8(o0); *(bf16x8*)(dst + 8) = pack8(o1); } }
              if (b < 3) __syncthreads();
          } }
        __syncthreads();
        { const int un = u + gridDim.x; if (un < 4096) R4_DMA(un); }
#ifndef NO_S5
        { const int rt_ = w >> 1; const int row = 16 * rt_ + lq;
          unsigned char* bigb = ws + WS_BIG;
          bf16_t* gRH = (bf16_t*)(bigb + BIG_RH) + (size_t)u * 4096; float* gY0 = (float*)((bf16_t*)(bigb + BIG_Y0) + (size_t)u * 4096);
          bf16_t* gMM = (bf16_t*)(bigb + BIG_MM) + (size_t)(h * 256 + c) * 4096; float* gNT = (float*)((bf16_t*)(bigb + BIG_NT) + (size_t)(h * 256 + c) * 4096);
          bf16x8 f_arb[2], f_ark[2], f_bt[2], f_w1[2], f_vt[2];
#pragma unroll
          for (int ks = 0; ks < 2; ++ks) { const int ko = ks * 32 + 8 * q; f_arb[ks] = ldsfrag(ARB, row, ko); f_ark[ks] = ldsfrag(ARK, row, ko); f_bt[ks] = ldsfrag(BT, row, ko); f_w1[ks] = ldsfrag(W1T, row, ko); f_vt[ks] = ldsfrag(VT, row, ko); }
          const float plrow = PL[row];
#pragma unroll
          for (int k2 = 0; k2 < 2; ++k2) { const int ct = 2 * (w & 1) + k2; const int c0 = 16 * ct + 4 * q;
              f32x4 drh = {0.f, 0.f, 0.f, 0.f}, dy0 = drh, dmm = drh, dnt = drh;
#pragma unroll
              for (int ks = 0; ks < 2; ++ks) { const int ko = ks * 32 + 8 * q;
                  const bf16x8 c_ah = ldsfrag(AhT, 16 * ct + lq, ko), c_w1 = ldsfrag(W1T, 16 * ct + lq, ko), c_vt = ldsfrag(VT, 16 * ct + lq, ko), c_bt = ldsfrag(BT, 16 * ct + lq, ko), c_kt = ldsfrag(KT, 16 * ct + lq, ko);
                  drh = MFMA16(c_ah, f_arb[ks], drh);
                  dy0 = MFMA16(c_w1, f_arb[ks], dy0); dy0 = MFMA16(c_vt, f_ark[ks], dy0);
                  dmm = MFMA16(c_ah, f_bt[ks], dmm);
                  dnt = MFMA16(c_bt, f_w1[ks], dnt); dnt = MFMA16(c_kt, f_vt[ks], dnt); }
              float rr[4]; ld4(Rrow + row * R4_LD + c0, rr);
              st4(gRH + nat_st4(rt_, lq, c0), drh[0] + rr[0], drh[1] + rr[1], drh[2] + rr[2], drh[3] + rr[3]);
              st4((bf16_t*)gY0 + ((rt_ * 4 + ct) * 64 + lane) * 4, dy0[0], dy0[1], dy0[2], dy0[3]);
#pragma unroll
              for (int e = 0; e < 4; ++e) { dmm[e] = plrow * (dmm[e] + ((c0 + e) == row ? 1.f : 0.f)); dnt[e] *= PL[c0 + e]; }
              st4(gMM + nat_st4(rt_, lq, c0), dmm[0], dmm[1], dmm[2], dmm[3]);
              st4((bf16_t*)gNT + ((rt_ * 4 + ct) * 64 + lane) * 4, dnt[0], dnt[1], dnt[2], dnt[3]); } }
#endif
    }
}
__device__ __forceinline__ void r5_phase(const Args& a, unsigned char* lds) {
    const int bid = pg8::opq_bid(); if (bid >= 64) return;
    unsigned char* ws = pg8::opq_ptr(a.ws); const int tid = pg8::opq_tid(), lane = tid & 63, w = tid >> 6, lq = lane & 15, q = lane >> 4; const int h = bid & 15, iq = bid >> 4;
    const bf16_t* gMM = (const bf16_t*)(ws + WS_BIG + BIG_MM); const float* gNT = (const float*)(ws + WS_BIG + BIG_NT);
    bf16_t* SC = (bf16_t*)(ws + WS_MIX + (size_t)1 * SZ_TD2);
    bf16_t* Sb = (bf16_t*)lds;
    for (int i = tid; i < 2 * 16 * R4_LD / 2; i += 512) ((unsigned*)Sb)[i] = 0u;
    for (int i = tid; i < 512; i += 512) ((unsigned*)(SC + (size_t)h * 4096 + iq * 1024))[i] = 0u;
    __syncthreads();
    if (w >= 4) {
        for (int c = 0; c < 256; ++c) { asm volatile("s_waitcnt lgkmcnt(0)" ::: "memory"); __builtin_amdgcn_s_barrier(); asm volatile("" ::: "memory"); }
        return; }
    const int jt = w; const int irow = 16 * iq + lq;
    bf16x8 Mr[8][2]; f32x4 Nr[8];
#pragma unroll
    for (int k = 0; k < 8; ++k) { const size_t ub = (size_t)(h * 256 + k) * 4096;
#pragma unroll
        for (int ks = 0; ks < 2; ++ks) Mr[k][ks] = *(const bf16x8*)(gMM + ub + nat_frag(jt, ks, lane));
        Nr[k] = ldbf4((const bf16_t*)gNT + ub + ((iq * 4 + jt) * 64 + lane) * 4); }
    for (int c0 = 0; c0 < 256; c0 += 8) {
#pragma unroll
        for (int k = 0; k < 8; ++k) { const int c = c0 + k;
            const bf16_t* Sc_ = Sb + (k & 1) * 16 * R4_LD; bf16_t* Sn_ = Sb + ((k & 1) ^ 1) * 16 * R4_LD;
            bf16_t* scn = SC + (size_t)((c + 1) * 16 + h) * 4096;
            f32x4 d = Nr[k];
#pragma unroll
            for (int ks = 0; ks < 2; ++ks) d = MFMA16(Mr[k][ks], ldsfrag(Sc_, lq, ks * 32 + 8 * q), d);
            st4(Sn_ + lq * R4_LD + 16 * jt + 4 * q, d[0], d[1], d[2], d[3]);
            if (c < 255) st4(scn + nat_st4(iq, lq, 16 * jt + 4 * q), d[0], d[1], d[2], d[3]);
            { const int cn = (c + 8 < 256) ? c + 8 : 255; const size_t ub = (size_t)(h * 256 + cn) * 4096;
#pragma unroll
              for (int ks = 0; ks < 2; ++ks) Mr[k][ks] = *(const bf16x8*)(gMM + ub + nat_frag(jt, ks, lane));
              Nr[k] = ldbf4((const bf16_t*)gNT + ub + ((iq * 4 + jt) * 64 + lane) * 4); }
            asm volatile("s_waitcnt lgkmcnt(0)" ::: "memory"); __builtin_amdgcn_s_barrier(); asm volatile("" ::: "memory");
        }
    }
}
__device__ __forceinline__ void r6_phase(const Args& a, int l) {
    unsigned char* ws = pg8::opq_ptr(a.ws); const int tid = pg8::opq_tid(), lane = tid & 63, lq = lane & 15, q = lane >> 4; const int gw = pg8::opq_bid() * 8 + (tid >> 6), NGW = gridDim.x * 8;
    const bf16_t* gRH = (const bf16_t*)(ws + WS_BIG + BIG_RH); const float* gY0 = (const float*)(ws + WS_BIG + BIG_Y0); const bf16_t* SC = (const bf16_t*)(ws + WS_MIX + (size_t)1 * SZ_TD2);
    const bf16_t* base = (const bf16_t*)(ws + WS_MIX); const bf16_t* pR = base; const bf16_t* pK = base + (size_t)2 * T * D; const bf16_t* pV = base + (size_t)(5 + l) * T * D; const bf16_t* pG = base + (size_t)7 * T * D;
    bf16_t* YG = (bf16_t*)(ws + WS_MIX + (size_t)3 * SZ_TD2);
    const float* lnw = a.in[21] + l * D; const float* lnb = a.in[22] + l * D; const float* rk = a.in[20] + l * D;
    struct R6In { bf16x8 fr[2]; bf16x8 fs[4][2]; u32x2 Ly[4], Lr[4], Lk[4], Lv[4], Lg[4]; };
#define R6_LOAD(R_, item_) do { const int tt_ = (item_) & 3, u_ = (item_) >> 2; const int h_ = u_ & 15, c_ = u_ >> 4; const int t_ = c_ * 64 + tt_ * 16 + lq; const size_t ub_ = (size_t)u_ * 4096; \
        _Pragma("unroll") for (int ks = 0; ks < 2; ++ks) (R_).fr[ks] = *(const bf16x8*)(gRH + ub_ + nat_frag(tt_, ks, lane)); \
        _Pragma("unroll") for (int it = 0; it < 4; ++it) { (R_).Ly[it] = *(const u32x2*)((const bf16_t*)gY0 + ub_ + ((tt_ * 4 + it) * 64 + lane) * 4); \
            _Pragma("unroll") for (int ks = 0; ks < 2; ++ks) (R_).fs[it][ks] = *(const bf16x8*)(SC + ub_ + nat_frag(it, ks, lane)); \
            const size_t off_ = (size_t)t_ * D + h_ * 64 + 16 * it + 4 * q; (R_).Lr[it] = *(const u32x2*)(pR + off_); (R_).Lk[it] = *(const u32x2*)(pK + off_); (R_).Lv[it] = *(const u32x2*)(pV + off_); (R_).Lg[it] = *(const u32x2*)(pG + off_); } } while (0)
    R6In Rn; if (gw < 16384) R6_LOAD(Rn, gw);
    for (int item = gw; item < 16384; item += NGW) { const int tt = item & 3, u = item >> 2; const int h = u & 15, c = u >> 4; const int t = c * 64 + tt * 16 + lq;
        const R6In Rc = Rn; { const int nx = item + NGW; if (nx < 16384) R6_LOAD(Rn, nx); }
        f32x4 y[4]; u32x2 Lr[4], Lk[4], Lv[4], Lg[4]; bf16x8 fr[2], fs[4][2];
#pragma unroll
        for (int ks = 0; ks < 2; ++ks) fr[ks] = Rc.fr[ks];
#pragma unroll
        for (int it = 0; it < 4; ++it) { y[it] = (f32x4){bflo(Rc.Ly[it].x), bfhi(Rc.Ly[it].x), bflo(Rc.Ly[it].y), bfhi(Rc.Ly[it].y)}; fs[it][0] = Rc.fs[it][0]; fs[it][1] = Rc.fs[it][1]; Lr[it] = Rc.Lr[it]; Lk[it] = Rc.Lk[it]; Lv[it] = Rc.Lv[it]; Lg[it] = Rc.Lg[it]; }
#pragma unroll
        for (int it = 0; it < 4; ++it)
#pragma unroll
            for (int ks = 0; ks < 2; ++ks) y[it] = MFMA16(fs[it][ks], fr[ks], y[it]);
        float sm = 0.f, bs = 0.f; float vv[4][4], gg[4][4];
#pragma unroll
        for (int it = 0; it < 4; ++it) { const int c0 = h * 64 + 16 * it + 4 * q; float r4[4], k4[4];
            up4(Lr[it], r4); up4(Lk[it], k4); up4(Lv[it], vv[it]); up4(Lg[it], gg[it]); const f32x4 rkv = *(const f32x4*)(rk + c0);
#pragma unroll
            for (int e = 0; e < 4; ++e) { sm += y[it][e]; bs += r4[e] * k4[e] * rkv[e]; } }
        sm += __shfl_xor(sm, 16); sm += __shfl_xor(sm, 32); bs += __shfl_xor(bs, 16); bs += __shfl_xor(bs, 32);
        const float mean = sm * (1.f / 64.f); float vr = 0.f;
#pragma unroll
        for (int it = 0; it < 4; ++it)
#pragma unroll
            for (int e = 0; e < 4; ++e) { const float dd = y[it][e] - mean; vr += dd * dd; }
        vr += __shfl_xor(vr, 16); vr += __shfl_xor(vr, 32);
        const float rstd = rsqrtf(vr * (1.f / 64.f) + 64e-5f);
#pragma unroll
        for (int it = 0; it < 4; ++it) { const int c0 = h * 64 + 16 * it + 4 * q; const f32x4 lw = *(const f32x4*)(lnw + c0), lb = *(const f32x4*)(lnb + c0); float o[4];
#pragma unroll
            for (int e = 0; e < 4; ++e) o[e] = ((y[it][e] - mean) * rstd * lw[e] + lb[e] + bs * vv[it][e]) * gg[it][e];
            st4(YG + (size_t)t * D + c0, o[0], o[1], o[2], o[3]); }
    }
}
constexpr int VT_LD = 136;
__device__ __forceinline__ int vt_addr(int dim, int kp) { return dim * VT_LD + (dim >> 4) * 8 + kp; }
constexpr int KL_LD = 72;
struct AttRegs { u32x4 k[4], v0a, v0b, v1a, v1b; bf16x8 q[2]; };
__device__ __forceinline__ void att_decode(int u, int& g, int& h, int& d, int& rsd, int& n) { g = u >> 11; const int rem = u & 2047; h = rem >> 7; const int rr = rem & 127; const int sh = 2 * g; d = 1 << sh; rsd = rr & (d - 1); n = rr >> sh; }
__device__ __forceinline__ void att_load(const bf16_t* Q, const bf16_t* KV, int u, int tid, AttRegs& R) {
    int g, h, d, rsd, n; att_decode(u, g, h, d, rsd, n); const int hc = g * 1024 + h * 64; const int lane = tid & 63, w = tid >> 6, lq = lane & 15, qp = lane >> 4;
    const int sh = 2 * g; const size_t plane = ((size_t)(g * 16 + h) * T + (size_t)rsd * (T >> sh)) * 64; (void)hc;
    { const int key = tid >> 1, half = tid & 1; int mk = 128 * (n - 1) + key; mk = mk < 0 ? 0 : mk; const bf16_t* p = KV + plane + (size_t)mk * 64 + half * 32;
#pragma unroll
      for (int i = 0; i < 4; ++i) R.k[i] = *(const u32x4*)(p + 8 * i); }
    { const int kp = tid >> 2, dg = tid & 3; const u32x4 z = {0u, 0u, 0u, 0u}; R.v0a = z; R.v0b = z; R.v1a = z; R.v1b = z; const int m0 = 128 * (n - 1) + 2 * kp;
      if (m0 >= 0) { const bf16_t* p0 = KV + (size_t)48 * T * 64 + plane + (size_t)m0 * 64 + dg * 16; const bf16_t* p1 = p0 + 64;
          R.v0a = *(const u32x4*)p0; R.v0b = *(const u32x4*)(p0 + 8); R.v1a = *(const u32x4*)p1; R.v1b = *(const u32x4*)(p1 + 8); } }
    { const int qi = 16 * w + lq; const int tq = (128 * n + qi) * d + rsd;
#pragma unroll
      for (int ks = 0; ks < 2; ++ks) R.q[ks] = *(const bf16x8*)(Q + plane + (size_t)(128 * n + qi) * 64 + ks * 32 + qp * 8); (void)tq; }
}
__device__ __forceinline__ void attn_phase(const Args& a, unsigned* vt) {
    unsigned char* ws = pg8::opq_ptr(a.ws); const int tid = pg8::opq_tid(), lane = tid & 63, w = tid >> 6, lq = lane & 15, qp = lane >> 4;
    const bf16_t* Q = (const bf16_t*)(ws + WS_BIG + BIG_Q); const bf16_t* KV = (const bf16_t*)(ws + WS_MIX);
    bf16_t* OG = (bf16_t*)(ws + WS_BIG + BIG_OG); float* LSE = (float*)(ws + WS_BIG + BIG_LSE);
    bf16_t* kl = (bf16_t*)(vt + 9216);
    const int G = gridDim.x; int u = pg8::opq_bid();
    AttRegs R, R2; if (u < 6144) { att_load(Q, KV, u, tid, R); att_load(Q, KV, (u + G < 6144) ? u + G : u, tid, R2); }
    for (; u < 6144; u += G) {
        int g, h, d, rsd, n; att_decode(u, g, h, d, rsd, n);
        asm volatile("s_waitcnt lgkmcnt(0)" ::: "memory"); __builtin_amdgcn_s_barrier(); asm volatile("" ::: "memory");
        { const int key = tid >> 1, half = tid & 1;
#pragma unroll
          for (int i = 0; i < 4; ++i) *(u32x4*)(kl + key * KL_LD + half * 32 + 8 * i) = R.k[i]; }
        { const int kp = tid >> 2, dg = tid & 3;
          const unsigned e0[8] = {R.v0a.x, R.v0a.y, R.v0a.z, R.v0a.w, R.v0b.x, R.v0b.y, R.v0b.z, R.v0b.w}; const unsigned e1[8] = {R.v1a.x, R.v1a.y, R.v1a.z, R.v1a.w, R.v1b.x, R.v1b.y, R.v1b.z, R.v1b.w};
#pragma unroll
          for (int j = 0; j < 8; ++j) { const int dim = dg * 16 + 2 * j;
              vt[vt_addr(dim, kp)] = (e0[j] & 0xffffu) | (e1[j] << 16);
              vt[vt_addr(dim + 1, kp)] = (e0[j] >> 16) | (e1[j] & 0xffff0000u); } }
        bf16x8 bq[2]; bq[0] = R.q[0]; bq[1] = R.q[1];
        asm volatile("s_waitcnt lgkmcnt(0)" ::: "memory"); __builtin_amdgcn_s_barrier(); asm volatile("" ::: "memory");
        R = R2; { const int un = (u + 2 * G < 6144) ? u + 2 * G : u; att_load(Q, KV, un, tid, R2); }
        const int qi = 16 * w + lq; const int tq = (128 * n + qi) * d + rsd;
        const int kt0 = 2 * (w >> 1);
        f32x4 sc[10];
#pragma unroll
        for (int kl_ = 0; kl_ < 10; ++kl_) { const int krow = 16 * (kt0 + kl_) + lq; f32x4 acc = {0.f, 0.f, 0.f, 0.f};
            acc = MFMA16(*(const bf16x8*)(kl + krow * KL_LD + qp * 8), bq[0], acc); acc = MFMA16(*(const bf16x8*)(kl + krow * KL_LD + 32 + qp * 8), bq[1], acc); sc[kl_] = acc; }
        float mx = -3.0e38f;
#pragma unroll
        for (int kl_ = 0; kl_ < 10; ++kl_)
#pragma unroll
            for (int e = 0; e < 4; ++e) { const int kj = 16 * (kt0 + kl_) + 4 * qp + e; const bool valid = (kj >= qi) && (kj <= qi + 128) && (n > 0 || kj >= 128);
                const float sv = valid ? sc[kl_][e] : -1e30f; sc[kl_][e] = sv; mx = fmaxf(mx, sv); }
        mx = fmaxf(mx, __shfl_xor(mx, 16)); mx = fmaxf(mx, __shfl_xor(mx, 32));
        float lsum = 0.f;
#pragma unroll
        for (int kl_ = 0; kl_ < 10; ++kl_)
#pragma unroll
            for (int e = 0; e < 4; ++e) { const float p = __expf(sc[kl_][e] - mx); sc[kl_][e] = p; lsum += p; }
        lsum += __shfl_xor(lsum, 16); lsum += __shfl_xor(lsum, 32);
        f32x4 oacc[4];
#pragma unroll
        for (int dt = 0; dt < 4; ++dt) oacc[dt] = (f32x4){0.f, 0.f, 0.f, 0.f};
#pragma unroll
        for (int sl = 0; sl < 5; ++sl) { u32x4 pw; pw.x = cvt_pk_bf16(sc[2 * sl][0], sc[2 * sl][1]); pw.y = cvt_pk_bf16(sc[2 * sl][2], sc[2 * sl][3]);
            pw.z = cvt_pk_bf16(sc[2 * sl + 1][0], sc[2 * sl + 1][1]); pw.w = cvt_pk_bf16(sc[2 * sl + 1][2], sc[2 * sl + 1][3]);
            const bf16x8 bp = __builtin_bit_cast(bf16x8, pw); const int kpb = 16 * ((kt0 >> 1) + sl) + 2 * qp;
#pragma unroll
            for (int dt = 0; dt < 4; ++dt) { const int dim = dt * 16 + lq; const u32x2 lo = *(const u32x2*)(vt + vt_addr(dim, kpb)); const u32x2 hi = *(const u32x2*)(vt + vt_addr(dim, kpb + 8));
                u32x4 aw; aw.x = lo.x; aw.y = lo.y; aw.z = hi.x; aw.w = hi.y;
                oacc[dt] = MFMA16(__builtin_bit_cast(bf16x8, aw), bp, oacc[dt]); } }
        const float il = 1.f / lsum;
        bf16_t* op = OG + (size_t)g * T * D + (size_t)tq * D + h * 64 + 4 * qp;
#pragma unroll
        for (int dt = 0; dt < 4; ++dt) st4(op + dt * 16, oacc[dt][0] * il, oacc[dt][1] * il, oacc[dt][2] * il, oacc[dt][3] * il);
        if (qp == 0) LSE[(size_t)g * T * 16 + (size_t)tq * 16 + h] = mx + __logf(lsum);
    }
}
__device__ __forceinline__ void comb_phase(const Args& a) {
    unsigned char* ws = pg8::opq_ptr(a.ws); const int lane = pg8::opq_tid() & 63; const int gw = pg8::opq_bid() * 8 + (pg8::opq_tid() >> 6), NGW = gridDim.x * 8;
    const bf16_t* OG = (const bf16_t*)(ws + WS_BIG + BIG_OG); const float* LSE = (const float*)(ws + WS_BIG + BIG_LSE); bf16_t* O = (bf16_t*)(ws + WS_MIX + (size_t)T * KVW * 2);
    const int c0 = lane * 16, h = lane >> 2;
    for (int t = gw; t < T; t += NGW) {
        const float l0 = LSE[(size_t)t * 16 + h], l1 = LSE[(size_t)T * 16 + (size_t)t * 16 + h], l2 = LSE[(size_t)2 * T * 16 + (size_t)t * 16 + h];
        const float mx = fmaxf(l0, fmaxf(l1, l2)); float e0 = __expf(l0 - mx), e1 = __expf(l1 - mx), e2 = __expf(l2 - mx); const float is = 1.f / (e0 + e1 + e2); e0 *= is; e1 *= is; e2 *= is;
        float o[16];
#pragma unroll
        for (int hf = 0; hf < 2; ++hf) { float x0[8], x1[8], x2[8]; const size_t off = (size_t)t * D + c0 + hf * 8;
            ld8(OG + off, x0); ld8(OG + (size_t)T * D + off, x1); ld8(OG + (size_t)2 * T * D + off, x2);
#pragma unroll
            for (int j = 0; j < 8; ++j) o[hf * 8 + j] = e0 * x0[j] + e1 * x1[j] + e2 * x2[j]; }
        u32x4 w0, w1; w0.x = cvt_pk_bf16(o[0], o[1]); w0.y = cvt_pk_bf16(o[2], o[3]); w0.z = cvt_pk_bf16(o[4], o[5]); w0.w = cvt_pk_bf16(o[6], o[7]);
        w1.x = cvt_pk_bf16(o[8], o[9]); w1.y = cvt_pk_bf16(o[10], o[11]); w1.z = cvt_pk_bf16(o[12], o[13]); w1.w = cvt_pk_bf16(o[14], o[15]);
        *(u32x4*)(O + (size_t)t * D + c0) = w0; *(u32x4*)(O + (size_t)t * D + c0 + 8) = w1; }
}
__global__ void __launch_bounds__(512, 2) mega(Args a) {
    extern __shared__ __attribute__((aligned(16))) unsigned char lds[];
    { volatile LAS unsigned* stw = (volatile LAS unsigned*)((LAS unsigned char*)lds + (LDS_BYTES - 64)); if (threadIdx.x < 2) stw[threadIdx.x] = 0u; }
    __syncthreads();
    { cg::grid_group grid = cg::this_grid(); if (a.ph_hi < 0) grid.sync(); }
    XcdBarrier bar = xcd_barrier_post((unsigned*)(a.ws + WS_BAR), (volatile LAS unsigned*)((LAS unsigned char*)lds + (LDS_BYTES - 64)));
    for (int s = a.ph_lo; s < a.ph_hi; ++s) {
        if (s > a.ph_lo) xcd_barrier(bar);
        unsigned char* ws = pg8::opq_ptr(a.ws); PG8_LAS unsigned char* glds = (PG8_LAS unsigned char*)lds; float* ssb = (float*)(ws + WS_SS); bf16_t* XB = (bf16_t*)(ws + WS_XB); const int bid = pg8::opq_bid();
        int type, l = 0, j = 0;
        if (s == 0) type = 0; else if (s == 21) type = 8;
        else { int o; if (s <= 10) { l = 0; o = s - 1; } else if (s <= 20) { l = 1; o = s - 11; } else if (s <= 29) { l = 2; o = s - 22; } else { l = 3; o = s - 30; }
            if (l < 2) { if (o < 2) type = 1 + o; else if (o < 6) type = o + 1; else if (o == 6) type = 13; else if (o == 7) type = 7; else { type = o - 7; j = 1; } }
            else { if (o < 2) type = 1 + o; else if (o < 6) type = o + 7; else { type = o - 5; j = 1; } } }
#ifndef DUP_MASK
#define DUP_MASK 0
#endif
        for (int rep = 0; rep < (((DUP_MASK >> type) & 1) ? 2 : 1); ++rep) {
#define FILL_RTAB(S_, ssp_) do { PG8_LAS float* rt_ = (PG8_LAS float*)(glds + 131072); for (int i_ = 0; i_ < 8; ++i_) { pg8::Unit u_; if (!(S_).next(i_, u_)) break; \
            if (threadIdx.x < 256) rt_[i_ * 256 + threadIdx.x] = row_rs((ssp_), u_.pm * 256 + (int)threadIdx.x); } __syncthreads(); } while (0)
        if (type == 0) { p0_phase(a, (float*)lds); }
        else if (type == 1) { pg8::Gemm g{XB, (const bf16_t*)(ws + WS_WIN + (size_t)(l * 2 + j) * SZ_WIN), T, 2 * FF, D}; pg8::StaticOrder S; S.init(T, 2 * FF, gridDim.x, bid);
            EpiSwiglu E{(bf16_t*)(ws + WS_BIG), ssb + (size_t)(3 * l + (j ? 2 : 0)) * T * 16, (const PG8_LAS float*)(glds + 131072)}; FILL_RTAB(S, E.ss);
            pg8::gemm_phase<EpiSwiglu, pg8::StaticOrder, true, true>(glds, g, S, E); }
        else if (type == 2 || type == 7 || type == 12) {
            pg8::Gemm g; EpiResid E; E.xnew = a.out; E.xb = XB; E.xold = a.out;
            if (type == 2) { g = pg8::Gemm{(const bf16_t*)(ws + WS_BIG), (const bf16_t*)(ws + WS_WOUT + (size_t)(l * 2 + j) * SZ_WOUT), T, D, FF}; E.alpha = 0.5f; E.ssn = ssb + (size_t)(3 * l + (j ? 3 : 1)) * T * 16; if (l == 0 && j == 0) E.xold = a.in[0]; }
            else if (type == 7) { g = pg8::Gemm{(const bf16_t*)(ws + WS_MIX + (size_t)3 * SZ_TD2), (const bf16_t*)(ws + WS_WOR + (size_t)l * SZ_SQ), T, D, D}; E.alpha = 1.f; E.ssn = ssb + (size_t)(3 * l + 2) * T * 16; }
            else { g = pg8::Gemm{(const bf16_t*)(ws + WS_MIX + (size_t)T * KVW * 2), (const bf16_t*)(ws + WS_WOA + (size_t)(l - 2) * SZ_SQ), T, D, D}; E.alpha = 1.f; E.ssn = ssb + (size_t)(3 * l + 2) * T * 16; }
            pg8::StaticOrder S; S.init(T, D, gridDim.x, bid);
            pg8::gemm_phase<EpiResid, pg8::StaticOrder, true, true>(glds, g, S, E); }
        else if (type == 3) { pg8::Gemm g{XB, (const bf16_t*)(ws + WS_WCAT + (size_t)l * SZ_WCAT), T, NCAT, D}; pg8::StaticOrder S; S.init(T, NCAT, gridDim.x, bid);
            EpiPlain E{(bf16_t*)(ws + WS_BIG), NCAT};
            pg8::gemm_phase<EpiPlain, pg8::StaticOrder, true, true>(glds, g, S, E); }
        else if (type == 4) f1_phase(a, l, lds);
        else if (type == 5) r4_phase(a, l, lds);
        else if (type == 6) { if (bid >= 64 && gridDim.x > 64) p0_convert(a, (float*)lds, l + 1, bid - 64, gridDim.x - 64); else r5_phase(a, lds); }
        else if (type == 13) r6_phase(a, l);
        else if (type == 8 || type == 9) {
            pg8::Gemm g; EpiHeadNorm E; E.nnorm = 48;
            if (type == 8) { g = pg8::Gemm{XB, (const bf16_t*)(ws + WS_WKV), T, KVW, D}; E.O = (bf16_t*)(ws + WS_MIX); E.ldc = KVW; E.ss = ssb + (size_t)6 * T * 16; E.gain = a.in[26]; E.scale = 1.f; }
            else { g = pg8::Gemm{XB, (const bf16_t*)(ws + WS_WQ + (size_t)(l - 2) * SZ_WQ), T, QW, D}; E.O = (bf16_t*)(ws + WS_BIG + BIG_Q); E.ldc = QW; E.ss = ssb + (size_t)(3 * l + 1) * T * 16; E.gain = a.in[28] + (l - 2) * 192; E.scale = 0.125f; }
            pg8::StaticOrder S; S.init(T, g.N, gridDim.x, bid); E.rtab = (const PG8_LAS float*)(glds + 131072); FILL_RTAB(S, E.ss);
            pg8::gemm_phase<EpiHeadNorm, pg8::StaticOrder, true, true>(glds, g, S, E); }
        else if (type == 10) attn_phase(a, (unsigned*)lds);
        else if (type == 11) comb_phase(a);
        }
    }
}

extern "C" void kernel_launch(void* const* d_in, const int* in_sizes, int n_in, void* d_out, int out_size, void* d_ws, size_t ws_size, hipStream_t stream) {
    static int grid = 0;
    if (grid == 0) {
        if (n_in != 30 || out_size != T * D || ws_size < WS_END) { fprintf(stderr, "kernel_launch: unexpected shapes: n_in %d out %d ws %zu (need %zu)\n", n_in, out_size, ws_size, (size_t)WS_END); grid = -1; return; }
        int dev = 0, cus = 0, per_cu = 0;
        (void)hipGetDevice(&dev); (void)hipDeviceGetAttribute(&cus, hipDeviceAttributeMultiprocessorCount, dev);
        if (hipFuncSetAttribute((const void*)mega, hipFuncAttributeMaxDynamicSharedMemorySize, LDS_BYTES) != hipSuccess) { fprintf(stderr, "kernel_launch: hipFuncSetAttribute failed\n"); grid = -1; return; }
        if (hipOccupancyMaxActiveBlocksPerMultiprocessor(&per_cu, (const void*)mega, 512, LDS_BYTES) != hipSuccess || per_cu < 1) { fprintf(stderr, "kernel_launch: occupancy query says %d\n", per_cu); per_cu = 1; }
        (void)hipGetLastError();
        grid = cus * 1;
        if (grid <= 0) grid = 256;
    }
    if (grid < 0) return;
    if (hipMemsetAsync((char*)d_ws + WS_BAR, 0, XCD_BAR_WORDS * 4, stream) != hipSuccess) { fprintf(stderr, "kernel_launch: memset failed\n"); return; }
    Args a{};
    for (int i = 0; i < 30; ++i) a.in[i] = (const float*)d_in[i];
    a.out = (float*)d_out; a.ws = (unsigned char*)d_ws;
#if ONE_LAUNCH
    a.ph_lo = 0; a.ph_hi = NSTEPS;
    void* args[] = {&a};
    hipError_t e = hipLaunchCooperativeKernel((const void*)mega, dim3(grid), dim3(512), args, LDS_BYTES, stream);
    if (e != hipSuccess) fprintf(stderr, "cooperative launch failed: %s (grid %d)\n", hipGetErrorString(e), grid);
#else
    for (int s = 0; s < NSTEPS; ++s) { a.ph_lo = s; a.ph_hi = s + 1; hipLaunchKernelGGL(mega, dim3(grid), dim3(512), LDS_BYTES, stream, a); }
#endif
}
```
